# Optimizing an MI355X kernel written in HIP

```python
import jax, jax.numpy as jnp
from jax import lax
import numpy as np

D_MODEL = 2048
BATCH = 1
SEQ = 16384
DEPTH = 2
DEC_BATCH = 16
DEC_SEQ = 64
PAST_LEN = 4096

CHUNK = 64
N_HEADS = 16
HEAD_DIM = 128
ROPE_DIM = 64
Q_LORA = 512
KV_LORA = 256
POOL_GROUPS = 4
POOL_GROUP_DIM = 128
POOL_WIDTH = POOL_GROUPS * POOL_GROUP_DIM
POOL_WINDOWS = (2, 4, 8, 16)
POOL_PAD = 15
POOL_OUT = D_MODEL // POOL_GROUPS
N_MEM = 256
MEM_HEADS = 4
MEM_QK_DIM = 128
MEM_V_DIM = D_MODEL // MEM_HEADS
D_FF = 5632
N_BRANCH = 3
Q_BLOCK = 128
ROPE_THETA = 10000.0
EPS = 1e-6
NEG_INF = -1e30
IN_SPLITS = (Q_LORA, Q_LORA + KV_LORA, Q_LORA + KV_LORA + ROPE_DIM,
             Q_LORA + KV_LORA + ROPE_DIM + POOL_WIDTH)
IN_WIDTH = Q_LORA + KV_LORA + ROPE_DIM + POOL_WIDTH + MEM_HEADS * MEM_QK_DIM

kernel_name = "hybrid_streaming_mla_pool_mem_step"


def rmsnorm(x, g):
    x32 = x.astype(jnp.float32)
    y = x32 * lax.rsqrt(jnp.mean(x32 * x32, axis=-1, keepdims=True) + EPS)
    return (y * g.astype(jnp.float32)).astype(x.dtype)


def rope(x, pos):
    half = ROPE_DIM // 2
    inv = jnp.power(ROPE_THETA, -jnp.arange(half, dtype=jnp.float32) / half)
    ang = pos.astype(jnp.float32)[:, None] * inv[None, :]
    shape = (1, pos.shape[0]) + (1,) * (x.ndim - 3) + (half,)
    cos = jnp.cos(ang).reshape(shape)
    sin = jnp.sin(ang).reshape(shape)
    x32 = x.astype(jnp.float32)
    x1, x2 = x32[..., :half], x32[..., half:]
    return jnp.concatenate([x1 * cos - x2 * sin, x1 * sin + x2 * cos], axis=-1).astype(x.dtype)


def swiglu(x, g, wg, wu, wd):
    h = rmsnorm(x, g)
    return (jax.nn.silu(h @ wg) * (h @ wu)) @ wd


def mla_attention(q_nope, q_rope, k_nope, k_rope, v, q_pos, k_pos):
    scale = (HEAD_DIM + ROPE_DIM) ** -0.5
    k_chunk = k_pos // CHUNK

    def block(qn, qr, qp):
        s = (jnp.einsum('bqhd,bkhd->bhqk', qn, k_nope)
             + jnp.einsum('bqhd,bkd->bhqk', qr, k_rope)).astype(jnp.float32) * scale
        mask = k_chunk[None, :] <= (qp // CHUNK)[:, None]
        s = jnp.where(mask[None, None], s, NEG_INF)
        p = jax.nn.softmax(s, axis=-1).astype(v.dtype)
        return jnp.einsum('bhqk,bkhd->bqhd', p, v)

    B, T = q_nope.shape[0], q_nope.shape[1]
    if T <= Q_BLOCK:
        return block(q_nope, q_rope, q_pos)
    nb = T // Q_BLOCK
    qn_b = jnp.moveaxis(q_nope.reshape(B, nb, Q_BLOCK, N_HEADS, HEAD_DIM), 1, 0)
    qr_b = jnp.moveaxis(q_rope.reshape(B, nb, Q_BLOCK, N_HEADS, ROPE_DIM), 1, 0)
    qp_b = q_pos.reshape(nb, Q_BLOCK)
    out = lax.map(lambda a: block(a[0], a[1], a[2]), (qn_b, qr_b, qp_b))
    return jnp.moveaxis(out, 0, 1).reshape(B, T, N_HEADS, HEAD_DIM)


def pool_mix(p_ext, pos, pool_w, pool_scale):
    B, L, _ = p_ext.shape
    T = L - POOL_PAD
    cs = jnp.cumsum(p_ext.astype(jnp.float32), axis=1)
    cs = jnp.concatenate([jnp.zeros((B, 1, POOL_WIDTH), jnp.float32), cs], axis=1)
    cur = p_ext[:, POOL_PAD:].astype(jnp.float32)
    outs = []
    for g, w in enumerate(POOL_WINDOWS):
        lo, hi = g * POOL_GROUP_DIM, (g + 1) * POOL_GROUP_DIM
        upper = cs[:, POOL_PAD + 1:, lo:hi]
        lower = cs[:, POOL_PAD + 1 - w:POOL_PAD + 1 - w + T, lo:hi]
        cnt = jnp.minimum(pos + 1, w).astype(jnp.float32)[None, :, None]
        outs.append((upper - lower) / cnt - cur[..., lo:hi])
    pooled = jnp.stack(outs, axis=2).astype(p_ext.dtype)
    y = jnp.einsum('btgc,gcd->btgd', pooled, pool_w).reshape(B, T, D_MODEL)
    return y * pool_scale


def mem_kv(mem, mem_norm, w_mk, w_mv, mk_norm):
    B, M, _ = mem.shape
    m = rmsnorm(mem, mem_norm)
    k = rmsnorm((m @ w_mk).reshape(B, M, MEM_HEADS, MEM_QK_DIM), mk_norm)
    v = (m @ w_mv).reshape(B, M, MEM_HEADS, MEM_V_DIM)
    return k, v


def layer(x, pos, ckv_past, kr_past, pool_buf, mem_k, mem_v,
          ffn1_norm, ffn1_wg, ffn1_wu, ffn1_wd, mix_norm, w_in, q_lat_norm, kv_lat_norm,
          w_uq, w_uqr, w_uk, w_uv, q_norm, k_norm, qr_norm, kr_norm, pool_w, pool_scale,
          mq_norm, w_gate, b_gate, w_out, ffn2_norm, ffn2_wg, ffn2_wu, ffn2_wd):
    B, T, _ = x.shape
    h = x + 0.5 * swiglu(x, ffn1_norm, ffn1_wg, ffn1_wu, ffn1_wd)
    u = rmsnorm(h, mix_norm)
    q_lat, kv_lat, kr, pin, mq = jnp.split(u @ w_in, IN_SPLITS, axis=-1)

    c_q = rmsnorm(q_lat, q_lat_norm)
    q_nope = rmsnorm((c_q @ w_uq).reshape(B, T, N_HEADS, HEAD_DIM), q_norm)
    q_rope = rope(rmsnorm((c_q @ w_uqr).reshape(B, T, N_HEADS, ROPE_DIM), qr_norm), pos)
    c_kv = rmsnorm(kv_lat, kv_lat_norm)
    k_r = rope(rmsnorm(kr, kr_norm), pos)
    if ckv_past is None:
        ckv_all, kr_all = c_kv, k_r
    else:
        ckv_all = jnp.concatenate([ckv_past, c_kv], axis=1)
        kr_all = jnp.concatenate([kr_past, k_r], axis=1)
    S = ckv_all.shape[1]
    k_nope = rmsnorm((ckv_all @ w_uk).reshape(B, S, N_HEADS, HEAD_DIM), k_norm)
    v = (ckv_all @ w_uv).reshape(B, S, N_HEADS, HEAD_DIM)
    attn = mla_attention(q_nope, q_rope, k_nope, kr_all, v, pos, jnp.arange(S)).reshape(B, T, D_MODEL)

    p_ext = jnp.concatenate([pool_buf.astype(pin.dtype), pin], axis=1)
    pool_out = pool_mix(p_ext, pos, pool_w, pool_scale)
    new_pool = p_ext[:, -POOL_PAD:]

    q_m = rmsnorm(mq.reshape(B, T, MEM_HEADS, MEM_QK_DIM), mq_norm)
    s_m = jnp.einsum('bqhd,bmhd->bhqm', q_m, mem_k).astype(jnp.float32) * MEM_QK_DIM ** -0.5
    p_m = jax.nn.softmax(s_m, axis=-1).astype(mem_v.dtype)
    mem_out = jnp.einsum('bhqm,bmhd->bqhd', p_m, mem_v).reshape(B, T, D_MODEL)

    gates = jax.nn.sigmoid((u @ w_gate).astype(jnp.float32) + b_gate.astype(jnp.float32))
    gates = gates.reshape(B, T, N_BRANCH, D_MODEL)
    merged = (gates[:, :, 0] * attn.astype(jnp.float32)
              + gates[:, :, 1] * pool_out.astype(jnp.float32)
              + gates[:, :, 2] * mem_out.astype(jnp.float32)).astype(x.dtype)
    h = h + merged @ w_out
    out = h + 0.5 * swiglu(h, ffn2_norm, ffn2_wg, ffn2_wu, ffn2_wd)
    return out, c_kv, k_r, new_pool


def setup_inputs(seed: int = 0) -> dict:
    key = jax.random.key(seed)
    ks = iter(jax.random.split(key, 48))

    def nrm(shape, scale):
        return jax.random.normal(next(ks), shape, jnp.float32) * scale

    def gain(dim):
        return 1.0 + 0.02 * jax.random.normal(next(ks), (DEPTH, dim), jnp.float32)

    d = D_MODEL
    inp = {}
    inp["x_prompt"] = nrm((BATCH, SEQ, d), 1.0)
    inp["x_sample"] = nrm((DEC_BATCH, DEC_SEQ, d), 1.0)
    inp["mem_prompt"] = nrm((BATCH, N_MEM, d), 1.0)
    inp["cache_ckv"] = nrm((DEPTH, DEC_BATCH, PAST_LEN, KV_LORA), 1.0)
    inp["cache_krope"] = nrm((DEPTH, DEC_BATCH, PAST_LEN, ROPE_DIM), 1.0)
    inp["state_pool"] = nrm((DEPTH, DEC_BATCH, POOL_PAD, POOL_WIDTH), 1.0)
    inp["cache_mem_k"] = nrm((DEPTH, DEC_BATCH, N_MEM, MEM_HEADS, MEM_QK_DIM), 1.0)
    inp["cache_mem_v"] = nrm((DEPTH, DEC_BATCH, N_MEM, MEM_HEADS, MEM_V_DIM), 1.0)
    inp["ffn1_norm"] = gain(d)
    inp["ffn1_wg"] = nrm((DEPTH, d, D_FF), d ** -0.5)
    inp["ffn1_wu"] = nrm((DEPTH, d, D_FF), d ** -0.5)
    inp["ffn1_wd"] = nrm((DEPTH, D_FF, d), D_FF ** -0.5)
    inp["mix_norm"] = gain(d)
    inp["w_in"] = nrm((DEPTH, d, IN_WIDTH), d ** -0.5)
    inp["q_lat_norm"] = gain(Q_LORA)
    inp["kv_lat_norm"] = gain(KV_LORA)
    inp["w_uq"] = nrm((DEPTH, Q_LORA, N_HEADS * HEAD_DIM), Q_LORA ** -0.5)
    inp["w_uqr"] = nrm((DEPTH, Q_LORA, N_HEADS * ROPE_DIM), Q_LORA ** -0.5)
    inp["w_uk"] = nrm((DEPTH, KV_LORA, N_HEADS * HEAD_DIM), KV_LORA ** -0.5)
    inp["w_uv"] = nrm((DEPTH, KV_LORA, N_HEADS * HEAD_DIM), KV_LORA ** -0.5)
    inp["q_norm"] = gain(HEAD_DIM)
    inp["k_norm"] = gain(HEAD_DIM)
    inp["qr_norm"] = gain(ROPE_DIM)
    inp["kr_norm"] = gain(ROPE_DIM)
    inp["pool_w"] = nrm((DEPTH, POOL_GROUPS, POOL_GROUP_DIM, POOL_OUT), POOL_GROUP_DIM ** -0.5)
    inp["pool_scale"] = 1.0 + 0.1 * nrm((DEPTH, d), 1.0)
    inp["mem_norm"] = gain(d)
    inp["w_mk"] = nrm((DEPTH, d, MEM_HEADS * MEM_QK_DIM), d ** -0.5)
    inp["w_mv"] = nrm((DEPTH, d, MEM_HEADS * MEM_V_DIM), d ** -0.5)
    inp["mq_norm"] = gain(MEM_QK_DIM)
    inp["mk_norm"] = gain(MEM_QK_DIM)
    inp["w_gate"] = nrm((DEPTH, d, N_BRANCH * d), d ** -0.5)
    inp["b_gate"] = nrm((DEPTH, N_BRANCH * d), 0.1)
    inp["w_out"] = nrm((DEPTH, d, d), 0.5 * d ** -0.5)
    inp["ffn2_norm"] = gain(d)
    inp["ffn2_wg"] = nrm((DEPTH, d, D_FF), d ** -0.5)
    inp["ffn2_wu"] = nrm((DEPTH, d, D_FF), d ** -0.5)
    inp["ffn2_wd"] = nrm((DEPTH, D_FF, d), D_FF ** -0.5)
    return inp


def reference(x_prompt, x_sample, mem_prompt, cache_ckv, cache_krope, state_pool, cache_mem_k, cache_mem_v,
              ffn1_norm, ffn1_wg, ffn1_wu, ffn1_wd, mix_norm, w_in, q_lat_norm, kv_lat_norm,
              w_uq, w_uqr, w_uk, w_uv, q_norm, k_norm, qr_norm, kr_norm, pool_w, pool_scale,
              mem_norm, w_mk, w_mv, mq_norm, mk_norm, w_gate, b_gate, w_out,
              ffn2_norm, ffn2_wg, ffn2_wu, ffn2_wd):
    layer_params = (ffn1_norm, ffn1_wg, ffn1_wu, ffn1_wd, mix_norm, w_in, q_lat_norm, kv_lat_norm,
                    w_uq, w_uqr, w_uk, w_uv, q_norm, k_norm, qr_norm, kr_norm, pool_w, pool_scale,
                    mq_norm, w_gate, b_gate, w_out, ffn2_norm, ffn2_wg, ffn2_wu, ffn2_wd)
    Bp, Tp, _ = x_prompt.shape
    Ts = x_sample.shape[1]
    past = cache_ckv.shape[2]
    pos_p = jnp.arange(Tp)
    pos_s = past + jnp.arange(Ts)

    xp, xs = x_prompt, x_sample
    ckv_p, kr_p, pool_p, mk_p, mv_p = [], [], [], [], []
    ckv_s, kr_s, pool_s = [], [], []
    for l in range(DEPTH):
        lp = [w[l] for w in layer_params]
        mk, mv = mem_kv(mem_prompt, mem_norm[l], w_mk[l], w_mv[l], mk_norm[l])
        zero_buf = jnp.zeros((Bp, POOL_PAD, POOL_WIDTH), xp.dtype)
        xp, c1, r1, b1 = layer(xp, pos_p, None, None, zero_buf, mk, mv, *lp)
        ckv_p.append(c1); kr_p.append(r1); pool_p.append(b1); mk_p.append(mk); mv_p.append(mv)
        xs, c2, r2, b2 = layer(xs, pos_s, cache_ckv[l], cache_krope[l], state_pool[l],
                               cache_mem_k[l], cache_mem_v[l], *lp)
        ckv_s.append(c2); kr_s.append(r2); pool_s.append(b2)

    return (xp, xs,
            jnp.stack(ckv_p), jnp.stack(kr_p), jnp.stack(pool_p), jnp.stack(mk_p), jnp.stack(mv_p),
            jnp.stack(ckv_s), jnp.stack(kr_s), jnp.stack(pool_s))
```

```cpp
#include <hip/hip_runtime.h>
#include <cstdio>
#include <cstdint>
#include <cmath>

constexpr int D = 2048, DFF = 5632, MP = 16384, MS = 1024, M = MP + MS, DEPTH = 2;
constexpr int NH = 16, HD = 128, RD = 64, QL = 512, KVL = 256, PWD = 512, MQD = 512, INW = 1856;
constexpr int NMEM = 256, MH = 4, MVD = 512;
constexpr int PAST = 4096, DB = 16, DS = 64, SKS = PAST + DS;
constexpr int CHB = 8, CHROWS = CHB * SKS;
constexpr int SALL = MP + DB * SKS;
constexpr int PPAD = 15;
constexpr float EPS = 1e-6f;
#define LOG2E 1.4426950408889634f

__device__ __forceinline__ int lane_id_fresh() { int x; asm volatile("v_mbcnt_lo_u32_b32 %0, -1, 0\n\tv_mbcnt_hi_u32_b32 %0, -1, %0" : "=v"(x)); return x; }
namespace pg8 {
#define PG8_LAS __attribute__((address_space(3)))
typedef unsigned short bf16_t;
typedef short bf16x8 __attribute__((ext_vector_type(8)));
typedef float f32x4 __attribute__((ext_vector_type(4)));
typedef unsigned u32x4 __attribute__((ext_vector_type(4)));
constexpr int BM = 256, BK = 64, HALF = 128, HTB = HALF * BK * 2  , STAGE_BYTES = 8 * HTB, NXCD = 8, WGM = 8;

__host__ __device__ __forceinline__ int lds_byte(int r, int c) { const int st = (r >> 4) * 2 + (c >> 5), rr = r & 15, cc = c & 31, ob = rr * 64 + cc * 2; return st * 1024 + (ob ^ (((ob >> 9) & 1) << 5)); }
__host__ __device__ __forceinline__ void stage_rc(int b, int& R, int& C) { const int st = b / 1024, sb = b % 1024, swz = sb ^ (((sb >> 9) & 1) << 5); R = (st >> 1) * 16 + swz / 64; C = (st & 1) * 32 + (swz % 64) / 2; }
__host__ __device__ __forceinline__ int perm32(int rho) { const int n = rho >> 4, i = rho & 15; return 8 * (i >> 2) + 4 * n + (i & 3); }

struct Unit { int pm, pn; };
struct Gemm { const bf16_t* A; const bf16_t* Bt; int M, N, K; };

struct StaticOrder {
    int nM, nN, nwg, G, c;
    __host__ __device__ void init(int M, int N, int G_, int c_) { nM = M / BM; nN = N / BM; nwg = nM * nN; G = G_; c = c_; }
    __host__ __device__ bool next(int i, Unit& u) const {
        const long L = (long)i * G + c; if (L >= nwg) return false;
        int wgid = (int)L; { const int q = nwg / NXCD, r = nwg % NXCD, xcd = wgid % NXCD, off = wgid / NXCD; wgid = (xcd < r ? xcd * (q + 1) : r * (q + 1) + (xcd - r) * q) + off; }
        const int nig = WGM * nN, gid = wgid / nig, fm = gid * WGM, gsz = (nM - fm) < WGM ? (nM - fm) : WGM;
        u.pm = fm + ((wgid % nig) % gsz); u.pn = (wgid % nig) / gsz; return true;
    }
    __device__ __forceinline__ void a_ready(const Unit&) const {}
    __device__ __forceinline__ void done(const Unit&) const {}
};
typedef float f32x2_t __attribute__((ext_vector_type(2)));
typedef __bf16 bf16x2_t __attribute__((ext_vector_type(2)));
__device__ __forceinline__ unsigned cvt_pk_bf16(float lo, float hi) { const f32x2_t v = {lo, hi}; const bf16x2_t r = __builtin_convertvector(v, bf16x2_t); return __builtin_bit_cast(unsigned, r); }
__device__ __forceinline__ u32x4 pack8(const f32x4 a, const f32x4 b) { u32x4 w; w.x = cvt_pk_bf16(a[0], a[1]); w.y = cvt_pk_bf16(a[2], a[3]); w.z = cvt_pk_bf16(b[0], b[1]); w.w = cvt_pk_bf16(b[2], b[3]); return w; }
__device__ __forceinline__ float bf_lo(unsigned w) { return __uint_as_float(w << 16); }
__device__ __forceinline__ float bf_hi(unsigned w) { return __uint_as_float(w & 0xffff0000u); }
__device__ __forceinline__ float dot4(const f32x4 a) { return (a[0] * a[0] + a[1] * a[1]) + (a[2] * a[2] + a[3] * a[3]); }
__device__ __forceinline__ float xsum_fq(float v) {
    { const auto a = __builtin_amdgcn_permlane16_swap(__float_as_uint(v), __float_as_uint(v), false, false); v = __uint_as_float(a[0]) + __uint_as_float(a[1]); }
    { const auto b = __builtin_amdgcn_permlane32_swap(__float_as_uint(v), __float_as_uint(v), false, false); v = __uint_as_float(b[0]) + __uint_as_float(b[1]); }
    return v;
}
__device__ __forceinline__ float row_rstd(const float* rs, int row, int fq) {
    const f32x4* p = (const f32x4*)(rs + (size_t)row * 32 + fq * 8); const f32x4 a = p[0], b = p[1];
    float s = ((a[0] + a[1]) + (a[2] + a[3])) + ((b[0] + b[1]) + (b[2] + b[3]));
    s = xsum_fq(s);
    return rsqrtf(s * (1.0f / D) + EPS);
}
__device__ __forceinline__ float silu_f(float g) { return g * __builtin_amdgcn_rcpf(1.0f + __builtin_amdgcn_exp2f(-LOG2E * g)); }
__device__ __forceinline__ float sigm_f(float g) { return __builtin_amdgcn_rcpf(1.0f + __builtin_amdgcn_exp2f(-LOG2E * g)); }

struct EpiSwiGLU { static constexpr bool PERM = true, AFTER_DRAIN = false;
    bf16_t* act; const float* rs;
    __device__ __forceinline__ void operator()(const f32x4 (&acc)[2][2][4][2], const Unit& u, int wr, int wc, int fr, int fq) const {
        { int ln_ = lane_id_fresh(); asm volatile("" : "+v"(ln_)); fr = ln_ & 15; fq = ln_ >> 4; }
        const int row0 = u.pm * BM + wr * 64 + fr, col0 = u.pn * HALF + wc * 32 + 8 * fq;
#pragma unroll
        for (int ai = 0; ai < 2; ++ai)
#pragma unroll
            for (int m = 0; m < 4; ++m) { const int row = row0 + ai * HALF + m * 16; const float r = row_rstd(rs, row, fq);
                f32x4 y[2];
#pragma unroll
                for (int n = 0; n < 2; ++n) { const f32x4 g = acc[ai][0][m][n] * r, uu = acc[ai][1][m][n] * r;
#pragma unroll
                    for (int j = 0; j < 4; ++j) y[n][j] = silu_f(g[j]) * uu[j]; }
                *(u32x4*)(act + (size_t)row * DFF + col0) = pack8(y[0], y[1]); }
    }
};
struct EpiResid { static constexpr bool PERM = true, AFTER_DRAIN = false;
    const float* res_lo; const float* res_hi; float* R; bf16_t* xb; float* rs; float alpha;
    __device__ __forceinline__ void operator()(const f32x4 (&acc)[2][2][4][2], const Unit& u, int wr, int wc, int fr, int fq) const {
        { int ln_ = lane_id_fresh(); asm volatile("" : "+v"(ln_)); fr = ln_ & 15; fq = ln_ >> 4; }
        const int row0 = u.pm * BM + wr * 64 + fr, col0 = u.pn * BM + wc * 32 + 8 * fq;
        const float* src = (u.pm < MP / BM) ? res_lo : (res_hi - (size_t)MP * D);
#pragma unroll
        for (int ai = 0; ai < 2; ++ai)
#pragma unroll
            for (int m = 0; m < 4; ++m) { const int row = row0 + ai * HALF + m * 16; const size_t off = (size_t)row * D + col0; float ss = 0.f;
#pragma unroll
                for (int bj = 0; bj < 2; ++bj) { const f32x4 x0 = *(const f32x4*)(src + off + bj * HALF), x1 = *(const f32x4*)(src + off + bj * HALF + 4);
                    const f32x4 o0 = x0 + acc[ai][bj][m][0] * alpha, o1 = x1 + acc[ai][bj][m][1] * alpha;
                    *(f32x4*)(R + off + bj * HALF) = o0; *(f32x4*)(R + off + bj * HALF + 4) = o1;
                    *(u32x4*)(xb + off + bj * HALF) = pack8(o0, o1); ss += dot4(o0) + dot4(o1); }
                ss = xsum_fq(ss);
                if (fq == 0) rs[(size_t)row * 32 + u.pn * 4 + wc] = ss; }
    }
};
struct EpiInGate { static constexpr bool PERM = true, AFTER_DRAIN = false;
    float* inproj; bf16_t* gates; const float* rs; const float* bgate;
    __device__ __forceinline__ void operator()(const f32x4 (&acc)[2][2][4][2], const Unit& u, int wr, int wc, int fr, int fq) const {
        { int ln_ = lane_id_fresh(); asm volatile("" : "+v"(ln_)); fr = ln_ & 15; fq = ln_ >> 4; }
        const int row0 = u.pm * BM + wr * 64 + fr;
        if (u.pn < 8) { const int col0 = u.pn * BM + wc * 32 + 8 * fq;
#pragma unroll
            for (int ai = 0; ai < 2; ++ai)
#pragma unroll
                for (int m = 0; m < 4; ++m) { const int row = row0 + ai * HALF + m * 16; const float r = row_rstd(rs, row, fq); float* o = inproj + (size_t)row * D + col0;
#pragma unroll
                    for (int bj = 0; bj < 2; ++bj) { *(f32x4*)(o + bj * HALF) = acc[ai][bj][m][0] * r; *(f32x4*)(o + bj * HALF + 4) = acc[ai][bj][m][1] * r; } }
        } else { const int t = u.pn - 8, j = t >> 3, col0 = (t & 7) * BM + wc * 32 + 8 * fq; bf16_t* G = gates + (size_t)j * M * D;
            f32x4 bv[2][2];
#pragma unroll
            for (int bj = 0; bj < 2; ++bj)
#pragma unroll
                for (int n = 0; n < 2; ++n) bv[bj][n] = *(const f32x4*)(bgate + j * D + col0 + bj * HALF + 4 * n);
#pragma unroll
            for (int ai = 0; ai < 2; ++ai)
#pragma unroll
                for (int m = 0; m < 4; ++m) { const int row = row0 + ai * HALF + m * 16; const float r = row_rstd(rs, row, fq);
#pragma unroll
                    for (int bj = 0; bj < 2; ++bj) { f32x4 v0 = acc[ai][bj][m][0] * r + bv[bj][0], v1 = acc[ai][bj][m][1] * r + bv[bj][1];
#ifndef DBG_NOSIG
#pragma unroll
                        for (int q = 0; q < 4; ++q) { v0[q] = sigm_f(v0[q]); v1[q] = sigm_f(v1[q]); }
#endif

                        *(u32x4*)(G + (size_t)row * D + col0 + bj * HALF) = pack8(v0, v1); } }
        }
    }
};
struct EpiPool { static constexpr bool PERM = true, AFTER_DRAIN = false;
    const bf16_t* gp; bf16_t* merged; const float* pscale;
    __device__ __forceinline__ void operator()(const f32x4 (&acc)[2][2][4][2], const Unit& u, int wr, int wc, int fr, int fq) const {
        { int ln_ = lane_id_fresh(); asm volatile("" : "+v"(ln_)); fr = ln_ & 15; fq = ln_ >> 4; }
        const int row0 = u.pm * BM + wr * 64 + fr, col0 = u.pn * BM + wc * 32 + 8 * fq;
        f32x4 ps[2][2];
#pragma unroll
        for (int bj = 0; bj < 2; ++bj)
#pragma unroll
            for (int n = 0; n < 2; ++n) ps[bj][n] = *(const f32x4*)(pscale + col0 + bj * HALF + 4 * n);
#pragma unroll
        for (int ai = 0; ai < 2; ++ai)
#pragma unroll
            for (int m = 0; m < 4; ++m) { const size_t off = (size_t)(row0 + ai * HALF + m * 16) * D + col0;
#pragma unroll
                for (int bj = 0; bj < 2; ++bj) { const u32x4 g = *(const u32x4*)(gp + off + bj * HALF);
                    f32x4 g0 = {bf_lo(g.x), bf_hi(g.x), bf_lo(g.y), bf_hi(g.y)}, g1 = {bf_lo(g.z), bf_hi(g.z), bf_lo(g.w), bf_hi(g.w)};
#ifdef DBG_NOGATE
                    g0 = (f32x4){1.f, 1.f, 1.f, 1.f}; g1 = g0;
#endif
                    *(u32x4*)(merged + off + bj * HALF) = pack8(acc[ai][bj][m][0] * ps[bj][0] * g0, acc[ai][bj][m][1] * ps[bj][1] * g1); } }
    }
};
struct EpiStore { static constexpr bool PERM = true, AFTER_DRAIN = false;
    bf16_t* O; int ldc;
    __device__ __forceinline__ void operator()(const f32x4 (&acc)[2][2][4][2], const Unit& u, int wr, int wc, int fr, int fq) const {
        { int ln_ = lane_id_fresh(); asm volatile("" : "+v"(ln_)); fr = ln_ & 15; fq = ln_ >> 4; }
        const int row0 = u.pm * BM + wr * 64 + fr, col0 = u.pn * BM + wc * 32 + 8 * fq;
#pragma unroll
        for (int ai = 0; ai < 2; ++ai)
#pragma unroll
            for (int m = 0; m < 4; ++m) { bf16_t* o = O + (size_t)(row0 + ai * HALF + m * 16) * ldc + col0;
#pragma unroll
                for (int bj = 0; bj < 2; ++bj) *(u32x4*)(o + bj * HALF) = pack8(acc[ai][bj][m][0], acc[ai][bj][m][1]); }
    }
};
struct EpiStoreF32 { static constexpr bool PERM = true, AFTER_DRAIN = false;
    float* O; int ldc;
    __device__ __forceinline__ void operator()(const f32x4 (&acc)[2][2][4][2], const Unit& u, int wr, int wc, int fr, int fq) const {
        { int ln_ = lane_id_fresh(); asm volatile("" : "+v"(ln_)); fr = ln_ & 15; fq = ln_ >> 4; }
        const int row0 = u.pm * BM + wr * 64 + fr, col0 = u.pn * BM + wc * 32 + 8 * fq;
#pragma unroll
        for (int ai = 0; ai < 2; ++ai)
#pragma unroll
            for (int m = 0; m < 4; ++m) { float* o = O + (size_t)(row0 + ai * HALF + m * 16) * ldc + col0;
#pragma unroll
                for (int bj = 0; bj < 2; ++bj) { *(f32x4*)(o + bj * HALF) = acc[ai][bj][m][0]; *(f32x4*)(o + bj * HALF + 4) = acc[ai][bj][m][1]; } }
    }
};
struct EpiKV { static constexpr bool PERM = true, AFTER_DRAIN = false;
    bf16_t *K0, *V0, *K1, *V1; int split; const float* knorm; PG8_LAS float* P;
    __device__ __forceinline__ void operator()(const f32x4 (&acc)[2][2][4][2], const Unit& u, int wr, int wc, int fr, int fq) const {
        { int ln_ = lane_id_fresh(); asm volatile("" : "+v"(ln_)); fr = ln_ & 15; fq = ln_ >> 4; }
        const int grow = u.pm * BM; const bool second = grow >= split; const int orow0 = (second ? grow - split : grow) + wr * 64 + fr;
        bf16_t* Kd = second ? K1 : K0; bf16_t* Vd = second ? V1 : V0;
        if (u.pn >= 8) { const int col0 = (u.pn - 8) * BM + wc * 32 + 8 * fq;
#pragma unroll
            for (int ai = 0; ai < 2; ++ai)
#pragma unroll
                for (int m = 0; m < 4; ++m) { bf16_t* o = Vd + (size_t)(orow0 + ai * HALF + m * 16) * D + col0;
#pragma unroll
                    for (int bj = 0; bj < 2; ++bj) *(u32x4*)(o + bj * HALF) = pack8(acc[ai][bj][m][0], acc[ai][bj][m][1]); }
        } else { const int col0 = u.pn * BM + wc * 32 + 8 * fq, rt0 = wr * 64 + fr;
#pragma unroll
            for (int ai = 0; ai < 2; ++ai)
#pragma unroll
                for (int m = 0; m < 4; ++m)
#pragma unroll
                    for (int bj = 0; bj < 2; ++bj) { float ss = dot4(acc[ai][bj][m][0]) + dot4(acc[ai][bj][m][1]); ss = xsum_fq(ss);
                        if (fq == 0) P[((rt0 + ai * HALF + m * 16) * 2 + bj) * 4 + wc] = ss; }
            asm volatile("s_waitcnt lgkmcnt(0)" ::: "memory"); __builtin_amdgcn_s_barrier(); asm volatile("" ::: "memory");
            const f32x4 g0 = *(const f32x4*)(knorm + wc * 32 + 8 * fq), g1 = *(const f32x4*)(knorm + wc * 32 + 8 * fq + 4);
#pragma unroll
            for (int ai = 0; ai < 2; ++ai)
#pragma unroll
                for (int m = 0; m < 4; ++m) { bf16_t* o = Kd + (size_t)(orow0 + ai * HALF + m * 16) * D + col0;
#pragma unroll
                    for (int bj = 0; bj < 2; ++bj) { const f32x4 p4 = *(const PG8_LAS f32x4*)(P + ((rt0 + ai * HALF + m * 16) * 2 + bj) * 4);
                        const float r = rsqrtf(((p4[0] + p4[1]) + (p4[2] + p4[3])) * (1.0f / HD) + EPS);
                        *(u32x4*)(o + bj * HALF) = pack8(acc[ai][bj][m][0] * r * g0, acc[ai][bj][m][1] * r * g1); }
                    asm volatile("" ::: "memory"); }
        }
    }
};

template <class Epi, class Sched, bool ALIGN_EPI = false, bool SP2 = false>
__device__ __forceinline__ void gemm_phase(PG8_LAS unsigned char* lds, const Gemm g, const Sched& S, const Epi& E, const int wv  ) {
    int tid_ = wv * 64 + lane_id_fresh(); asm volatile("" : "+v"(tid_));
    const int tid = tid_, wid = __builtin_amdgcn_readfirstlane(tid >> 6), lane = tid & 63, wr = wid >> 2, wc = wid & 3, fr = lane & 15, fq = lane >> 4;
    const int K = g.K, nt = K / BK;
    unsigned voffA[2], voffB[2];
#pragma unroll
    for (int i = 0; i < 2; ++i) { int R, C; stage_rc(tid * 16 + i * 8192, R, C); const int Rb = Epi::PERM ? ((R & ~31) + perm32(R & 31)) : R;
        voffA[i] = (unsigned)(R * K + C) * 2u; voffB[i] = (unsigned)(Rb * K + C) * 2u; }
    const size_t kstep = (size_t)(BK * 2);
    const size_t hstep = (size_t)HALF * K * 2;
    const size_t tstep = 2 * hstep;
    const unsigned ldsw = (unsigned)wid * 1024u;
    const int aoff = lds_byte(wr * 64 + fr, fq * 8), boff = lds_byte(wc * 32 + fr, fq * 8);
#define PG8_SA(b, h) (((b) * 2 + (h)) * HTB)
#define PG8_SB(b, h) ((4 + (b) * 2 + (h)) * HTB)
#define PG8_STAGE(bufoff, gbase, voff) do { _Pragma("unroll") for (int _i = 0; _i < 2; ++_i) \
        __builtin_amdgcn_global_load_lds((const unsigned*)((const char*)(gbase) + (voff)[_i]), (PG8_LAS unsigned*)(lds + (bufoff) + ldsw + _i * 8192), 16, 0, 0); } while (0)
#define PG8_LDA(dst, b, h) do { _Pragma("unroll") for (int m = 0; m < 4; ++m) _Pragma("unroll") for (int k = 0; k < 2; ++k) dst[m][k] = *(const PG8_LAS bf16x8*)(lds + PG8_SA(b, h) + aoff + m * 2048 + k * 1024); } while (0)
#define PG8_LDB(dst, b, h) do { _Pragma("unroll") for (int n = 0; n < 2; ++n) _Pragma("unroll") for (int k = 0; k < 2; ++k) dst[n][k] = *(const PG8_LAS bf16x8*)(lds + PG8_SB(b, h) + boff + n * 2048 + k * 1024); } while (0)
#define PG8_MMA(ai, bj, At, Bt) do { __builtin_amdgcn_s_setprio(1); _Pragma("unroll") for (int m = 0; m < 4; ++m) _Pragma("unroll") for (int n = 0; n < 2; ++n) _Pragma("unroll") for (int k = 0; k < 2; ++k) \
        acc[ai][bj][m][n] = __builtin_amdgcn_mfma_f32_16x16x32_bf16(Bt[n][k], At[m][k], acc[ai][bj][m][n], 0, 0, 0); __builtin_amdgcn_s_setprio(0); } while (0)
#define PG8_WAIT_V(n) asm volatile("s_waitcnt vmcnt(" #n ")" ::: "memory")
#define PG8_WAIT_L(n) asm volatile("s_waitcnt lgkmcnt(" #n ")" ::: "memory")
#define PG8_BAR __builtin_amdgcn_s_barrier()
#define PG8_SCHED __builtin_amdgcn_sched_barrier(0)
    Unit cur, nxt; int ui = 0;
    if (!S.next(0, cur)) return;
    f32x4 acc[2][2][4][2];
#pragma unroll
    for (int a = 0; a < 2; ++a)
#pragma unroll
        for (int b = 0; b < 2; ++b)
#pragma unroll
            for (int m = 0; m < 4; ++m)
#pragma unroll
                for (int n = 0; n < 2; ++n) acc[a][b][m][n] = (f32x4){0.f, 0.f, 0.f, 0.f};
    bf16x8 At[4][2], B0[2][2], B1[2][2];
    const char* cA = (const char*)g.A + (size_t)cur.pm * tstep; const char* cB = (const char*)g.Bt + (size_t)cur.pn * tstep;
    S.a_ready(cur);
    if constexpr (SP2) {
        PG8_STAGE(PG8_SB(0, 0), cB, voffB); PG8_STAGE(PG8_SB(0, 1), cB + hstep, voffB); PG8_STAGE(PG8_SA(0, 0), cA, voffA); PG8_STAGE(PG8_SA(0, 1), cA + hstep, voffA);
        if (wr == 1) PG8_BAR;
        PG8_WAIT_V(2); PG8_BAR;
        PG8_STAGE(PG8_SB(1, 0), cB + kstep, voffB); PG8_STAGE(PG8_SA(1, 0), cA + kstep, voffA); PG8_STAGE(PG8_SB(1, 1), cB + hstep + kstep, voffB);
        PG8_WAIT_V(6); PG8_BAR;
    } else {
        PG8_STAGE(PG8_SB(0, 0), cB, voffB); PG8_STAGE(PG8_SA(0, 0), cA, voffA); PG8_STAGE(PG8_SB(0, 1), cB + hstep, voffB); PG8_STAGE(PG8_SA(0, 1), cA + hstep, voffA);
        if (wr == 1) PG8_BAR;
        PG8_WAIT_V(4); PG8_BAR;
        PG8_STAGE(PG8_SB(1, 0), cB + kstep, voffB); PG8_STAGE(PG8_SA(1, 0), cA + kstep, voffA); PG8_STAGE(PG8_SB(1, 1), cB + hstep + kstep, voffB);
        PG8_WAIT_V(6); PG8_BAR;
    }
    for (;;) {
        const bool has_next = S.next(ui + 1, nxt);
        const char* nA = has_next ? (const char*)g.A + (size_t)nxt.pm * tstep : cA; const char* nB = has_next ? (const char*)g.Bt + (size_t)nxt.pn * tstep : cB;
        for (int t = 0; t < nt; t += 2) {
            const bool last = (t == nt - 2);
            const char* a1 = cA + (size_t)(t + 1) * kstep;
            const char* a2 = last ? nA : cA + (size_t)(t + 2) * kstep; const char* b2 = last ? nB : cB + (size_t)(t + 2) * kstep;
            const char* a3 = a2 + kstep; const char* b3 = b2 + kstep;
            if (last && has_next) S.a_ready(nxt);
            if constexpr (SP2) {
            PG8_LDB(B0, 0, 0); PG8_LDB(B1, 0, 1); PG8_SCHED; PG8_LDA(At, 0, 0); PG8_STAGE(PG8_SA(1, 1), a1 + hstep, voffA);
            PG8_WAIT_V(8); PG8_WAIT_L(0); PG8_BAR; PG8_MMA(0, 0, At, B0); PG8_MMA(0, 1, At, B1); PG8_BAR; PG8_SCHED;
            PG8_LDA(At, 0, 1); PG8_STAGE(PG8_SB(0, 0), b2, voffB); PG8_STAGE(PG8_SB(0, 1), b2 + hstep, voffB); PG8_STAGE(PG8_SA(0, 0), a2, voffA);
            PG8_WAIT_V(8); PG8_WAIT_L(0); PG8_BAR; PG8_MMA(1, 0, At, B0); PG8_MMA(1, 1, At, B1); PG8_BAR; PG8_SCHED;
            PG8_LDB(B0, 1, 0); PG8_LDB(B1, 1, 1); PG8_SCHED; PG8_LDA(At, 1, 0); PG8_STAGE(PG8_SA(0, 1), a2 + hstep, voffA);
            PG8_WAIT_V(8); PG8_WAIT_L(0); PG8_BAR; PG8_MMA(0, 0, At, B0); PG8_MMA(0, 1, At, B1); PG8_BAR; PG8_SCHED;
            PG8_LDA(At, 1, 1); PG8_STAGE(PG8_SB(1, 0), b3, voffB); PG8_STAGE(PG8_SB(1, 1), b3 + hstep, voffB); PG8_STAGE(PG8_SA(1, 0), a3, voffA);
            PG8_WAIT_V(8); PG8_WAIT_L(0); PG8_BAR; PG8_MMA(1, 0, At, B0); PG8_MMA(1, 1, At, B1); PG8_BAR; PG8_SCHED;
            } else {
            PG8_LDB(B0, 0, 0); PG8_SCHED; PG8_LDA(At, 0, 0); PG8_STAGE(PG8_SA(1, 1), a1 + hstep, voffA);
            PG8_WAIT_L(8); PG8_BAR; PG8_WAIT_L(0); PG8_MMA(0, 0, At, B0); PG8_BAR; PG8_SCHED;
            PG8_LDB(B1, 0, 1); PG8_STAGE(PG8_SB(0, 0), b2, voffB);
            PG8_BAR; PG8_WAIT_L(0); PG8_MMA(0, 1, At, B1); PG8_BAR;
            PG8_LDA(At, 0, 1); PG8_STAGE(PG8_SA(0, 0), a2, voffA);
            PG8_BAR; PG8_WAIT_L(0); PG8_MMA(1, 0, At, B0); PG8_BAR; PG8_SCHED;
            PG8_STAGE(PG8_SB(0, 1), b2 + hstep, voffB);
            PG8_WAIT_V(6); PG8_BAR; PG8_MMA(1, 1, At, B1); PG8_BAR;
            PG8_LDB(B0, 1, 0); PG8_SCHED; PG8_LDA(At, 1, 0); PG8_STAGE(PG8_SA(0, 1), a2 + hstep, voffA);
            PG8_WAIT_L(8); PG8_BAR; PG8_WAIT_L(0); PG8_MMA(0, 0, At, B0); PG8_BAR; PG8_SCHED;
            PG8_LDB(B1, 1, 1); PG8_STAGE(PG8_SB(1, 0), b3, voffB);
            PG8_BAR; PG8_WAIT_L(0); PG8_MMA(0, 1, At, B1); PG8_BAR;
            PG8_LDA(At, 1, 1); PG8_STAGE(PG8_SA(1, 0), a3, voffA);
            PG8_BAR; PG8_WAIT_L(0); PG8_MMA(1, 0, At, B0); PG8_BAR; PG8_SCHED;
            PG8_STAGE(PG8_SB(1, 1), b3 + hstep, voffB);
            PG8_WAIT_V(6); PG8_BAR; PG8_MMA(1, 1, At, B1); PG8_BAR;
            }
        }
        if constexpr (ALIGN_EPI) { if (wr == 0) PG8_BAR; }
        if constexpr (!Epi::AFTER_DRAIN) { E(acc, cur, wr, wc, fr, fq); S.done(cur); }
        if (!has_next) break;
#pragma unroll
        for (int a = 0; a < 2; ++a)
#pragma unroll
            for (int b = 0; b < 2; ++b)
#pragma unroll
                for (int m = 0; m < 4; ++m)
#pragma unroll
                    for (int n = 0; n < 2; ++n) acc[a][b][m][n] = (f32x4){0.f, 0.f, 0.f, 0.f};
        cur = nxt; cA = nA; cB = nB; ++ui;
        if constexpr (ALIGN_EPI) { if (wr == 1) PG8_BAR; }
    }
    PG8_WAIT_V(0);
    if constexpr (!ALIGN_EPI) { if (wr == 0) PG8_BAR; }
    PG8_BAR;
    if constexpr (Epi::AFTER_DRAIN) { E.fused(acc, cur, wr, wc, fr, fq, lds, wid, lane); S.done(cur); }
#undef PG8_SA
#undef PG8_SB
#undef PG8_STAGE
#undef PG8_LDA
#undef PG8_LDB
#undef PG8_MMA
#undef PG8_WAIT_V
#undef PG8_WAIT_L
#undef PG8_BAR
#undef PG8_SCHED
}
}

#ifndef ATT_SD_MEM
#define ATT_SD_MEM 1
#endif
#ifndef ATT_SD_MAIN
#define ATT_SD_MAIN 1
#endif
namespace att {
typedef unsigned short bf16_t;
using bf16x8 = __attribute__((ext_vector_type(8))) short;
using s16x4  = __attribute__((ext_vector_type(4))) short;
using f32x16 = __attribute__((ext_vector_type(16))) float;
using f32x4  = __attribute__((ext_vector_type(4))) float;
using u32x4  = __attribute__((ext_vector_type(4))) unsigned;
constexpr int KVBLK = 64;
constexpr float THR = 8.f;
#define ATT_SBAR() __builtin_amdgcn_sched_barrier(0)
__device__ __forceinline__ int crow(int r, int hi) { return (r & 3) + 8 * (r >> 2) + 4 * hi; }
__device__ __forceinline__ unsigned cvtpk(float lo, float hi) { return pg8::cvt_pk_bf16(lo, hi); }
__device__ __forceinline__ float bflo(unsigned w) { return __uint_as_float(w << 16); }
__device__ __forceinline__ float bfhi(unsigned w) { return __uint_as_float(w & 0xffff0000u); }
template <int DQK> __device__ __forceinline__ int kswz(int row, int cb) { if constexpr (DQK == 128) return row * 256 + (cb ^ ((row & 7) << 4)); else return row * 384 + (cb ^ (((row >> 1) & 7) << 4)); }
__device__ __forceinline__ int v_st(int k, int c) { const int kk = (k & ~0xC) | ((k & 4) << 1) | ((k & 8) >> 1); return ((kk >> 3) * 4 + (c >> 5)) * 512 + ((kk & 7) * 32 + (c & 31)) * 2; }
__device__ __forceinline__ int v_rd_base(int lane) { return ((lane & 3) << 3) | (((lane >> 2) & 3) << 6) | (((lane >> 4) & 1) << 5) | (((lane >> 5) & 1) << 8); }
constexpr int v_rd_off(int d0, int ks, int half) { return d0 * 512 + ks * 4096 + half * 2048; }
template <int OFF> __device__ __forceinline__ s16x4 tr_read(int vb) { s16x4 r; asm volatile("ds_read_b64_tr_b16 %0, %1 offset:%2" : "=&v"(r) : "v"(vb), "i"(OFF) : "memory"); return r; }
template <int D0> __device__ __forceinline__ void pv_one(f32x16& od, int vb, bf16x8 pa0, bf16x8 pa1, bf16x8 pa2, bf16x8 pa3) {
  const s16x4 l0 = tr_read<v_rd_off(D0, 0, 0)>(vb), h0 = tr_read<v_rd_off(D0, 0, 1)>(vb), l1 = tr_read<v_rd_off(D0, 1, 0)>(vb), h1 = tr_read<v_rd_off(D0, 1, 1)>(vb);
  const s16x4 l2 = tr_read<v_rd_off(D0, 2, 0)>(vb), h2 = tr_read<v_rd_off(D0, 2, 1)>(vb), l3 = tr_read<v_rd_off(D0, 3, 0)>(vb), h3 = tr_read<v_rd_off(D0, 3, 1)>(vb);
  asm volatile("s_waitcnt lgkmcnt(0)" ::: "memory"); ATT_SBAR();
#define ATT_PK(L, H) (bf16x8){L[0], L[1], L[2], L[3], H[0], H[1], H[2], H[3]}
  od = __builtin_amdgcn_mfma_f32_32x32x16_bf16(pa0, ATT_PK(l0, h0), od, 0, 0, 0);
  od = __builtin_amdgcn_mfma_f32_32x32x16_bf16(pa1, ATT_PK(l1, h1), od, 0, 0, 0);
  od = __builtin_amdgcn_mfma_f32_32x32x16_bf16(pa2, ATT_PK(l2, h2), od, 0, 0, 0);
  od = __builtin_amdgcn_mfma_f32_32x32x16_bf16(pa3, ATT_PK(l3, h3), od, 0, 0, 0);
#undef ATT_PK
}
__device__ __forceinline__ void pv_d0(f32x16* o, int vb, bf16x8 pa0, bf16x8 pa1, bf16x8 pa2, bf16x8 pa3) {
  pv_one<0>(o[0], vb, pa0, pa1, pa2, pa3); pv_one<1>(o[1], vb, pa0, pa1, pa2, pa3); pv_one<2>(o[2], vb, pa0, pa1, pa2, pa3); pv_one<3>(o[3], vb, pa0, pa1, pa2, pa3);
}
__device__ __forceinline__ void partialSM(f32x16& p0, f32x16& p1, float& m_reg, float& mn, float& alpha, const float C, const bool masked) {
  if (masked) {
#pragma unroll
    for (int r = 0; r < 16; ++r) { p0[r] = -__builtin_inff(); p1[r] = -__builtin_inff(); } }
  float pmax = p0[0];
#pragma unroll
  for (int r = 1; r < 16; ++r) pmax = fmaxf(pmax, p0[r]);
#pragma unroll
  for (int r = 0; r < 16; ++r) pmax = fmaxf(pmax, p1[r]);
  { auto rr = __builtin_amdgcn_permlane32_swap(__float_as_uint(pmax), __float_as_uint(pmax), false, false);
    pmax = fmaxf(__uint_as_float(rr[0]), __uint_as_float(rr[1])); }
  if (__builtin_expect(__all((pmax - m_reg) * C <= THR * LOG2E), 1)) { mn = m_reg; alpha = 1.f; }
  else { mn = fmaxf(m_reg, pmax); alpha = __builtin_amdgcn_exp2f((m_reg - mn) * C); m_reg = mn; }
  const float mnC = -mn * C;
#pragma unroll
  for (int r = 0; r < 16; ++r) p0[r] = fmaf(p0[r], C, mnC);
#pragma unroll
  for (int r = 0; r < 16; ++r) p1[r] = fmaf(p1[r], C, mnC);
#pragma unroll
  for (int r = 0; r < 16; ++r) p0[r] = __builtin_amdgcn_exp2f(p0[r]);
}
__device__ __forceinline__ void finishSM(f32x16& p0, f32x16& p1, float alpha, float& l_reg, bf16x8& pa0, bf16x8& pa1, bf16x8& pa2, bf16x8& pa3) {
#pragma unroll
  for (int r = 0; r < 16; ++r) p1[r] = __builtin_amdgcn_exp2f(p1[r]);
  float ps = 0;
#pragma unroll
  for (int r = 0; r < 16; ++r) ps += p0[r];
#pragma unroll
  for (int r = 0; r < 16; ++r) ps += p1[r];
  { auto rr = __builtin_amdgcn_permlane32_swap(__float_as_uint(ps), __float_as_uint(ps), false, false);
    ps = __uint_as_float(rr[0]) + __uint_as_float(rr[1]); }
  l_reg = l_reg * alpha + ps;
#define ATT_PK4(P, BASE, OUT) do { unsigned a0 = cvtpk(P[BASE + 0], P[BASE + 1]), a1 = cvtpk(P[BASE + 2], P[BASE + 3]);   \
    unsigned b0 = cvtpk(P[BASE + 4], P[BASE + 5]), b1 = cvtpk(P[BASE + 6], P[BASE + 7]);                              \
    auto r0 = __builtin_amdgcn_permlane32_swap(a0, b0, false, false); auto r1 = __builtin_amdgcn_permlane32_swap(a1, b1, false, false); \
    u32x4 w = {r0[0], r1[0], r0[1], r1[1]}; OUT = *reinterpret_cast<bf16x8*>(&w); } while (0)
  ATT_PK4(p0, 0, pa0); ATT_PK4(p0, 8, pa1); ATT_PK4(p1, 0, pa2); ATT_PK4(p1, 8, pa3);
#undef ATT_PK4
}
template <int DQK, int BUFOFF> __device__ __forceinline__ void qkt(f32x16& p0, f32x16& p1, const int (&kb)[4], const bf16x8* qr, const int qrb) {
  typedef const __attribute__((address_space(3))) bf16x8* lp;
  constexpr int ROWB = DQK * 2;
  p0 = f32x16{}; p1 = f32x16{};
#pragma unroll
  for (int d0 = 0; d0 < DQK / 16; ++d0) {
    const bf16x8 b0 = *(lp)(kb[d0 & 3] + (d0 >> 2) * 128 + BUFOFF);
    const bf16x8 b1 = *(lp)(kb[d0 & 3] + (d0 >> 2) * 128 + BUFOFF + 32 * ROWB);
    const bf16x8 q = d0 < 8 ? qr[d0 < 8 ? d0 : 0] : *(lp)(qrb + (d0 - 8) * 1024);
    p0 = __builtin_amdgcn_mfma_f32_32x32x16_bf16(b0, q, p0, 0, 0, 0);
    p1 = __builtin_amdgcn_mfma_f32_32x32x16_bf16(b1, q, p1, 0, 0, 0); }
}
template <int DQK, int SDEPTH, int ldk, int ldv>
__device__ __forceinline__ void attn_item(const bf16x8* qr, const bf16_t* __restrict__ Kn, const bf16_t* __restrict__ Kr, const bf16_t* __restrict__ Vh,
                                          int NT, int NTR, int tlim, float C, char* lds, f32x16* o, float& l_out, const int wv) {
  constexpr int SHM_V = KVBLK * 128 * 2, SHM_K = KVBLK * DQK * 2;
  int tid_ = wv * 64 + lane_id_fresh(); asm volatile("" : "+v"(tid_));
  const int tid = tid_, wid = tid >> 6, lane = tid & 63, r32 = lane & 31, hi = lane >> 5;
  char* V_lds = lds; char* K_lds = lds + 2 * SHM_V;
  float* ws = (float*)(lds + 2 * SHM_V + 2 * SHM_K) + wid * 64; float* al_l = ws + 32;
  float m_reg = -1e30f, l_reg = 0;
  const int sr = tid >> 4, sc = (tid & 15) * 8, vst0 = v_st(sr, sc), vst1 = v_st(32 + sr, sc);
  const int kst0 = kswz<DQK>(sr, sc * 2), kst1 = kswz<DQK>(32 + sr, sc * 2);
  const int rr_ = tid >> 3, rc_ = (tid & 7) * 8, kst2 = kswz<DQK>(rr_, 256 + rc_ * 2);
  const int vb0 = (int)(uintptr_t)V_lds + v_rd_base(lane);
  int kb[4];
#pragma unroll
  for (int q = 0; q < 4; ++q) { kb[q] = (int)(uintptr_t)K_lds + kswz<DQK>(r32, q * 32 + hi * 16); asm volatile("" : "+v"(kb[q])); }
  int qrb = (int)(uintptr_t)lds + 2 * SHM_V + 2 * SHM_K + 2048 + wid * 4096 + lane * 16; asm volatile("" : "+v"(qrb));
  struct { bf16x8 vs0, vs1, ks0, ks1, kr; } sr_[SDEPTH];
  const unsigned voV = (unsigned)(sr * ldv + sc) * 2u, voK = (unsigned)(sr * ldk + sc) * 2u, voR = (unsigned)(rr_ * 64 + rc_) * 2u;
#define ATT_SLOAD(i, t) do { const int k0_ = ((t) < NTR ? (t) : NTR - 1) * KVBLK; \
    const char* vt_ = (const char*)(Vh + (long)k0_ * ldv); const char* kt_ = (const char*)(Kn + (long)k0_ * ldk); \
    sr_[i].vs0 = *(const bf16x8*)(vt_ + voV); sr_[i].vs1 = *(const bf16x8*)(vt_ + (long)32 * ldv * 2 + voV); \
    sr_[i].ks0 = *(const bf16x8*)(kt_ + voK); sr_[i].ks1 = *(const bf16x8*)(kt_ + (long)32 * ldk * 2 + voK); \
    if constexpr (DQK == 192) sr_[i].kr = *(const bf16x8*)((const char*)(Kr + (long)k0_ * 64) + voR); } while (0)
#define ATT_SWRITE(b, i) do { *(bf16x8*)(V_lds + (b) * SHM_V + vst0) = sr_[i].vs0; *(bf16x8*)(V_lds + (b) * SHM_V + vst1) = sr_[i].vs1; \
    *(bf16x8*)(K_lds + (b) * SHM_K + kst0) = sr_[i].ks0; *(bf16x8*)(K_lds + (b) * SHM_K + kst1) = sr_[i].ks1; \
    if constexpr (DQK == 192) *(bf16x8*)(K_lds + (b) * SHM_K + kst2) = sr_[i].kr; } while (0)
#define ATT_SWAIT() do { if constexpr (SDEPTH == 1) asm volatile("s_waitcnt vmcnt(0)" ::: "memory"); else if constexpr (DQK == 192) asm volatile("s_waitcnt vmcnt(5)" ::: "memory"); else asm volatile("s_waitcnt vmcnt(4)" ::: "memory"); } while (0)
#define ATT_RESC(a) do { if (__any((a) < 1.f)) { if (hi == 0) al_l[r32] = (a); asm volatile("s_waitcnt lgkmcnt(0)" ::: "memory"); \
    _Pragma("unroll") for (int d = 0; d < 4; ++d) _Pragma("unroll") for (int r = 0; r < 16; ++r) o[d][r] *= al_l[crow(r, hi)]; } } while (0)
  f32x16 pA0, pA1, pB0, pB1; float mnA, mnB, alA, alB; bf16x8 pa0, pa1, pa2, pa3;
  constexpr int SE = 0, SO = SDEPTH - 1;
  ATT_SLOAD(SE, 0); asm volatile("s_waitcnt vmcnt(0)" ::: "memory"); ATT_SWRITE(0, SE); __syncthreads();
  qkt<DQK, 0>(pA0, pA1, kb, qr, qrb); partialSM(pA0, pA1, m_reg, mnA, alA, C, 0 >= tlim);
  ATT_SLOAD(SO, 1); if constexpr (SDEPTH == 2) { if (2 < NT) ATT_SLOAD(SE, 2); }
  ATT_SWAIT(); ATT_SWRITE(1, SO); __syncthreads();
  for (int j = 1; j + 1 < NT; j += 2) {
    ATT_SBAR(); qkt<DQK, SHM_K>(pB0, pB1, kb, qr, qrb);
    finishSM(pA0, pA1, alA, l_reg, pa0, pa1, pa2, pa3); ATT_SBAR();
    ATT_SLOAD(SO, j + SDEPTH); ATT_SBAR();
    pv_d0(o, vb0, pa0, pa1, pa2, pa3); partialSM(pB0, pB1, m_reg, mnB, alB, C, j >= tlim);
    __syncthreads(); ATT_SWAIT(); ATT_SWRITE(0, SE);
    ATT_RESC(alB); __syncthreads();
    ATT_SBAR(); qkt<DQK, 0>(pA0, pA1, kb, qr, qrb);
    finishSM(pB0, pB1, alB, l_reg, pa0, pa1, pa2, pa3); ATT_SBAR();
    if (SDEPTH == 1 || j + 3 < NT) ATT_SLOAD(SE, j + 1 + SDEPTH); ATT_SBAR();
    pv_d0(o, vb0 + SHM_V, pa0, pa1, pa2, pa3); partialSM(pA0, pA1, m_reg, mnA, alA, C, j + 1 >= tlim);
    __syncthreads(); ATT_SWAIT(); ATT_SWRITE(1, SO);
    ATT_RESC(alA); __syncthreads();
  }
  ATT_SBAR(); qkt<DQK, SHM_K>(pB0, pB1, kb, qr, qrb);
  finishSM(pA0, pA1, alA, l_reg, pa0, pa1, pa2, pa3); ATT_SBAR();
  pv_d0(o, vb0, pa0, pa1, pa2, pa3); partialSM(pB0, pB1, m_reg, mnB, alB, C, NT - 1 >= tlim);
  __syncthreads(); ATT_RESC(alB);
  finishSM(pB0, pB1, alB, l_reg, pa0, pa1, pa2, pa3); ATT_SBAR();
  pv_d0(o, vb0 + SHM_V, pa0, pa1, pa2, pa3);
  l_out = l_reg;
#undef ATT_SLOAD
#undef ATT_SWRITE
#undef ATT_SWAIT
#undef ATT_RESC
}
}

constexpr size_t WS_CTL = 0, CTL_BYTES = 1u << 20;
constexpr size_t WS_ROPE = WS_CTL + CTL_BYTES;
constexpr size_t WS_RS = WS_ROPE + (size_t)MP * 32 * 8;
constexpr size_t WS_W1A = WS_RS + (size_t)M * 32 * 4;
constexpr size_t WS_W1D = WS_W1A + (size_t)2 * DFF * D * 2;
constexpr size_t WS_WIG = WS_W1D + (size_t)D * DFF * 2;
constexpr size_t WS_WUQ = WS_WIG + (size_t)8192 * D * 2;
constexpr size_t WS_WKV = WS_WUQ + (size_t)3072 * QL * 2;
constexpr size_t WS_WPL = WS_WKV + (size_t)4096 * KVL * 2;
constexpr size_t WS_WMK = WS_WPL + (size_t)D * PWD * 2;
constexpr size_t WS_WO = WS_WMK + (size_t)2560 * D * 2;
constexpr size_t WS_W2A = WS_WO + (size_t)D * D * 2;
constexpr size_t WS_W2D = WS_W2A + (size_t)2 * DFF * D * 2;
constexpr size_t WS_XB = WS_W2D + (size_t)D * DFF * 2;
constexpr size_t WS_MB = WS_XB + (size_t)M * D * 2;
constexpr size_t WS_MKVRAW = WS_MB + (size_t)NMEM * D * 2;
constexpr size_t WS_MEMKP = WS_MKVRAW + (size_t)NMEM * 2560 * 4;
constexpr size_t WS_MEMVP = WS_MEMKP + (size_t)NMEM * 512 * 2;
constexpr size_t WS_MEMKS = WS_MEMVP + (size_t)NMEM * D * 2;
constexpr size_t WS_MEMVS = WS_MEMKS + (size_t)DB * NMEM * 512 * 2;
constexpr size_t WS_KRP = WS_MEMVS + (size_t)DB * NMEM * D * 2;
constexpr size_t WS_KRS = WS_KRP + (size_t)MP * RD * 2;
constexpr size_t WS_QRAW = WS_KRS + (size_t)DB * SKS * RD * 2;
constexpr size_t WS_CKV = WS_QRAW + (size_t)M * 3072 * 2;
constexpr size_t WS_MERGED = WS_CKV + (size_t)SALL * KVL * 2;
constexpr size_t WS_CQ = WS_MERGED + (size_t)M * D * 2;
constexpr size_t WS_POOLED = WS_CQ + (size_t)M * QL * 2;
constexpr size_t WS_QM = WS_POOLED + (size_t)M * PWD * 2;
constexpr size_t WS_GA = WS_QM + (size_t)M * MQD * 2;
constexpr size_t WS_BIG = WS_GA + (size_t)M * D * 2;
constexpr size_t WS_GP = WS_BIG, WS_GM = WS_GP + (size_t)M * D * 2, WS_INPROJ = WS_GM + (size_t)M * D * 2, WS_EARLY_END = WS_INPROJ + (size_t)M * D * 4;
constexpr size_t WS_KP = WS_BIG, WS_VP = WS_KP + (size_t)MP * D * 2, WS_KS = WS_VP + (size_t)MP * D * 2, WS_VS = WS_KS + (size_t)CHROWS * D * 2, WS_LATE_END = WS_VS + (size_t)CHROWS * D * 2;
static_assert(WS_GP == WS_GA + (size_t)M * D * 2 && WS_GM == WS_GP + (size_t)M * D * 2, "gates contiguous");
constexpr size_t WS_ACT = WS_BIG, WS_ACT_END = WS_ACT + (size_t)M * DFF * 2;
constexpr size_t WS_END = WS_LATE_END > WS_EARLY_END ? (WS_LATE_END > WS_ACT_END ? WS_LATE_END : WS_ACT_END) : (WS_EARLY_END > WS_ACT_END ? WS_EARLY_END : WS_ACT_END);
constexpr int CW_BAR = 4096;
constexpr size_t O_Y = 0, O_CKVP = (size_t)M * D, O_KRP = O_CKVP + (size_t)DEPTH * MP * KVL, O_POOLP = O_KRP + (size_t)DEPTH * MP * RD, O_MKP = O_POOLP + (size_t)DEPTH * PPAD * PWD,
                 O_MVP = O_MKP + (size_t)DEPTH * NMEM * 512, O_CKVS = O_MVP + (size_t)DEPTH * NMEM * D, O_KRS = O_CKVS + (size_t)DEPTH * MS * KVL, O_POOLS = O_KRS + (size_t)DEPTH * MS * RD,
                 O_END = O_POOLS + (size_t)DEPTH * DB * PPAD * PWD;
constexpr int RING_BYTES = 131072, LDSX_OFF = RING_BYTES  , MISC_OFF = LDSX_OFF + 8192, LDS_BYTES = 147456;

#define LAS __attribute__((address_space(3)))
typedef unsigned short bf16;
typedef float f32x4 __attribute__((ext_vector_type(4)));
typedef unsigned u32x4 __attribute__((ext_vector_type(4)));
typedef unsigned u32x2 __attribute__((ext_vector_type(2)));
typedef float f32x2 __attribute__((ext_vector_type(2)));
#define LDS_WAIT() asm volatile("s_waitcnt lgkmcnt(0)" ::: "memory")
__device__ __forceinline__ unsigned pk2(float lo, float hi) { return pg8::cvt_pk_bf16(lo, hi); }
template <int CTRL> __device__ __forceinline__ float dpp_f(float v) { return __uint_as_float(__builtin_amdgcn_update_dpp(0u, __float_as_uint(v), CTRL, 0xf, 0xf, false)); }
__device__ __forceinline__ float sum16(float v) { v += dpp_f<0x128>(v); v += dpp_f<0x124>(v); v += dpp_f<0x122>(v); v += dpp_f<0x121>(v); return v; }
__device__ __forceinline__ float wave_sum(float v) { return pg8::xsum_fq(sum16(v)); }
__device__ __forceinline__ float sum_x32(float v) { const auto b = __builtin_amdgcn_permlane32_swap(__float_as_uint(v), __float_as_uint(v), false, false); return __uint_as_float(b[0]) + __uint_as_float(b[1]); }
__device__ __forceinline__ float other_x32(float v, bool upper) { const auto b = __builtin_amdgcn_permlane32_swap(__float_as_uint(v), __float_as_uint(v), false, false); return __uint_as_float(upper ? b[0] : b[1]); }

#define XB_TMO      128
#define XB_XCNT(j)  (256  + 64 * (j))
#define XB_XSUB(j)  (1280 + 64 * (j))
#define XB_XGEN(j)  (2304 + 64 * (j))
#define XB_TOP      3328
#define XB_TOPGEN   3392
#define XCD_BAR_WORDS 3456
#define XB_SPIN_CAP (1u << 22)

__device__ __forceinline__ unsigned xb_ld(unsigned* p)              { return __hip_atomic_load(p, __ATOMIC_RELAXED, __HIP_MEMORY_SCOPE_AGENT); }
__device__ __forceinline__ unsigned xb_add(unsigned* p, unsigned v) { return __hip_atomic_fetch_add(p, v, __ATOMIC_RELAXED, __HIP_MEMORY_SCOPE_AGENT); }
__device__ __forceinline__ unsigned xb_xcc_id() { return (unsigned)__builtin_amdgcn_s_getreg((3 << 11) | 20) & 0xFu; }
#define XB_SPIN(cond, bar) do { unsigned _sp = 0; while (cond) { __builtin_amdgcn_s_sleep(1); \
    if ((++_sp & 255u) == 0u) { if (xb_ld(&(bar)[XB_TMO])) break; if (_sp > XB_SPIN_CAP) { atomicAdd(&(bar)[XB_TMO], 1u); break; } } } } while (0)

struct XcdBarrier {
    unsigned* bar; unsigned x;
    volatile LAS unsigned* st;
};

__device__ __forceinline__ XcdBarrier xcd_barrier_post(unsigned* bar, volatile LAS unsigned* st) {
    XcdBarrier b; b.bar = bar; b.x = xb_xcc_id(); b.st = st;
    if (threadIdx.x == 0) (void)xb_add(&bar[XB_XCNT(b.x)], 1u);
    return b;
}
__device__ __forceinline__ void xcd_barrier_complete(unsigned* bar, unsigned x, unsigned& nloc, unsigned& nx) {
    const unsigned G = gridDim.x * gridDim.y * gridDim.z;
    unsigned sum, cnt, mine, sp = 0u;
    for (;;) {
        sum = 0u; cnt = 0u; mine = 0u;
#pragma unroll
        for (unsigned j = 0; j < 16; ++j) { const unsigned c = xb_ld(&bar[XB_XCNT(j)]); sum += c; cnt += (c > 0u) ? 1u : 0u; mine = (j == x) ? c : mine; }
        if (sum == G) break;
        __builtin_amdgcn_s_sleep(1);
        if ((++sp & 255u) == 0u) { if (xb_ld(&bar[XB_TMO])) break; if (sp > XB_SPIN_CAP) { atomicAdd(&bar[XB_TMO], 1u); break; } }
    }
    nloc = mine > 0u ? mine : 1u; nx = cnt > 0u ? cnt : 1u;
}

__device__ __forceinline__ void xcd_barrier(const XcdBarrier& b) {
    asm volatile("s_waitcnt vmcnt(0)" ::: "memory");
    __syncthreads();
    if (threadIdx.x == 0) {
        unsigned* bar = b.bar;
        __builtin_amdgcn_s_waitcnt(0);
        unsigned nloc = b.st[0], nx = b.st[1];
        if (nloc == 0u) { xcd_barrier_complete(bar, b.x, nloc, nx); b.st[0] = nloc; b.st[1] = nx; }
        const unsigned old = xb_add(&bar[XB_XSUB(b.x)], 1u);
        const unsigned gen = old / nloc;
        if (old + 1u == (gen + 1u) * nloc) {
            __builtin_amdgcn_fence(__ATOMIC_RELEASE, "agent");
            asm volatile("s_waitcnt vmcnt(0)" ::: "memory");
            const unsigned og = xb_add(&bar[XB_TOP], 1u);
            const unsigned tg = og / nx;
            if (og + 1u == (tg + 1u) * nx) xb_add(&bar[XB_TOPGEN], 1u);
            else XB_SPIN(xb_ld(&bar[XB_TOPGEN]) == tg, bar);
            __builtin_amdgcn_fence(__ATOMIC_ACQUIRE, "agent");
            xb_add(&bar[XB_XGEN(b.x)], 1u);
            asm volatile("s_waitcnt vmcnt(0)" ::: "memory");
        } else {
            XB_SPIN(xb_ld(&bar[XB_XGEN(b.x)]) == gen, bar);
            __builtin_amdgcn_fence(__ATOMIC_ACQUIRE, "agent");
            asm volatile("s_waitcnt vmcnt(0)" ::: "memory");
        }
    }
    __syncthreads();
}


enum { PH_PREP = 0, PH_MEMKV, PH_F1A, PH_F1D, PH_ING, PH_POST, PH_POOL, PH_MEMATT, PH_UQ, PH_KV0, PH_ATT0, PH_KV1, PH_ATT1, PH_WO, PH_F2A, PH_F2D, NPH };
enum { I_XP = 0, I_XS, I_MEMP, I_CCKV, I_CKR, I_SPOOL, I_CMK, I_CMV, I_F1N, I_F1G, I_F1U, I_F1D, I_MIXN, I_WIN, I_QLN, I_KVLN, I_WUQ, I_WUQR, I_WUK, I_WUV, I_QN, I_KN, I_QRN, I_KRN,
       I_POOLW, I_POOLS, I_MEMN, I_WMK, I_WMV, I_MQN, I_MKN, I_WG, I_BG, I_WOUT, I_F2N, I_F2G, I_F2U, I_F2D, N_IN };
struct Params { const float* in[N_IN]; float* out; unsigned char* ws; double inv[32]; int ph_lo, ph_hi, li, pad; };
constexpr int PT_OFF = MISC_OFF + 256, PT_OUT = N_IN, PT_WS = N_IN + 1, PT_INV = PT_OFF + 8 * (N_IN + 2);
__device__ __forceinline__ const float* ldp(LAS unsigned char* lds, int i) {
    const LAS unsigned* t = (const LAS unsigned*)(lds + PT_OFF) + 2 * i;
    const unsigned lo = __builtin_amdgcn_readfirstlane(t[0]), hi = __builtin_amdgcn_readfirstlane(t[1]);
    return (const float*)(const __attribute__((address_space(1))) float*)(((unsigned long long)hi << 32) | (unsigned long long)lo);
}
__device__ __forceinline__ unsigned char* ldws(LAS unsigned char* lds) { return (unsigned char*)ldp(lds, PT_WS); }
__device__ __forceinline__ float* ldout(LAS unsigned char* lds) { return (float*)ldp(lds, PT_OUT); }

__device__ __forceinline__ void tr_item(const float* W, int N, const float* gain, bf16* dst, int ldt, int mode, int item, LAS float* scr, int lane) {
    const int nblk = N >> 5, kb = item / nblk, nb = item - kb * nblk, k0 = kb << 6, n0 = nb << 5;
    const int drow0 = mode == 0 ? n0 : (((n0 >> 7) << 8) + (n0 & 127) + (mode == 2 ? 128 : 0));
#pragma unroll 8
    for (int i = 0; i < 32; ++i) { const int kk = 2 * i + (lane >> 5); float v = W[(size_t)(k0 + kk) * N + n0 + (lane & 31)]; if (gain) v *= gain[k0 + kk]; scr[kk * 33 + (lane & 31)] = v; }
    LDS_WAIT(); asm volatile("" ::: "memory");
    const int c = lane & 7;
#pragma unroll
    for (int j = 0; j < 4; ++j) { const int n = (lane >> 3) + 8 * j; const LAS float* s = scr + (8 * c) * 33 + n;
        u32x4 o; o.x = pk2(s[0 * 33], s[1 * 33]); o.y = pk2(s[2 * 33], s[3 * 33]); o.z = pk2(s[4 * 33], s[5 * 33]); o.w = pk2(s[6 * 33], s[7 * 33]);
        *(u32x4*)(dst + (size_t)(drow0 + n) * ldt + k0 + 8 * c) = o; }
    LDS_WAIT(); asm volatile("" ::: "memory");
}
__device__ __forceinline__ u32x4 cvt8(const float* p) { const f32x4 a = *(const f32x4*)p, b = *(const f32x4*)(p + 4); u32x4 o; o.x = pk2(a[0], a[1]); o.y = pk2(a[2], a[3]); o.z = pk2(b[0], b[1]); o.w = pk2(b[2], b[3]); return o; }

__device__ __forceinline__ void phase_prep(int l, LAS unsigned char* lds, const int wv) {
    int tid_ = wv * 64 + lane_id_fresh(); asm volatile("" : "+v"(tid_));     const int lane = tid_ & 63, wave = __builtin_amdgcn_readfirstlane(tid_ >> 6);
    unsigned char* ws = ldws(lds);
    LAS float* scr = (LAS float*)(lds + wave * 16384);
    const int gw = blockIdx.x * 8 + wave, NGW = gridDim.x * 8;
    constexpr int C_FA = (D / 64) * (DFF / 32), C_FD = (DFF / 64) * (D / 32), C_IN = (D / 64) * (INW / 32), C_G = (D / 64) * (3 * D / 32), C_UQ = (QL / 64) * (D / 32), C_UQR = (QL / 64) * (1024 / 32),
                  C_UK = (KVL / 64) * (D / 32), C_PL = 4 * 2 * 16, C_MK = (D / 64) * (512 / 32), C_MV = (D / 64) * (D / 32), C_WO = (D / 64) * (D / 32), C_ZIG = 192, C_ZPL = D;
    constexpr int NITEMS = 4 * C_FA + 2 * C_FD + C_IN + C_G + C_UQ + C_UQR + 2 * C_UK + C_PL + C_MK + C_MV + C_WO + C_ZIG + C_ZPL;
    for (int it = gw; it < NITEMS; it += NGW) {
        int r = it;
        if (r < C_FA) { tr_item(ldp(lds, I_F1G) + (size_t)l * D * DFF, DFF, ldp(lds, I_F1N) + l * D, (bf16*)(ws + WS_W1A), D, 1, r, scr, lane); continue; } r -= C_FA;
        if (r < C_FA) { tr_item(ldp(lds, I_F1U) + (size_t)l * D * DFF, DFF, ldp(lds, I_F1N) + l * D, (bf16*)(ws + WS_W1A), D, 2, r, scr, lane); continue; } r -= C_FA;
        if (r < C_FD) { tr_item(ldp(lds, I_F1D) + (size_t)l * D * DFF, D, nullptr, (bf16*)(ws + WS_W1D), DFF, 0, r, scr, lane); continue; } r -= C_FD;
        if (r < C_FA) { tr_item(ldp(lds, I_F2G) + (size_t)l * D * DFF, DFF, ldp(lds, I_F2N) + l * D, (bf16*)(ws + WS_W2A), D, 1, r, scr, lane); continue; } r -= C_FA;
        if (r < C_FA) { tr_item(ldp(lds, I_F2U) + (size_t)l * D * DFF, DFF, ldp(lds, I_F2N) + l * D, (bf16*)(ws + WS_W2A), D, 2, r, scr, lane); continue; } r -= C_FA;
        if (r < C_FD) { tr_item(ldp(lds, I_F2D) + (size_t)l * D * DFF, D, nullptr, (bf16*)(ws + WS_W2D), DFF, 0, r, scr, lane); continue; } r -= C_FD;
        if (r < C_IN) { tr_item(ldp(lds, I_WIN) + (size_t)l * D * INW, INW, ldp(lds, I_MIXN) + l * D, (bf16*)(ws + WS_WIG), D, 0, r, scr, lane); continue; } r -= C_IN;
        if (r < C_G) { tr_item(ldp(lds, I_WG) + (size_t)l * D * 3 * D, 3 * D, ldp(lds, I_MIXN) + l * D, (bf16*)(ws + WS_WIG) + (size_t)D * D, D, 0, r, scr, lane); continue; } r -= C_G;
        if (r < C_UQ) { tr_item(ldp(lds, I_WUQ) + (size_t)l * QL * D, D, nullptr, (bf16*)(ws + WS_WUQ), QL, 0, r, scr, lane); continue; } r -= C_UQ;
        if (r < C_UQR) { tr_item(ldp(lds, I_WUQR) + (size_t)l * QL * 1024, 1024, nullptr, (bf16*)(ws + WS_WUQ) + (size_t)D * QL, QL, 0, r, scr, lane); continue; } r -= C_UQR;
        if (r < C_UK) { tr_item(ldp(lds, I_WUK) + (size_t)l * KVL * D, D, nullptr, (bf16*)(ws + WS_WKV), KVL, 0, r, scr, lane); continue; } r -= C_UK;
        if (r < C_UK) { tr_item(ldp(lds, I_WUV) + (size_t)l * KVL * D, D, nullptr, (bf16*)(ws + WS_WKV) + (size_t)D * KVL, KVL, 0, r, scr, lane); continue; } r -= C_UK;
        if (r < C_PL) { const int g = r >> 5; tr_item(ldp(lds, I_POOLW) + ((size_t)l * 4 + g) * 128 * 512, 512, nullptr, (bf16*)(ws + WS_WPL) + (size_t)(g * 512) * PWD + g * 128, PWD, 0, r & 31, scr, lane); continue; } r -= C_PL;
        if (r < C_MK) { tr_item(ldp(lds, I_WMK) + (size_t)l * D * 512, 512, nullptr, (bf16*)(ws + WS_WMK), D, 0, r, scr, lane); continue; } r -= C_MK;
        if (r < C_MV) { tr_item(ldp(lds, I_WMV) + (size_t)l * D * D, D, nullptr, (bf16*)(ws + WS_WMK) + (size_t)512 * D, D, 0, r, scr, lane); continue; } r -= C_MV;
        if (r < C_WO) { tr_item(ldp(lds, I_WOUT) + (size_t)l * D * D, D, nullptr, (bf16*)(ws + WS_WO), D, 0, r, scr, lane); continue; } r -= C_WO;
        if (r < C_ZIG) { u32x4* o = (u32x4*)((bf16*)(ws + WS_WIG) + (size_t)(INW + r) * D) + lane; const u32x4 z = {0u, 0u, 0u, 0u}; o[0] = z; o[64] = z; o[128] = z; o[192] = z; continue; } r -= C_ZIG;
        { if ((lane >> 4) != (r >> 9)) { const u32x4 z = {0u, 0u, 0u, 0u}; *((u32x4*)((bf16*)(ws + WS_WPL) + (size_t)r * PWD) + lane) = z; } }
    }
    const size_t tix = (size_t)gw * 64 + lane, tst = (size_t)NGW * 64;
    { const float* src = ldp(lds, I_CCKV) + (size_t)l * DB * PAST * KVL; bf16* dst = (bf16*)(ws + WS_CKV);
      for (size_t e = tix; e < (size_t)DB * PAST * (KVL / 8); e += tst) { const size_t row = e >> 5, c8 = e & 31, b = row >> 12, s = row & 4095;
          *(u32x4*)(dst + ((size_t)MP + b * SKS + s) * KVL + c8 * 8) = cvt8(src + row * KVL + c8 * 8); } }
    { const float* src = ldp(lds, I_CKR) + (size_t)l * DB * PAST * RD; bf16* dst = (bf16*)(ws + WS_KRS);
      for (size_t e = tix; e < (size_t)DB * PAST * (RD / 8); e += tst) { const size_t row = e >> 3, c8 = e & 7, b = row >> 12, s = row & 4095;
          *(u32x4*)(dst + (b * SKS + s) * RD + c8 * 8) = cvt8(src + row * RD + c8 * 8); } }
    { const float* src = ldp(lds, I_CMK) + (size_t)l * DB * NMEM * 512; bf16* dst = (bf16*)(ws + WS_MEMKS);
      for (size_t e = tix; e < (size_t)DB * NMEM * 512 / 8; e += tst) *(u32x4*)(dst + e * 8) = cvt8(src + e * 8); }
    { const float* src = ldp(lds, I_CMV) + (size_t)l * DB * NMEM * D; bf16* dst = (bf16*)(ws + WS_MEMVS);
      for (size_t e = tix; e < (size_t)DB * NMEM * D / 8; e += tst) *(u32x4*)(dst + e * 8) = cvt8(src + e * 8); }
    { const float* mn = ldp(lds, I_MEMN) + l * D; const float* memp = ldp(lds, I_MEMP); bf16* MBp = (bf16*)(ws + WS_MB);
      for (int row = gw; row < NMEM; row += NGW) { const float* x = memp + (size_t)row * D; f32x4 v[8]; float ss = 0.f;
#pragma unroll
          for (int j = 0; j < 8; ++j) { v[j] = *(const f32x4*)(x + j * 256 + lane * 4); ss += pg8::dot4(v[j]); }
          const float r = rsqrtf(wave_sum(ss) * (1.0f / D) + EPS);
#pragma unroll
          for (int j = 0; j < 8; ++j) { const f32x4 g = *(const f32x4*)(mn + j * 256 + lane * 4); const f32x4 y = v[j] * r * g; u32x2 o; o.x = pk2(y[0], y[1]); o.y = pk2(y[2], y[3]); *(u32x2*)(MBp + (size_t)row * D + j * 256 + lane * 4) = o; } } }
    if (l == 0) {
        bf16* XB = (bf16*)(ws + WS_XB); float* RS = (float*)(ws + WS_RS); const float* xp = ldp(lds, I_XP); const float* xs = ldp(lds, I_XS);
        for (int row = gw; row < M; row += NGW) { const float* x = row < MP ? xp + (size_t)row * D : xs + (size_t)(row - MP) * D; float ss = 0.f;
#pragma unroll
            for (int j = 0; j < 8; ++j) { const f32x4 v = *(const f32x4*)(x + j * 256 + lane * 4); ss += pg8::dot4(v); u32x2 o; o.x = pk2(v[0], v[1]); o.y = pk2(v[2], v[3]); *(u32x2*)(XB + (size_t)row * D + j * 256 + lane * 4) = o; }
            ss = wave_sum(ss); if (lane < 32) RS[(size_t)row * 32 + lane] = lane == 0 ? ss : 0.f; }
        f32x2* tab = (f32x2*)(ws + WS_ROPE);
        for (size_t e = tix; e < (size_t)MP * 32; e += tst) { const int pos = (int)(e >> 5), i = (int)(e & 31);
            const double ang = (double)pos * ((const LAS double*)(lds + PT_INV))[i]; const double n = __builtin_rint(ang * 0.15915494309189535); const double rr = __builtin_fma(-n, 6.283185307179586, ang) - n * 2.4492935982947064e-16;
            const double x2 = rr * rr; double sn = 0.0, cs = 0.0;
#pragma unroll
            for (int k = 14; k >= 1; --k) { sn = (sn + 1.0) * (x2 * (-1.0 / (double)((2 * k) * (2 * k + 1)))); cs = (cs + 1.0) * (x2 * (-1.0 / (double)((2 * k - 1) * (2 * k)))); }
            sn = (sn + 1.0) * rr; cs = cs + 1.0;
            tab[e] = (f32x2){(float)cs, (float)sn}; }
    }
}

__device__ __forceinline__ void phase_post(int l, LAS unsigned char* lds, const int wv) {
    int tid_ = wv * 64 + lane_id_fresh(); asm volatile("" : "+v"(tid_));     const int lane = tid_ & 63, wave = __builtin_amdgcn_readfirstlane(tid_ >> 6);
    unsigned char* ws = ldws(lds); const int gw = blockIdx.x * 8 + wave, NGW = gridDim.x * 8;
    const float* INP = (const float*)(ws + WS_INPROJ); const f32x2* tab = (const f32x2*)(ws + WS_ROPE);
    bf16* CQ = (bf16*)(ws + WS_CQ); bf16* CKV = (bf16*)(ws + WS_CKV); bf16* KRP = (bf16*)(ws + WS_KRP); bf16* KRS = (bf16*)(ws + WS_KRS); bf16* POOLED = (bf16*)(ws + WS_POOLED); bf16* QM = (bf16*)(ws + WS_QM);
    const float* qln = ldp(lds, I_QLN) + l * QL; const float* kvln = ldp(lds, I_KVLN) + l * KVL; const float* krn = ldp(lds, I_KRN) + l * RD; const float* mqn = ldp(lds, I_MQN) + l * 128;
    float* out = ldout(lds); const float* spool = ldp(lds, I_SPOOL); const float* mkn = ldp(lds, I_MKN) + l * 128;
    const f32x4 gq0 = *(const f32x4*)(qln + 8 * lane), gq1 = *(const f32x4*)(qln + 8 * lane + 4), gkv = *(const f32x4*)(kvln + 4 * lane);
    const f32x4 gm0 = *(const f32x4*)(mqn + ((8 * lane) & 127)), gm1 = *(const f32x4*)(mqn + ((8 * lane) & 127) + 4); const float gkr = krn[lane];
    const int NBLK = M / 4;
    for (int blk = gw; blk < NBLK + NMEM; blk += NGW) {
        if (blk >= NBLK) {
            const int j = blk - NBLK; const float* raw = (const float*)(ws + WS_MKVRAW) + (size_t)j * 2560;
            { const f32x4 a = *(const f32x4*)(raw + 8 * lane), b = *(const f32x4*)(raw + 8 * lane + 4); const float r = rsqrtf(sum16(pg8::dot4(a) + pg8::dot4(b)) * (1.0f / 128) + EPS);
              const f32x4 g0 = *(const f32x4*)(mkn + ((8 * lane) & 127)), g1 = *(const f32x4*)(mkn + ((8 * lane) & 127) + 4); const f32x4 y0 = a * r * g0, y1 = b * r * g1;
              float* o = out + O_MKP + ((size_t)l * NMEM + j) * 512 + 8 * lane; *(f32x4*)o = y0; *(f32x4*)(o + 4) = y1;
              *(u32x4*)((bf16*)(ws + WS_MEMKP) + (size_t)j * 512 + 8 * lane) = pg8::pack8(y0, y1); }
#pragma unroll
            for (int q = 0; q < 4; ++q) { const f32x4 a = *(const f32x4*)(raw + 512 + q * 512 + 8 * lane), b = *(const f32x4*)(raw + 512 + q * 512 + 8 * lane + 4);
              float* o = out + O_MVP + ((size_t)l * NMEM + j) * D + q * 512 + 8 * lane; *(f32x4*)o = a; *(f32x4*)(o + 4) = b;
              *(u32x4*)((bf16*)(ws + WS_MEMVP) + (size_t)j * D + q * 512 + 8 * lane) = pg8::pack8(a, b); }
            continue;
        }
        const int r0 = blk * 4; const bool samp = r0 >= MP; const int b = samp ? (r0 - MP) >> 6 : 0; const int s0 = samp ? MP + b * DS : 0; const int t0 = r0 - s0;
        const int w = 2 << (lane >> 4);
        f32x4 acc[4][2], cur[4][2];
#pragma unroll
        for (int k = 0; k < 4; ++k) { acc[k][0] = (f32x4){0.f, 0.f, 0.f, 0.f}; acc[k][1] = acc[k][0]; cur[k][0] = acc[k][0]; cur[k][1] = acc[k][0]; }
        for (int dj = 0; dj < 19; ++dj) { const int t = t0 + 3 - dj;
            if (dj < w + 3) { f32x4 a = {0.f, 0.f, 0.f, 0.f}, bb = a;
                if (t >= 0) { const float* src = INP + (size_t)(s0 + t) * D + 832 + 8 * lane; a = *(const f32x4*)src; bb = *(const f32x4*)(src + 4); }
                else if (samp) { const float* src = spool + (((size_t)l * DB + b) * PPAD + (PPAD + t)) * PWD + 8 * lane; a = *(const f32x4*)src; bb = *(const f32x4*)(src + 4); }
#pragma unroll
                for (int k = 0; k < 4; ++k) { const int d = k - (3 - dj);
                    if (d >= 0 && d < w) { acc[k][0] += a; acc[k][1] += bb; } if (d == 0) { cur[k][0] = a; cur[k][1] = bb; } } } }
#pragma unroll
        for (int k = 0; k < 4; ++k) { const int t = t0 + k; const int cnt = samp ? w : (t + 1 < w ? t + 1 : w); const float ic = 1.0f / (float)cnt;
            *(u32x4*)(POOLED + (size_t)(r0 + k) * PWD + 8 * lane) = pg8::pack8(acc[k][0] * ic - cur[k][0], acc[k][1] * ic - cur[k][1]);
            const int T = samp ? DS : MP;
            if (t >= T - PPAD) { float* o = samp ? out + O_POOLS + (((size_t)l * DB + b) * PPAD + (t - (T - PPAD))) * PWD + 8 * lane : out + O_POOLP + ((size_t)l * PPAD + (t - (T - PPAD))) * PWD + 8 * lane;
                *(f32x4*)o = cur[k][0]; *(f32x4*)(o + 4) = cur[k][1]; } }
#pragma unroll 1
        for (int k = 0; k < 4; ++k) { const int row = r0 + k, t = t0 + k; const float* ip = INP + (size_t)row * D;
            { const f32x4 a = *(const f32x4*)(ip + 8 * lane), bb = *(const f32x4*)(ip + 8 * lane + 4); const float r = rsqrtf(wave_sum(pg8::dot4(a) + pg8::dot4(bb)) * (1.0f / QL) + EPS);
              *(u32x4*)(CQ + (size_t)row * QL + 8 * lane) = pg8::pack8(a * r * gq0, bb * r * gq1); }
            { const f32x4 a = *(const f32x4*)(ip + 512 + 4 * lane); const float r = rsqrtf(wave_sum(pg8::dot4(a)) * (1.0f / KVL) + EPS); const f32x4 y = a * r * gkv;
              float* o = samp ? out + O_CKVS + ((size_t)l * MS + (row - MP)) * KVL + 4 * lane : out + O_CKVP + ((size_t)l * MP + row) * KVL + 4 * lane; *(f32x4*)o = y;
              const size_t crow = samp ? (size_t)MP + (size_t)b * SKS + PAST + t : (size_t)row; u32x2 o2; o2.x = pk2(y[0], y[1]); o2.y = pk2(y[2], y[3]); *(u32x2*)(CKV + crow * KVL + 4 * lane) = o2; }
            { const float x = ip[768 + lane]; const float r = rsqrtf(wave_sum(x * x) * (1.0f / RD) + EPS); const float v = x * r * gkr; const float pv = other_x32(v, lane >= 32);
              const int pos = samp ? PAST + t : t; const f32x2 cs = tab[(size_t)pos * 32 + (lane & 31)];
              const float y = lane < 32 ? v * cs.x - pv * cs.y : pv * cs.y + v * cs.x;
              float* o = samp ? out + O_KRS + ((size_t)l * MS + (row - MP)) * RD + lane : out + O_KRP + ((size_t)l * MP + row) * RD + lane; *o = y;
              bf16* ko = samp ? KRS + ((size_t)b * SKS + PAST + t) * RD + lane : KRP + (size_t)row * RD + lane; *ko = (bf16)(pk2(y, 0.f) & 0xffffu); }
            { const f32x4 a = *(const f32x4*)(ip + 1344 + 8 * lane), bb = *(const f32x4*)(ip + 1344 + 8 * lane + 4); const float r = rsqrtf(sum16(pg8::dot4(a) + pg8::dot4(bb)) * (1.0f / 128) + EPS);
              *(u32x4*)(QM + (size_t)row * MQD + 8 * lane) = pg8::pack8(a * r * gm0, bb * r * gm1); }
        }
    }
}

__device__ __forceinline__ void attn_store(att::f32x16* o, float l_reg, const bf16* gate, bf16* merged, bool store, float* li_l, int r32, int hi) {
    if (hi == 0) li_l[r32] = l_reg; LDS_WAIT();
    if (store) {
#pragma unroll
        for (int r = 0; r < 16; ++r) { const int row = att::crow(r, hi); const float rl = __builtin_amdgcn_rcpf(li_l[row]);
#pragma unroll
            for (int d0 = 0; d0 < 4; ++d0) { const size_t idx = (size_t)row * D + d0 * 32 + r32; const float g = __uint_as_float((unsigned)gate[idx] << 16), mo = __uint_as_float((unsigned)merged[idx] << 16);
                merged[idx] = (bf16)(pk2(mo + g * o[d0][r] * rl, 0.f) & 0xffffu); }
            asm volatile("" ::: "memory"); } }
}
__device__ __forceinline__ void phase_mematt(int l, LAS unsigned char* ldsl, char* lds, const int wv) {
    int tid_ = wv * 64 + lane_id_fresh(); asm volatile("" : "+v"(tid_));     const int lane = tid_ & 63, wave = __builtin_amdgcn_readfirstlane(tid_ >> 6);
    unsigned char* ws = ldws(ldsl); const int r32 = lane & 31, hi = lane >> 5;
    const bf16* QM = (const bf16*)(ws + WS_QM); const bf16* GM = (const bf16*)(ws + WS_GM); bf16* MERGED = (bf16*)(ws + WS_MERGED);
    float* li_l = (float*)(lds + 2 * 16384 + 2 * 16384) + wave * 64;
    const float C = 0.08838834764831845f * LOG2E;
    for (int it = blockIdx.x; it < 1024 + 256; it += gridDim.x) {
        const bool samp = it >= 1024; const int ii = samp ? it - 1024 : it; const int hc = ii & 15, h = hc >> 2, c = hc & 3, qb = ii >> 4;
        const int rowbase = samp ? MP + qb * DS + (wave & 1) * 32 : qb * 256 + wave * 32;
        const bf16* Kb = samp ? (const bf16*)(ws + WS_MEMKS) + (size_t)qb * NMEM * 512 + h * 128 : (const bf16*)(ws + WS_MEMKP) + h * 128;
        const bf16* Vb = samp ? (const bf16*)(ws + WS_MEMVS) + (size_t)qb * NMEM * D + h * 512 + c * 128 : (const bf16*)(ws + WS_MEMVP) + h * 512 + c * 128;
        att::bf16x8 qr[8];
        const bf16* qp = QM + (size_t)(rowbase + r32) * MQD + h * 128 + hi * 8;
#pragma unroll
        for (int d0 = 0; d0 < 8; ++d0) qr[d0] = *(const att::bf16x8*)(qp + d0 * 16);
        att::f32x16 o[4] = {}; float l_reg;
        int nt = 4; asm volatile("" : "+s"(nt)); att::attn_item<128, ATT_SD_MEM, 512, D>(qr, Kb, nullptr, Vb, nt, nt, nt, C, lds, o, l_reg, wv);
        const size_t ob = (size_t)rowbase * D + h * 512 + c * 128;
        attn_store(o, l_reg, GM + ob, MERGED + ob, !samp || wave < 2, li_l, r32, hi);
        __syncthreads();
    }
}
__device__ __forceinline__ void main_attn_item(int l, LAS unsigned char* ldsl, char* lds, bool samp, int qb_or_b, int h, const int wv) {
    int tid_ = wv * 64 + lane_id_fresh(); asm volatile("" : "+v"(tid_));     const int lane = tid_ & 63, wave = __builtin_amdgcn_readfirstlane(tid_ >> 6);
    unsigned char* ws = ldws(ldsl); const int r32 = lane & 31, hi = lane >> 5;
    const bf16* QRAW = (const bf16*)(ws + WS_QRAW); const bf16* GA = (const bf16*)(ws + WS_GA); bf16* MERGED = (bf16*)(ws + WS_MERGED); const f32x2* tab = (const f32x2*)(ws + WS_ROPE);
    float* li_l = (float*)(lds + 2 * 16384 + 2 * 24576) + wave * 64;
    const float C = 0.07216878364870322f * LOG2E;
    const int rowbase = samp ? MP + qb_or_b * DS + (wave & 1) * 32 : qb_or_b * 256 + wave * 32;
    const int row = rowbase + r32; const int pos = samp ? PAST + (row - MP - qb_or_b * DS) : row;
    att::bf16x8 qr[8]; char* qrl = lds + 2 * 16384 + 2 * 24576 + 2048 + wave * 4096 + lane * 16;
    { const bf16* qn = QRAW + (size_t)row * 3072 + h * 128 + hi * 8; const bf16* qrp = QRAW + (size_t)row * 3072 + D + h * 64 + hi * 8;
      const float* gn = ldp(ldsl, I_QN) + l * 128 + hi * 8; const float* gr = ldp(ldsl, I_QRN) + l * 64 + hi * 8;
      u32x4 rn[8]; float ss = 0.f;
#pragma unroll
      for (int d0 = 0; d0 < 8; ++d0) { rn[d0] = *(const u32x4*)(qn + d0 * 16);
#pragma unroll
          for (int q = 0; q < 4; ++q) { const float a = att::bflo(rn[d0][q]), bb = att::bfhi(rn[d0][q]); ss += a * a + bb * bb; } }
      ss = sum_x32(ss); const float rs_n = rsqrtf(ss * (1.0f / 128) + EPS);
#pragma unroll
      for (int d0 = 0; d0 < 8; ++d0) { const f32x4 g0 = *(const f32x4*)(gn + d0 * 16), g1 = *(const f32x4*)(gn + d0 * 16 + 4); u32x4 w;
          w.x = pk2(att::bflo(rn[d0].x) * rs_n * g0[0], att::bfhi(rn[d0].x) * rs_n * g0[1]); w.y = pk2(att::bflo(rn[d0].y) * rs_n * g0[2], att::bfhi(rn[d0].y) * rs_n * g0[3]);
          w.z = pk2(att::bflo(rn[d0].z) * rs_n * g1[0], att::bfhi(rn[d0].z) * rs_n * g1[1]); w.w = pk2(att::bflo(rn[d0].w) * rs_n * g1[2], att::bfhi(rn[d0].w) * rs_n * g1[3]);
          qr[d0] = *reinterpret_cast<att::bf16x8*>(&w); }
      u32x4 rr[4]; float sr = 0.f;
#pragma unroll
      for (int d = 0; d < 4; ++d) { rr[d] = *(const u32x4*)(qrp + d * 16);
#pragma unroll
          for (int q = 0; q < 4; ++q) { const float a = att::bflo(rr[d][q]), bb = att::bfhi(rr[d][q]); sr += a * a + bb * bb; } }
      sr = sum_x32(sr); const float rs_r = rsqrtf(sr * (1.0f / 64) + EPS);
#pragma unroll
      for (int d = 0; d < 2; ++d) { float x1[8], x2[8], y1[8], y2[8];
          const f32x4 ga0 = *(const f32x4*)(gr + d * 16), ga1 = *(const f32x4*)(gr + d * 16 + 4), gb0 = *(const f32x4*)(gr + 32 + d * 16), gb1 = *(const f32x4*)(gr + 32 + d * 16 + 4);
#pragma unroll
          for (int q = 0; q < 4; ++q) { x1[2 * q] = att::bflo(rr[d][q]) * rs_r * (q < 2 ? ga0[2 * q] : ga1[2 * q - 4]); x1[2 * q + 1] = att::bfhi(rr[d][q]) * rs_r * (q < 2 ? ga0[2 * q + 1] : ga1[2 * q - 3]);
                                        x2[2 * q] = att::bflo(rr[d + 2][q]) * rs_r * (q < 2 ? gb0[2 * q] : gb1[2 * q - 4]); x2[2 * q + 1] = att::bfhi(rr[d + 2][q]) * rs_r * (q < 2 ? gb0[2 * q + 1] : gb1[2 * q - 3]); }
          const f32x4* tp = (const f32x4*)(tab + (size_t)pos * 32 + d * 16 + hi * 8);
#pragma unroll
          for (int q = 0; q < 4; ++q) { const f32x4 cs = tp[q];
              y1[2 * q] = x1[2 * q] * cs[0] - x2[2 * q] * cs[1]; y2[2 * q] = x1[2 * q] * cs[1] + x2[2 * q] * cs[0];
              y1[2 * q + 1] = x1[2 * q + 1] * cs[2] - x2[2 * q + 1] * cs[3]; y2[2 * q + 1] = x1[2 * q + 1] * cs[3] + x2[2 * q + 1] * cs[2]; }
          u32x4 w1, w2; w1.x = pk2(y1[0], y1[1]); w1.y = pk2(y1[2], y1[3]); w1.z = pk2(y1[4], y1[5]); w1.w = pk2(y1[6], y1[7]);
          w2.x = pk2(y2[0], y2[1]); w2.y = pk2(y2[2], y2[3]); w2.z = pk2(y2[4], y2[5]); w2.w = pk2(y2[6], y2[7]);
          *(u32x4*)(qrl + d * 1024) = w1; *(u32x4*)(qrl + (2 + d) * 1024) = w2; }
    }
    const bf16* Kn; const bf16* Kr; const bf16* Vh; int NT, NTR, tlim;
    if (samp) { const int bl = qb_or_b & (CHB - 1); Kn = (const bf16*)(ws + WS_KS) + (size_t)bl * SKS * D + h * 128; Vh = (const bf16*)(ws + WS_VS) + (size_t)bl * SKS * D + h * 128;
                Kr = (const bf16*)(ws + WS_KRS) + (size_t)qb_or_b * SKS * RD; NT = 66; NTR = 65; tlim = 65; }
    else { Kn = (const bf16*)(ws + WS_KP) + h * 128; Vh = (const bf16*)(ws + WS_VP) + h * 128; Kr = (const bf16*)(ws + WS_KRP); NT = 4 * qb_or_b + 4; NTR = NT; tlim = 4 * qb_or_b + (wave >> 1) + 1; }
    att::f32x16 o[4] = {}; float l_reg;
    att::attn_item<192, ATT_SD_MAIN, D, D>(qr, Kn, Kr, Vh, NT, NTR, tlim, C, lds, o, l_reg, wv);
    const size_t ob = (size_t)rowbase * D + h * 128;
    attn_store(o, l_reg, GA + ob, MERGED + ob, !samp || wave < 2, li_l, r32, hi);
    __syncthreads();
}
__device__ __forceinline__ void phase_attn(int l, int half, LAS unsigned char* ldsl, char* lds, const int wv) {
    const int w = blockIdx.x, pp = half * 256 + w, h = pp & 15, x = pp >> 4, si = half == 0 ? w : w - 128;
    const int nit = (w < 256 ? 2 : 0) + ((si >= 0 && si < 128 && w < 256) ? 1 : 0);
#pragma unroll 1
    for (int it = 0; it < nit; ++it) {
        const bool samp = it == 2; const int qb = samp ? half * CHB + (si >> 4) : (it == 0 ? 63 - x : x); const int hh = samp ? (si & 15) : h;
        main_attn_item(l, ldsl, lds, samp, qb, hh, wv);
    }
}
#ifndef PHMASK
#define PHMASK 0xFFFF
#endif
#define GEMM_PHASE(EpiT, E, Ap, Bp, Mr, Nc, Kd) do { pg8::Gemm g_{(const pg8::bf16_t*)(Ap), (const pg8::bf16_t*)(Bp), (Mr), (Nc), (Kd)}; pg8::StaticOrder S_; S_.init((Mr), (Nc), G, (int)blockIdx.x); \
        pg8::gemm_phase<EpiT, pg8::StaticOrder, true, true>(lds, g_, S_, E, wv); } while (0)
template <int l> __device__ __forceinline__ void layer_program(LAS unsigned char* lds, unsigned char* lds_raw, const XcdBarrier& bar, const int lo, const int hi, const int G, const int wv) {
        const int pb = l * NPH;
#define WSP ldws(lds)
#define RP (ldout(lds) + O_Y)
#define IN(k) (((PHMASK >> (k)) & 1) && lo <= pb + (k) && pb + (k) < hi)
#define SEAM(k) do { if (pb + (k) + 1 < hi) xcd_barrier(bar); } while (0)
        if (IN(PH_PREP)) { phase_prep(l, lds, wv); SEAM(PH_PREP); }
        if (IN(PH_MEMKV)) { unsigned char* ws = WSP; pg8::EpiStoreF32 E{(float*)(ws + WS_MKVRAW), 2560}; GEMM_PHASE(pg8::EpiStoreF32, E, ws + WS_MB, ws + WS_WMK, NMEM, 2560, D); SEAM(PH_MEMKV); }
        if (IN(PH_F1A)) { unsigned char* ws = WSP; pg8::EpiSwiGLU E{(bf16*)(ws + WS_ACT), (const float*)(ws + WS_RS)}; GEMM_PHASE(pg8::EpiSwiGLU, E, ws + WS_XB, ws + WS_W1A, M, 2 * DFF, D); SEAM(PH_F1A); }
        if (IN(PH_F1D)) { unsigned char* ws = WSP; float* R = RP; pg8::EpiResid E{l == 0 ? ldp(lds, I_XP) : R, l == 0 ? ldp(lds, I_XS) : R + (size_t)MP * D, R, (bf16*)(ws + WS_XB), (float*)(ws + WS_RS), 0.5f}; GEMM_PHASE(pg8::EpiResid, E, ws + WS_ACT, ws + WS_W1D, M, D, DFF); SEAM(PH_F1D); }
        if (IN(PH_ING)) { unsigned char* ws = WSP; pg8::EpiInGate E{(float*)(ws + WS_INPROJ), (bf16*)(ws + WS_GA), (const float*)(ws + WS_RS), ldp(lds, I_BG) + (size_t)l * 3 * D};
            GEMM_PHASE(pg8::EpiInGate, E, ws + WS_XB, ws + WS_WIG, M, 8192, D); SEAM(PH_ING); }
        if (IN(PH_POST)) { phase_post(l, lds, wv); SEAM(PH_POST); }
        if (IN(PH_POOL)) { unsigned char* ws = WSP;
#ifdef DBG_POOL_STORE
            pg8::EpiStore E{(bf16*)(ws + WS_MERGED), D}; GEMM_PHASE(pg8::EpiStore, E, ws + WS_POOLED, ws + WS_WPL, M, D, PWD);
#else
            pg8::EpiPool E{(const bf16*)(ws + WS_GP), (bf16*)(ws + WS_MERGED), ldp(lds, I_POOLS) + (size_t)l * D}; GEMM_PHASE(pg8::EpiPool, E, ws + WS_POOLED, ws + WS_WPL, M, D, PWD);
#endif
 SEAM(PH_POOL); }
        if (IN(PH_MEMATT)) { phase_mematt(l, lds, (char*)lds_raw, wv); SEAM(PH_MEMATT); }
        if (IN(PH_UQ)) { unsigned char* ws = WSP; pg8::EpiStore E{(bf16*)(ws + WS_QRAW), 3072}; GEMM_PHASE(pg8::EpiStore, E, ws + WS_CQ, ws + WS_WUQ, M, 3072, QL); SEAM(PH_UQ); }
        if (IN(PH_KV0)) { unsigned char* ws = WSP; pg8::EpiKV E{(bf16*)(ws + WS_KP), (bf16*)(ws + WS_VP), (bf16*)(ws + WS_KS), (bf16*)(ws + WS_VS), MP, ldp(lds, I_KN) + l * 128, (LAS float*)(lds + LDSX_OFF)};
            GEMM_PHASE(pg8::EpiKV, E, ws + WS_CKV, ws + WS_WKV, MP + CHROWS, 4096, KVL); SEAM(PH_KV0); }
        if (IN(PH_ATT0)) { phase_attn(l, 0, lds, (char*)lds_raw, wv); SEAM(PH_ATT0); }
        if (IN(PH_KV1)) { unsigned char* ws = WSP; pg8::EpiKV E{(bf16*)(ws + WS_KS), (bf16*)(ws + WS_VS), (bf16*)(ws + WS_KS), (bf16*)(ws + WS_VS), 0, ldp(lds, I_KN) + l * 128, (LAS float*)(lds + LDSX_OFF)};
            GEMM_PHASE(pg8::EpiKV, E, (const bf16*)(ws + WS_CKV) + (size_t)(MP + CHROWS) * KVL, ws + WS_WKV, CHROWS, 4096, KVL); SEAM(PH_KV1); }
        if (IN(PH_ATT1)) { phase_attn(l, 1, lds, (char*)lds_raw, wv); SEAM(PH_ATT1); }
        if (IN(PH_WO)) { unsigned char* ws = WSP; float* R = RP; pg8::EpiResid E{R, R + (size_t)MP * D, R, (bf16*)(ws + WS_XB), (float*)(ws + WS_RS), 1.0f}; GEMM_PHASE(pg8::EpiResid, E, ws + WS_MERGED, ws + WS_WO, M, D, D); SEAM(PH_WO); }
        if (IN(PH_F2A)) { unsigned char* ws = WSP; pg8::EpiSwiGLU E{(bf16*)(ws + WS_ACT), (const float*)(ws + WS_RS)}; GEMM_PHASE(pg8::EpiSwiGLU, E, ws + WS_XB, ws + WS_W2A, M, 2 * DFF, D); SEAM(PH_F2A); }
        if (IN(PH_F2D)) { unsigned char* ws = WSP; float* R = RP; pg8::EpiResid E{R, R + (size_t)MP * D, R, (bf16*)(ws + WS_XB), (float*)(ws + WS_RS), 0.5f}; GEMM_PHASE(pg8::EpiResid, E, ws + WS_ACT, ws + WS_W2D, M, D, DFF); SEAM(PH_F2D); }
#undef IN
#undef SEAM
#undef WSP
#undef RP
}
__global__ void __launch_bounds__(512, 2) mega_fwd(Params p) {
    extern __shared__ __attribute__((aligned(16))) unsigned char lds_raw[];
    LAS unsigned char* lds = (LAS unsigned char*)lds_raw;
    const int tid = threadIdx.x, wv = __builtin_amdgcn_readfirstlane(tid >> 6);
    const int G = gridDim.x;
    volatile LAS unsigned* MISC = (volatile LAS unsigned*)(lds + MISC_OFF);
    if (tid < 64) MISC[tid] = 0u;
    if (tid == 64) { LAS unsigned long long* t = (LAS unsigned long long*)(lds + PT_OFF);
#pragma unroll
        for (int i = 0; i < N_IN; ++i) t[i] = (unsigned long long)p.in[i];
        t[PT_OUT] = (unsigned long long)p.out; t[PT_WS] = (unsigned long long)p.ws;
        LAS double* iv = (LAS double*)(lds + PT_INV);
#pragma unroll
        for (int i = 0; i < 32; ++i) iv[i] = p.inv[i]; }
    __syncthreads();
    XcdBarrier bar = xcd_barrier_post((unsigned*)(p.ws + WS_CTL) + CW_BAR + p.li * XCD_BAR_WORDS, MISC + 8);
    const int lo = p.ph_lo, hi = p.ph_hi;
    layer_program<0>(lds, lds_raw, bar, lo, hi, G, wv);
    layer_program<1>(lds, lds_raw, bar, lo, hi, G, wv);
}


#ifdef DBG_COPY_OFF
__global__ void dbg_copy(const unsigned char* ws, unsigned char* out, size_t bytes) { for (size_t i = ((size_t)blockIdx.x * 256 + threadIdx.x) * 16; i < bytes; i += (size_t)gridDim.x * 256 * 16) *(uint4*)(out + i) = *(const uint4*)(ws + i); }
#endif
#ifndef MK_N_LAUNCHES
#define MK_N_LAUNCHES 1
#endif
extern "C" void kernel_launch(void* const* d_in, const int* in_sizes, int n_in, void* d_out, int out_size, void* d_ws, size_t ws_size, hipStream_t stream) {
    static int grid = 0;
    if (grid == 0) {
        if (n_in != N_IN || (size_t)out_size != O_END || ws_size < WS_END) { fprintf(stderr, "kernel_launch: built for %d inputs, %zu outputs, >= %zu bytes of workspace; got %d, %d, %zu; nothing launched\n", (int)N_IN, (size_t)O_END, (size_t)WS_END, n_in, out_size, ws_size); grid = -1; return; }
        int dev = 0, cus = 0, per_cu = 0;
        if (hipGetDevice(&dev) != hipSuccess || hipDeviceGetAttribute(&cus, hipDeviceAttributeMultiprocessorCount, dev) != hipSuccess) { fprintf(stderr, "kernel_launch: device query failed\n"); grid = -1; return; }
        if (hipFuncSetAttribute((const void*)mega_fwd, hipFuncAttributeMaxDynamicSharedMemorySize, LDS_BYTES) != hipSuccess) { fprintf(stderr, "kernel_launch: hipFuncSetAttribute failed\n"); grid = -1; return; }
        if (hipOccupancyMaxActiveBlocksPerMultiprocessor(&per_cu, (const void*)mega_fwd, 512, LDS_BYTES) != hipSuccess || per_cu < 1) fprintf(stderr, "kernel_launch: note: occupancy query reports %d workgroups per CU\n", per_cu);
        (void)hipGetLastError();
        grid = cus;
    }
    if (grid < 0) return;
#ifdef DBG_MEMSET_ALL
    (void)hipMemsetAsync((char*)d_ws, 0, WS_END, stream);
#endif
    if (hipMemsetAsync((char*)d_ws + WS_CTL, 0, CTL_BYTES, stream) != hipSuccess) { fprintf(stderr, "kernel_launch: memset failed\n"); return; }
    Params p{};
    for (int i = 0; i < N_IN; ++i) p.in[i] = (const float*)d_in[i];
    p.out = (float*)d_out; p.ws = (unsigned char*)d_ws;
    for (int i = 0; i < 32; ++i) p.inv[i] = std::pow(10000.0, -(double)i / 32.0);
    p.pad = 0;
#ifdef DBG_NPH
    const int total = DBG_NPH;
#else
    const int total = DEPTH * NPH;
#endif
#if MK_N_LAUNCHES == 1
    p.ph_lo = 0; p.ph_hi = total; p.li = 0;
    hipLaunchKernelGGL(mega_fwd, dim3(grid), dim3(512), LDS_BYTES, stream, p);
#else
#ifdef DBG_PHLIST
    { const int lst[] = DBG_PHLIST; for (int k : lst) { p.ph_lo = k; p.ph_hi = k + 1; p.li = 0; hipLaunchKernelGGL(mega_fwd, dim3(grid), dim3(512), LDS_BYTES, stream, p); } (void)total; }
#else
    for (int k = 0; k < total; ++k) { p.ph_lo = k; p.ph_hi = k + 1; p.li = 0; hipLaunchKernelGGL(mega_fwd, dim3(grid), dim3(512), LDS_BYTES, stream, p); }
#endif
#endif
#ifdef DBG_COPY_OFF
    hipLaunchKernelGGL(dbg_copy, dim3(2048), dim3(256), 0, stream, (const unsigned char*)d_ws + (DBG_COPY_OFF), (unsigned char*)d_out, (size_t)(DBG_COPY_BYTES));
#endif
    const hipError_t le = hipPeekAtLastError();
    if (le != hipSuccess) fprintf(stderr, "kernel_launch: launch failed: %s\n", hipGetErrorName(le));
}
```

```cpp
#include <hip/hip_runtime.h>
#include <cstdio>
#include <cstdint>
#include <cmath>

constexpr int D = 2048, DFF = 5632, MP = 16384, MS = 1024, M = MP + MS, DEPTH = 2;
constexpr int NH = 16, HD = 128, RD = 64, QL = 512, KVL = 256, PWD = 512, MQD = 512, INW = 1856;
constexpr int NMEM = 256, MH = 4, MVD = 512;
constexpr int PAST = 4096, DB = 16, DS = 64, SKS = PAST + DS;
constexpr int CHB = 8, CHROWS = CHB * SKS;
constexpr int SALL = MP + DB * SKS;
constexpr int PPAD = 15;
constexpr float EPS = 1e-6f;
#define LOG2E 1.4426950408889634f

__device__ __forceinline__ int lane_id_fresh() { int x; asm volatile("v_mbcnt_lo_u32_b32 %0, -1, 0\n\tv_mbcnt_hi_u32_b32 %0, -1, %0" : "=v"(x)); return x; }
__device__ __forceinline__ const char* uni64(const char* p) { const unsigned long long v = (unsigned long long)p; const unsigned lo = __builtin_amdgcn_readfirstlane((unsigned)v), hi = __builtin_amdgcn_readfirstlane((unsigned)(v >> 32));
    return (const char*)(const __attribute__((address_space(1))) char*)(((unsigned long long)hi << 32) | (unsigned long long)lo); }
namespace pg8 {
#define PG8_LAS __attribute__((address_space(3)))
typedef unsigned short bf16_t;
typedef short bf16x8 __attribute__((ext_vector_type(8)));
typedef float f32x4 __attribute__((ext_vector_type(4)));
typedef unsigned u32x4 __attribute__((ext_vector_type(4)));
constexpr int BM = 256, BK = 64, HALF = 128, HTB = HALF * BK * 2  , STAGE_BYTES = 8 * HTB, NXCD = 8, WGM = 8;

__host__ __device__ __forceinline__ int lds_byte(int r, int c) { const int st = (r >> 4) * 2 + (c >> 5), rr = r & 15, cc = c & 31, ob = rr * 64 + cc * 2; return st * 1024 + (ob ^ (((ob >> 9) & 1) << 5)); }
__host__ __device__ __forceinline__ void stage_rc(int b, int& R, int& C) { const int st = b / 1024, sb = b % 1024, swz = sb ^ (((sb >> 9) & 1) << 5); R = (st >> 1) * 16 + swz / 64; C = (st & 1) * 32 + (swz % 64) / 2; }
__host__ __device__ __forceinline__ int perm32(int rho) { const int n = rho >> 4, i = rho & 15; return 8 * (i >> 2) + 4 * n + (i & 3); }

struct Unit { int pm, pn; };
struct Gemm { const bf16_t* A; const bf16_t* Bt; int M, N, K; };

struct StaticOrder {
    int nM, nN, nwg, G, c;
    __host__ __device__ void init(int M, int N, int G_, int c_) { nM = M / BM; nN = N / BM; nwg = nM * nN; G = G_; c = c_; }
    __device__ bool next(int i, Unit& u) const {
        const long L = (long)i * G + c; if (L >= nwg) return false;
        int wgid = (int)L; { const int q = nwg / NXCD, r = nwg % NXCD, xcd = wgid % NXCD, off = wgid / NXCD; wgid = (xcd < r ? xcd * (q + 1) : r * (q + 1) + (xcd - r) * q) + off; }
        const int nig = WGM * nN, gid = wgid / nig, fm = gid * WGM, gsz = (nM - fm) < WGM ? (nM - fm) : WGM;
        u.pm = __builtin_amdgcn_readfirstlane(fm + ((wgid % nig) % gsz)); u.pn = __builtin_amdgcn_readfirstlane((wgid % nig) / gsz); return true;
    }
    __device__ __forceinline__ void a_ready(const Unit&) const {}
    __device__ __forceinline__ void done(const Unit&) const {}
};
typedef float f32x2_t __attribute__((ext_vector_type(2)));
typedef __bf16 bf16x2_t __attribute__((ext_vector_type(2)));
__device__ __forceinline__ unsigned cvt_pk_bf16(float lo, float hi) { const f32x2_t v = {lo, hi}; const bf16x2_t r = __builtin_convertvector(v, bf16x2_t); return __builtin_bit_cast(unsigned, r); }
__device__ __forceinline__ u32x4 pack8(const f32x4 a, const f32x4 b) { u32x4 w; w.x = cvt_pk_bf16(a[0], a[1]); w.y = cvt_pk_bf16(a[2], a[3]); w.z = cvt_pk_bf16(b[0], b[1]); w.w = cvt_pk_bf16(b[2], b[3]); return w; }
__device__ __forceinline__ float bf_lo(unsigned w) { return __uint_as_float(w << 16); }
__device__ __forceinline__ float bf_hi(unsigned w) { return __uint_as_float(w & 0xffff0000u); }
__device__ __forceinline__ float dot4(const f32x4 a) { return (a[0] * a[0] + a[1] * a[1]) + (a[2] * a[2] + a[3] * a[3]); }
__device__ __forceinline__ float xsum_fq(float v) {
    { const auto a = __builtin_amdgcn_permlane16_swap(__float_as_uint(v), __float_as_uint(v), false, false); v = __uint_as_float(a[0]) + __uint_as_float(a[1]); }
    { const auto b = __builtin_amdgcn_permlane32_swap(__float_as_uint(v), __float_as_uint(v), false, false); v = __uint_as_float(b[0]) + __uint_as_float(b[1]); }
    return v;
}
__device__ __forceinline__ float row_rstd(const float* rs, int row, int fq) {
    const f32x4* p = (const f32x4*)(rs + (size_t)row * 32 + fq * 8); const f32x4 a = p[0], b = p[1];
    float s = ((a[0] + a[1]) + (a[2] + a[3])) + ((b[0] + b[1]) + (b[2] + b[3]));
    s = xsum_fq(s);
    return rsqrtf(s * (1.0f / D) + EPS);
}
__device__ __forceinline__ float silu_f(float g) { return g * __builtin_amdgcn_rcpf(1.0f + __builtin_amdgcn_exp2f(-LOG2E * g)); }
__device__ __forceinline__ float sigm_f(float g) { return __builtin_amdgcn_rcpf(1.0f + __builtin_amdgcn_exp2f(-LOG2E * g)); }

struct EpiSwiGLU { static constexpr bool PERM = true, AFTER_DRAIN = false;
    bf16_t* act; const float* rs;
    __device__ __forceinline__ void operator()(const f32x4 (&acc)[2][2][4][2], const Unit& u, int wr, int wc, int fr, int fq) const {
        { int ln_ = lane_id_fresh(); asm volatile("" : "+v"(ln_)); fr = ln_ & 15; fq = ln_ >> 4; }
        const int row0 = u.pm * BM + wr * 64 + fr, col0 = u.pn * HALF + wc * 32 + 8 * fq;
#pragma unroll
        for (int ai = 0; ai < 2; ++ai)
#pragma unroll
            for (int m = 0; m < 4; ++m) { const int row = row0 + ai * HALF + m * 16; const float r = row_rstd(rs, row, fq);
                f32x4 y[2];
#pragma unroll
                for (int n = 0; n < 2; ++n) { const f32x4 g = acc[ai][0][m][n] * r, uu = acc[ai][1][m][n] * r;
#pragma unroll
                    for (int j = 0; j < 4; ++j) y[n][j] = silu_f(g[j]) * uu[j]; }
                *(u32x4*)(act + (size_t)row * DFF + col0) = pack8(y[0], y[1]); }
    }
};
struct EpiResid { static constexpr bool PERM = true, AFTER_DRAIN = false;
    const float* res_lo; const float* res_hi; float* R; bf16_t* xb; float* rs; float alpha;
    __device__ __forceinline__ void operator()(const f32x4 (&acc)[2][2][4][2], const Unit& u, int wr, int wc, int fr, int fq) const {
        { int ln_ = lane_id_fresh(); asm volatile("" : "+v"(ln_)); fr = ln_ & 15; fq = ln_ >> 4; }
        const int row0 = u.pm * BM + wr * 64 + fr, col0 = u.pn * BM + wc * 32 + 8 * fq;
        const float* src = (u.pm < MP / BM) ? res_lo : (res_hi - (size_t)MP * D);
#pragma unroll
        for (int ai = 0; ai < 2; ++ai)
#pragma unroll
            for (int m = 0; m < 4; ++m) { const int row = row0 + ai * HALF + m * 16; const size_t off = (size_t)row * D + col0; float ss = 0.f;
#pragma unroll
                for (int bj = 0; bj < 2; ++bj) { const f32x4 x0 = *(const f32x4*)(src + off + bj * HALF), x1 = *(const f32x4*)(src + off + bj * HALF + 4);
                    const f32x4 o0 = x0 + acc[ai][bj][m][0] * alpha, o1 = x1 + acc[ai][bj][m][1] * alpha;
                    *(f32x4*)(R + off + bj * HALF) = o0; *(f32x4*)(R + off + bj * HALF + 4) = o1;
                    *(u32x4*)(xb + off + bj * HALF) = pack8(o0, o1); ss += dot4(o0) + dot4(o1); }
                ss = xsum_fq(ss);
                if (fq == 0) rs[(size_t)row * 32 + u.pn * 4 + wc] = ss; }
    }
};
struct EpiInGate { static constexpr bool PERM = true, AFTER_DRAIN = false;
    float* inproj; bf16_t* gates; const float* rs; const float* bgate;
    __device__ __forceinline__ void operator()(const f32x4 (&acc)[2][2][4][2], const Unit& u, int wr, int wc, int fr, int fq) const {
        { int ln_ = lane_id_fresh(); asm volatile("" : "+v"(ln_)); fr = ln_ & 15; fq = ln_ >> 4; }
        const int row0 = u.pm * BM + wr * 64 + fr;
        if (u.pn < 8) { const int col0 = u.pn * BM + wc * 32 + 8 * fq;
#pragma unroll
            for (int ai = 0; ai < 2; ++ai)
#pragma unroll
                for (int m = 0; m < 4; ++m) { const int row = row0 + ai * HALF + m * 16; const float r = row_rstd(rs, row, fq); float* o = inproj + (size_t)row * D + col0;
#pragma unroll
                    for (int bj = 0; bj < 2; ++bj) { *(f32x4*)(o + bj * HALF) = acc[ai][bj][m][0] * r; *(f32x4*)(o + bj * HALF + 4) = acc[ai][bj][m][1] * r; } }
        } else { const int t = u.pn - 8, j = t >> 3, col0 = (t & 7) * BM + wc * 32 + 8 * fq; bf16_t* G = gates + (size_t)j * M * D;
            f32x4 bv[2][2];
#pragma unroll
            for (int bj = 0; bj < 2; ++bj)
#pragma unroll
                for (int n = 0; n < 2; ++n) bv[bj][n] = *(const f32x4*)(bgate + j * D + col0 + bj * HALF + 4 * n);
#pragma unroll
            for (int ai = 0; ai < 2; ++ai)
#pragma unroll
                for (int m = 0; m < 4; ++m) { const int row = row0 + ai * HALF + m * 16; const float r = row_rstd(rs, row, fq);
#pragma unroll
                    for (int bj = 0; bj < 2; ++bj) { f32x4 v0 = acc[ai][bj][m][0] * r + bv[bj][0], v1 = acc[ai][bj][m][1] * r + bv[bj][1];
#ifndef DBG_NOSIG
#pragma unroll
                        for (int q = 0; q < 4; ++q) { v0[q] = sigm_f(v0[q]); v1[q] = sigm_f(v1[q]); }
#endif

                        *(u32x4*)(G + (size_t)row * D + col0 + bj * HALF) = pack8(v0, v1); } }
        }
    }
};
struct EpiPool { static constexpr bool PERM = true, AFTER_DRAIN = false;
    const bf16_t* gp; bf16_t* merged; const float* pscale;
    __device__ __forceinline__ void operator()(const f32x4 (&acc)[2][2][4][2], const Unit& u, int wr, int wc, int fr, int fq) const {
        { int ln_ = lane_id_fresh(); asm volatile("" : "+v"(ln_)); fr = ln_ & 15; fq = ln_ >> 4; }
        const int row0 = u.pm * BM + wr * 64 + fr, col0 = u.pn * BM + wc * 32 + 8 * fq;
        f32x4 ps[2][2];
#pragma unroll
        for (int bj = 0; bj < 2; ++bj)
#pragma unroll
            for (int n = 0; n < 2; ++n) ps[bj][n] = *(const f32x4*)(pscale + col0 + bj * HALF + 4 * n);
#pragma unroll
        for (int ai = 0; ai < 2; ++ai)
#pragma unroll
            for (int m = 0; m < 4; ++m) { const size_t off = (size_t)(row0 + ai * HALF + m * 16) * D + col0;
#pragma unroll
                for (int bj = 0; bj < 2; ++bj) { const u32x4 g = *(const u32x4*)(gp + off + bj * HALF);
                    f32x4 g0 = {bf_lo(g.x), bf_hi(g.x), bf_lo(g.y), bf_hi(g.y)}, g1 = {bf_lo(g.z), bf_hi(g.z), bf_lo(g.w), bf_hi(g.w)};
#ifdef DBG_NOGATE
                    g0 = (f32x4){1.f, 1.f, 1.f, 1.f}; g1 = g0;
#endif
                    *(u32x4*)(merged + off + bj * HALF) = pack8(acc[ai][bj][m][0] * ps[bj][0] * g0, acc[ai][bj][m][1] * ps[bj][1] * g1); } }
    }
};
struct EpiStore { static constexpr bool PERM = true, AFTER_DRAIN = false;
    bf16_t* O; int ldc;
    __device__ __forceinline__ void operator()(const f32x4 (&acc)[2][2][4][2], const Unit& u, int wr, int wc, int fr, int fq) const {
        { int ln_ = lane_id_fresh(); asm volatile("" : "+v"(ln_)); fr = ln_ & 15; fq = ln_ >> 4; }
        const int row0 = u.pm * BM + wr * 64 + fr, col0 = u.pn * BM + wc * 32 + 8 * fq;
#pragma unroll
        for (int ai = 0; ai < 2; ++ai)
#pragma unroll
            for (int m = 0; m < 4; ++m) { bf16_t* o = O + (size_t)(row0 + ai * HALF + m * 16) * ldc + col0;
#pragma unroll
                for (int bj = 0; bj < 2; ++bj) *(u32x4*)(o + bj * HALF) = pack8(acc[ai][bj][m][0], acc[ai][bj][m][1]); }
    }
};
struct EpiStoreF32 { static constexpr bool PERM = true, AFTER_DRAIN = false;
    float* O; int ldc;
    __device__ __forceinline__ void operator()(const f32x4 (&acc)[2][2][4][2], const Unit& u, int wr, int wc, int fr, int fq) const {
        { int ln_ = lane_id_fresh(); asm volatile("" : "+v"(ln_)); fr = ln_ & 15; fq = ln_ >> 4; }
        const int row0 = u.pm * BM + wr * 64 + fr, col0 = u.pn * BM + wc * 32 + 8 * fq;
#pragma unroll
        for (int ai = 0; ai < 2; ++ai)
#pragma unroll
            for (int m = 0; m < 4; ++m) { float* o = O + (size_t)(row0 + ai * HALF + m * 16) * ldc + col0;
#pragma unroll
                for (int bj = 0; bj < 2; ++bj) { *(f32x4*)(o + bj * HALF) = acc[ai][bj][m][0]; *(f32x4*)(o + bj * HALF + 4) = acc[ai][bj][m][1]; } }
    }
};
struct EpiKV { static constexpr bool PERM = true, AFTER_DRAIN = false;
    bf16_t *K0, *V0, *K1, *V1; int split; const float* knorm; PG8_LAS float* P;
    __device__ __forceinline__ void operator()(const f32x4 (&acc)[2][2][4][2], const Unit& u, int wr, int wc, int fr, int fq) const {
        { int ln_ = lane_id_fresh(); asm volatile("" : "+v"(ln_)); fr = ln_ & 15; fq = ln_ >> 4; }
        const int grow = u.pm * BM; const bool second = grow >= split; const int orow0 = (second ? grow - split : grow) + wr * 64 + fr;
        bf16_t* Kd = second ? K1 : K0; bf16_t* Vd = second ? V1 : V0;
        if (u.pn >= 8) { const int col0 = (u.pn - 8) * BM + wc * 32 + 8 * fq;
#pragma unroll
            for (int ai = 0; ai < 2; ++ai)
#pragma unroll
                for (int m = 0; m < 4; ++m) { bf16_t* o = Vd + (size_t)(orow0 + ai * HALF + m * 16) * D + col0;
#pragma unroll
                    for (int bj = 0; bj < 2; ++bj) *(u32x4*)(o + bj * HALF) = pack8(acc[ai][bj][m][0], acc[ai][bj][m][1]); }
        } else { const int col0 = u.pn * BM + wc * 32 + 8 * fq, rt0 = wr * 64 + fr;
#pragma unroll
            for (int ai = 0; ai < 2; ++ai)
#pragma unroll
                for (int m = 0; m < 4; ++m)
#pragma unroll
                    for (int bj = 0; bj < 2; ++bj) { float ss = dot4(acc[ai][bj][m][0]) + dot4(acc[ai][bj][m][1]); ss = xsum_fq(ss);
                        if (fq == 0) P[((rt0 + ai * HALF + m * 16) * 2 + bj) * 4 + wc] = ss; __builtin_amdgcn_sched_barrier(0); }
            asm volatile("s_waitcnt lgkmcnt(0)" ::: "memory"); __builtin_amdgcn_s_barrier(); asm volatile("" ::: "memory");
            const f32x4 g0 = *(const f32x4*)(knorm + wc * 32 + 8 * fq), g1 = *(const f32x4*)(knorm + wc * 32 + 8 * fq + 4);
#pragma unroll
            for (int ai = 0; ai < 2; ++ai)
#pragma unroll
                for (int m = 0; m < 4; ++m) { bf16_t* o = Kd + (size_t)(orow0 + ai * HALF + m * 16) * D + col0;
#pragma unroll
                    for (int bj = 0; bj < 2; ++bj) { const f32x4 p4 = *(const PG8_LAS f32x4*)(P + ((rt0 + ai * HALF + m * 16) * 2 + bj) * 4);
                        const float r = rsqrtf(((p4[0] + p4[1]) + (p4[2] + p4[3])) * (1.0f / HD) + EPS);
                        *(u32x4*)(o + bj * HALF) = pack8(acc[ai][bj][m][0] * r * g0, acc[ai][bj][m][1] * r * g1); }
                    asm volatile("" ::: "memory"); __builtin_amdgcn_sched_barrier(0); }
        }
    }
};

template <class Epi, class Sched, bool ALIGN_EPI = false, bool SP2 = false>
__device__ __forceinline__ void gemm_phase(PG8_LAS unsigned char* lds, const Gemm g, const Sched& S, const Epi& E, const int wv  ) {
    int tid_ = wv * 64 + lane_id_fresh(); asm volatile("" : "+v"(tid_));
    const int tid = tid_, wid = __builtin_amdgcn_readfirstlane(tid >> 6), lane = tid & 63, wr = wid >> 2, wc = wid & 3, fr = lane & 15, fq = lane >> 4;
    const int K = g.K, nt = K / BK;
    unsigned voffA[2], voffB[2];
#pragma unroll
    for (int i = 0; i < 2; ++i) { int R, C; stage_rc(tid * 16 + i * 8192, R, C); const int Rb = Epi::PERM ? ((R & ~31) + perm32(R & 31)) : R;
        voffA[i] = (unsigned)(R * K + C) * 2u; voffB[i] = (unsigned)(Rb * K + C) * 2u; }
    const size_t kstep = (size_t)(BK * 2);
    const size_t hstep = (size_t)HALF * K * 2;
    const size_t tstep = 2 * hstep;
    const unsigned ldsw = (unsigned)wid * 1024u;
    const int aoff = lds_byte(wr * 64 + fr, fq * 8), boff = lds_byte(wc * 32 + fr, fq * 8);
#define PG8_SA(b, h) (((b) * 2 + (h)) * HTB)
#define PG8_SB(b, h) ((4 + (b) * 2 + (h)) * HTB)
#define PG8_STAGE(bufoff, gbase, voff) do { const char* gb_ = uni64((const char*)(gbase)); _Pragma("unroll") for (int _i = 0; _i < 2; ++_i) \
        __builtin_amdgcn_global_load_lds((const unsigned*)(gb_ + (voff)[_i]), (PG8_LAS unsigned*)(lds + (bufoff) + ldsw + _i * 8192), 16, 0, 0); } while (0)
#define PG8_LDA(dst, b, h) do { _Pragma("unroll") for (int m = 0; m < 4; ++m) _Pragma("unroll") for (int k = 0; k < 2; ++k) dst[m][k] = *(const PG8_LAS bf16x8*)(lds + PG8_SA(b, h) + aoff + m * 2048 + k * 1024); } while (0)
#define PG8_LDB(dst, b, h) do { _Pragma("unroll") for (int n = 0; n < 2; ++n) _Pragma("unroll") for (int k = 0; k < 2; ++k) dst[n][k] = *(const PG8_LAS bf16x8*)(lds + PG8_SB(b, h) + boff + n * 2048 + k * 1024); } while (0)
#define PG8_MMA(ai, bj, At, Bt) do { __builtin_amdgcn_s_setprio(1); _Pragma("unroll") for (int m = 0; m < 4; ++m) _Pragma("unroll") for (int n = 0; n < 2; ++n) _Pragma("unroll") for (int k = 0; k < 2; ++k) \
        acc[ai][bj][m][n] = __builtin_amdgcn_mfma_f32_16x16x32_bf16(Bt[n][k], At[m][k], acc[ai][bj][m][n], 0, 0, 0); __builtin_amdgcn_s_setprio(0); } while (0)
#define PG8_WAIT_V(n) asm volatile("s_waitcnt vmcnt(" #n ")" ::: "memory")
#define PG8_WAIT_L(n) asm volatile("s_waitcnt lgkmcnt(" #n ")" ::: "memory")
#define PG8_BAR __builtin_amdgcn_s_barrier()
#define PG8_SCHED __builtin_amdgcn_sched_barrier(0)
    Unit cur, nxt; int ui = 0;
    if (!S.next(0, cur)) return;
    f32x4 acc[2][2][4][2];
#pragma unroll
    for (int a = 0; a < 2; ++a)
#pragma unroll
        for (int b = 0; b < 2; ++b)
#pragma unroll
            for (int m = 0; m < 4; ++m)
#pragma unroll
                for (int n = 0; n < 2; ++n) acc[a][b][m][n] = (f32x4){0.f, 0.f, 0.f, 0.f};
    bf16x8 At[4][2], B0[2][2], B1[2][2];
    const char* cA = (const char*)g.A + (size_t)cur.pm * tstep; const char* cB = (const char*)g.Bt + (size_t)cur.pn * tstep;
    S.a_ready(cur);
    if constexpr (SP2) {
        PG8_STAGE(PG8_SB(0, 0), cB, voffB); PG8_STAGE(PG8_SB(0, 1), cB + hstep, voffB); PG8_STAGE(PG8_SA(0, 0), cA, voffA); PG8_STAGE(PG8_SA(0, 1), cA + hstep, voffA);
        if (wr == 1) PG8_BAR;
        PG8_WAIT_V(2); PG8_BAR;
        PG8_STAGE(PG8_SB(1, 0), cB + kstep, voffB); PG8_STAGE(PG8_SA(1, 0), cA + kstep, voffA); PG8_STAGE(PG8_SB(1, 1), cB + hstep + kstep, voffB);
        PG8_WAIT_V(6); PG8_BAR;
    } else {
        PG8_STAGE(PG8_SB(0, 0), cB, voffB); PG8_STAGE(PG8_SA(0, 0), cA, voffA); PG8_STAGE(PG8_SB(0, 1), cB + hstep, voffB); PG8_STAGE(PG8_SA(0, 1), cA + hstep, voffA);
        if (wr == 1) PG8_BAR;
        PG8_WAIT_V(4); PG8_BAR;
        PG8_STAGE(PG8_SB(1, 0), cB + kstep, voffB); PG8_STAGE(PG8_SA(1, 0), cA + kstep, voffA); PG8_STAGE(PG8_SB(1, 1), cB + hstep + kstep, voffB);
        PG8_WAIT_V(6); PG8_BAR;
    }
    for (;;) {
        const bool has_next = S.next(ui + 1, nxt);
        const char* nA = has_next ? (const char*)g.A + (size_t)nxt.pm * tstep : cA; const char* nB = has_next ? (const char*)g.Bt + (size_t)nxt.pn * tstep : cB;
        for (int t = 0; t < nt; t += 2) {
            const bool last = (t == nt - 2);
            const char* a1 = cA + (size_t)(t + 1) * kstep;
            const char* a2 = last ? nA : cA + (size_t)(t + 2) * kstep; const char* b2 = last ? nB : cB + (size_t)(t + 2) * kstep;
            const char* a3 = a2 + kstep; const char* b3 = b2 + kstep;
            if (last && has_next) S.a_ready(nxt);
            if constexpr (SP2) {
            PG8_LDB(B0, 0, 0); PG8_LDB(B1, 0, 1); PG8_SCHED; PG8_LDA(At, 0, 0); PG8_STAGE(PG8_SA(1, 1), a1 + hstep, voffA);
            PG8_WAIT_V(8); PG8_WAIT_L(0); PG8_BAR; PG8_MMA(0, 0, At, B0); PG8_MMA(0, 1, At, B1); PG8_BAR; PG8_SCHED;
            PG8_LDA(At, 0, 1); PG8_STAGE(PG8_SB(0, 0), b2, voffB); PG8_STAGE(PG8_SB(0, 1), b2 + hstep, voffB); PG8_STAGE(PG8_SA(0, 0), a2, voffA);
            PG8_WAIT_V(8); PG8_WAIT_L(0); PG8_BAR; PG8_MMA(1, 0, At, B0); PG8_MMA(1, 1, At, B1); PG8_BAR; PG8_SCHED;
            PG8_LDB(B0, 1, 0); PG8_LDB(B1, 1, 1); PG8_SCHED; PG8_LDA(At, 1, 0); PG8_STAGE(PG8_SA(0, 1), a2 + hstep, voffA);
            PG8_WAIT_V(8); PG8_WAIT_L(0); PG8_BAR; PG8_MMA(0, 0, At, B0); PG8_MMA(0, 1, At, B1); PG8_BAR; PG8_SCHED;
            PG8_LDA(At, 1, 1); PG8_STAGE(PG8_SB(1, 0), b3, voffB); PG8_STAGE(PG8_SB(1, 1), b3 + hstep, voffB); PG8_STAGE(PG8_SA(1, 0), a3, voffA);
            PG8_WAIT_V(8); PG8_WAIT_L(0); PG8_BAR; PG8_MMA(1, 0, At, B0); PG8_MMA(1, 1, At, B1); PG8_BAR; PG8_SCHED;
            } else {
            PG8_LDB(B0, 0, 0); PG8_SCHED; PG8_LDA(At, 0, 0); PG8_STAGE(PG8_SA(1, 1), a1 + hstep, voffA);
            PG8_WAIT_L(8); PG8_BAR; PG8_WAIT_L(0); PG8_MMA(0, 0, At, B0); PG8_BAR; PG8_SCHED;
            PG8_LDB(B1, 0, 1); PG8_STAGE(PG8_SB(0, 0), b2, voffB);
            PG8_BAR; PG8_WAIT_L(0); PG8_MMA(0, 1, At, B1); PG8_BAR;
            PG8_LDA(At, 0, 1); PG8_STAGE(PG8_SA(0, 0), a2, voffA);
            PG8_BAR; PG8_WAIT_L(0); PG8_MMA(1, 0, At, B0); PG8_BAR; PG8_SCHED;
            PG8_STAGE(PG8_SB(0, 1), b2 + hstep, voffB);
            PG8_WAIT_V(6); PG8_BAR; PG8_MMA(1, 1, At, B1); PG8_BAR;
            PG8_LDB(B0, 1, 0); PG8_SCHED; PG8_LDA(At, 1, 0); PG8_STAGE(PG8_SA(0, 1), a2 + hstep, voffA);
            PG8_WAIT_L(8); PG8_BAR; PG8_WAIT_L(0); PG8_MMA(0, 0, At, B0); PG8_BAR; PG8_SCHED;
            PG8_LDB(B1, 1, 1); PG8_STAGE(PG8_SB(1, 0), b3, voffB);
            PG8_BAR; PG8_WAIT_L(0); PG8_MMA(0, 1, At, B1); PG8_BAR;
            PG8_LDA(At, 1, 1); PG8_STAGE(PG8_SA(1, 0), a3, voffA);
            PG8_BAR; PG8_WAIT_L(0); PG8_MMA(1, 0, At, B0); PG8_BAR; PG8_SCHED;
            PG8_STAGE(PG8_SB(1, 1), b3 + hstep, voffB);
            PG8_WAIT_V(6); PG8_BAR; PG8_MMA(1, 1, At, B1); PG8_BAR;
            }
        }
        if constexpr (ALIGN_EPI) { if (wr == 0) PG8_BAR; }
        if constexpr (!Epi::AFTER_DRAIN) { E(acc, cur, wr, wc, fr, fq); S.done(cur); }
        if (!has_next) break;
#pragma unroll
        for (int a = 0; a < 2; ++a)
#pragma unroll
            for (int b = 0; b < 2; ++b)
#pragma unroll
                for (int m = 0; m < 4; ++m)
#pragma unroll
                    for (int n = 0; n < 2; ++n) acc[a][b][m][n] = (f32x4){0.f, 0.f, 0.f, 0.f};
        cur = nxt; cA = nA; cB = nB; ++ui;
        if constexpr (ALIGN_EPI) { if (wr == 1) PG8_BAR; }
    }
    PG8_WAIT_V(0);
    if constexpr (!ALIGN_EPI) { if (wr == 0) PG8_BAR; }
    PG8_BAR;
    if constexpr (Epi::AFTER_DRAIN) { E.fused(acc, cur, wr, wc, fr, fq, lds, wid, lane); S.done(cur); }
#undef PG8_SA
#undef PG8_SB
#undef PG8_STAGE
#undef PG8_LDA
#undef PG8_LDB
#undef PG8_MMA
#undef PG8_WAIT_V
#undef PG8_WAIT_L
#undef PG8_BAR
#undef PG8_SCHED
}
}

#ifndef ATT_SD_MEM
#define ATT_SD_MEM 1
#endif
#ifndef ATT_SD_MAIN
#define ATT_SD_MAIN 1
#endif
namespace att {
typedef unsigned short bf16_t;
using bf16x8 = __attribute__((ext_vector_type(8))) short;
using s16x4  = __attribute__((ext_vector_type(4))) short;
using f32x16 = __attribute__((ext_vector_type(16))) float;
using f32x4  = __attribute__((ext_vector_type(4))) float;
using u32x4  = __attribute__((ext_vector_type(4))) unsigned;
constexpr int KVBLK = 64;
constexpr float THR = 8.f;
#define ATT_SBAR() __builtin_amdgcn_sched_barrier(0)
__device__ __forceinline__ int crow(int r, int hi) { return (r & 3) + 8 * (r >> 2) + 4 * hi; }
__device__ __forceinline__ unsigned cvtpk(float lo, float hi) { return pg8::cvt_pk_bf16(lo, hi); }
__device__ __forceinline__ float bflo(unsigned w) { return __uint_as_float(w << 16); }
__device__ __forceinline__ float bfhi(unsigned w) { return __uint_as_float(w & 0xffff0000u); }
template <int DQK> __device__ __forceinline__ int kswz(int row, int cb) { if constexpr (DQK == 128) return row * 256 + (cb ^ ((row & 7) << 4)); else return row * 384 + (cb ^ (((row >> 1) & 7) << 4)); }
__device__ __forceinline__ int v_st(int k, int c) { const int kk = (k & ~0xC) | ((k & 4) << 1) | ((k & 8) >> 1); return ((kk >> 3) * 4 + (c >> 5)) * 512 + ((kk & 7) * 32 + (c & 31)) * 2; }
__device__ __forceinline__ int v_rd_base(int lane) { return ((lane & 3) << 3) | (((lane >> 2) & 3) << 6) | (((lane >> 4) & 1) << 5) | (((lane >> 5) & 1) << 8); }
constexpr int v_rd_off(int d0, int ks, int half) { return d0 * 512 + ks * 4096 + half * 2048; }
template <int OFF> __device__ __forceinline__ s16x4 tr_read(int vb) { s16x4 r; asm volatile("ds_read_b64_tr_b16 %0, %1 offset:%2" : "=&v"(r) : "v"(vb), "i"(OFF) : "memory"); return r; }
template <int D0> __device__ __forceinline__ void pv_one(f32x16& od, int vb, bf16x8 pa0, bf16x8 pa1, bf16x8 pa2, bf16x8 pa3) {
  const s16x4 l0 = tr_read<v_rd_off(D0, 0, 0)>(vb), h0 = tr_read<v_rd_off(D0, 0, 1)>(vb), l1 = tr_read<v_rd_off(D0, 1, 0)>(vb), h1 = tr_read<v_rd_off(D0, 1, 1)>(vb);
  const s16x4 l2 = tr_read<v_rd_off(D0, 2, 0)>(vb), h2 = tr_read<v_rd_off(D0, 2, 1)>(vb), l3 = tr_read<v_rd_off(D0, 3, 0)>(vb), h3 = tr_read<v_rd_off(D0, 3, 1)>(vb);
  asm volatile("s_waitcnt lgkmcnt(0)" ::: "memory"); ATT_SBAR();
#define ATT_PK(L, H) (bf16x8){L[0], L[1], L[2], L[3], H[0], H[1], H[2], H[3]}
  od = __builtin_amdgcn_mfma_f32_32x32x16_bf16(pa0, ATT_PK(l0, h0), od, 0, 0, 0);
  od = __builtin_amdgcn_mfma_f32_32x32x16_bf16(pa1, ATT_PK(l1, h1), od, 0, 0, 0);
  od = __builtin_amdgcn_mfma_f32_32x32x16_bf16(pa2, ATT_PK(l2, h2), od, 0, 0, 0);
  od = __builtin_amdgcn_mfma_f32_32x32x16_bf16(pa3, ATT_PK(l3, h3), od, 0, 0, 0);
#undef ATT_PK
}
__device__ __forceinline__ void pv_d0(f32x16* o, int vb, bf16x8 pa0, bf16x8 pa1, bf16x8 pa2, bf16x8 pa3) {
  pv_one<0>(o[0], vb, pa0, pa1, pa2, pa3); pv_one<1>(o[1], vb, pa0, pa1, pa2, pa3); pv_one<2>(o[2], vb, pa0, pa1, pa2, pa3); pv_one<3>(o[3], vb, pa0, pa1, pa2, pa3);
}
__device__ __forceinline__ void partialSM(f32x16& p0, f32x16& p1, float& m_reg, float& mn, float& alpha, const float C, const bool masked) {
  if (masked) {
#pragma unroll
    for (int r = 0; r < 16; ++r) { p0[r] = -__builtin_inff(); p1[r] = -__builtin_inff(); } }
  float pmax = p0[0];
#pragma unroll
  for (int r = 1; r < 16; ++r) pmax = fmaxf(pmax, p0[r]);
#pragma unroll
  for (int r = 0; r < 16; ++r) pmax = fmaxf(pmax, p1[r]);
  { auto rr = __builtin_amdgcn_permlane32_swap(__float_as_uint(pmax), __float_as_uint(pmax), false, false);
    pmax = fmaxf(__uint_as_float(rr[0]), __uint_as_float(rr[1])); }
  if (__builtin_expect(__all((pmax - m_reg) * C <= THR * LOG2E), 1)) { mn = m_reg; alpha = 1.f; }
  else { mn = fmaxf(m_reg, pmax); alpha = __builtin_amdgcn_exp2f((m_reg - mn) * C); m_reg = mn; }
  const float mnC = -mn * C;
#pragma unroll
  for (int r = 0; r < 16; ++r) p0[r] = fmaf(p0[r], C, mnC);
#pragma unroll
  for (int r = 0; r < 16; ++r) p1[r] = fmaf(p1[r], C, mnC);
#pragma unroll
  for (int r = 0; r < 16; ++r) p0[r] = __builtin_amdgcn_exp2f(p0[r]);
}
__device__ __forceinline__ void finishSM(f32x16& p0, f32x16& p1, float alpha, float& l_reg, bf16x8& pa0, bf16x8& pa1, bf16x8& pa2, bf16x8& pa3) {
#pragma unroll
  for (int r = 0; r < 16; ++r) p1[r] = __builtin_amdgcn_exp2f(p1[r]);
  float ps = 0;
#pragma unroll
  for (int r = 0; r < 16; ++r) ps += p0[r];
#pragma unroll
  for (int r = 0; r < 16; ++r) ps += p1[r];
  { auto rr = __builtin_amdgcn_permlane32_swap(__float_as_uint(ps), __float_as_uint(ps), false, false);
    ps = __uint_as_float(rr[0]) + __uint_as_float(rr[1]); }
  l_reg = l_reg * alpha + ps;
#define ATT_PK4(P, BASE, OUT) do { unsigned a0 = cvtpk(P[BASE + 0], P[BASE + 1]), a1 = cvtpk(P[BASE + 2], P[BASE + 3]);   \
    unsigned b0 = cvtpk(P[BASE + 4], P[BASE + 5]), b1 = cvtpk(P[BASE + 6], P[BASE + 7]);                              \
    auto r0 = __builtin_amdgcn_permlane32_swap(a0, b0, false, false); auto r1 = __builtin_amdgcn_permlane32_swap(a1, b1, false, false); \
    u32x4 w = {r0[0], r1[0], r0[1], r1[1]}; OUT = *reinterpret_cast<bf16x8*>(&w); } while (0)
  ATT_PK4(p0, 0, pa0); ATT_PK4(p0, 8, pa1); ATT_PK4(p1, 0, pa2); ATT_PK4(p1, 8, pa3);
#undef ATT_PK4
}
template <int DQK, int BUFOFF> __device__ __forceinline__ void qkt(f32x16& p0, f32x16& p1, const int (&kb)[4], const bf16x8* qr, const int qrb) {
  typedef const __attribute__((address_space(3))) bf16x8* lp;
  constexpr int ROWB = DQK * 2;
  p0 = f32x16{}; p1 = f32x16{};
#pragma unroll
  for (int d0 = 0; d0 < DQK / 16; ++d0) {
    const bf16x8 b0 = *(lp)(kb[d0 & 3] + (d0 >> 2) * 128 + BUFOFF);
    const bf16x8 b1 = *(lp)(kb[d0 & 3] + (d0 >> 2) * 128 + BUFOFF + 32 * ROWB);
    const bf16x8 q = d0 < 8 ? qr[d0 < 8 ? d0 : 0] : *(lp)(qrb + (d0 - 8) * 1024);
    p0 = __builtin_amdgcn_mfma_f32_32x32x16_bf16(b0, q, p0, 0, 0, 0);
    p1 = __builtin_amdgcn_mfma_f32_32x32x16_bf16(b1, q, p1, 0, 0, 0); }
}
template <int DQK, int SDEPTH, int ldk, int ldv>
__device__ __forceinline__ void attn_item(const bf16x8* qr, const bf16_t* __restrict__ Kn, const bf16_t* __restrict__ Kr, const bf16_t* __restrict__ Vh,
                                          int NT, int NTR, int tlim, float C, char* lds, f32x16* o, float& l_out, const int wv) {
  constexpr int SHM_V = KVBLK * 128 * 2, SHM_K = KVBLK * DQK * 2;
  int tid_ = wv * 64 + lane_id_fresh(); asm volatile("" : "+v"(tid_));
  const int tid = tid_, wid = tid >> 6, lane = tid & 63, r32 = lane & 31, hi = lane >> 5;
  char* V_lds = lds; char* K_lds = lds + 2 * SHM_V;
  float* ws = (float*)(lds + 2 * SHM_V + 2 * SHM_K) + wid * 64; float* al_l = ws + 32;
  float m_reg = -1e30f, l_reg = 0;
  const int sr = tid >> 4, sc = (tid & 15) * 8, vst0 = v_st(sr, sc), vst1 = v_st(32 + sr, sc);
  const int kst0 = kswz<DQK>(sr, sc * 2), kst1 = kswz<DQK>(32 + sr, sc * 2);
  const int rr_ = tid >> 3, rc_ = (tid & 7) * 8, kst2 = kswz<DQK>(rr_, 256 + rc_ * 2);
  const int vb0 = (int)(uintptr_t)V_lds + v_rd_base(lane);
  int kb[4];
#pragma unroll
  for (int q = 0; q < 4; ++q) { kb[q] = (int)(uintptr_t)K_lds + kswz<DQK>(r32, q * 32 + hi * 16); asm volatile("" : "+v"(kb[q])); }
  int qrb = (int)(uintptr_t)lds + 2 * SHM_V + 2 * SHM_K + 2048 + wid * 4096 + lane * 16; asm volatile("" : "+v"(qrb));
  struct { bf16x8 vs0, vs1, ks0, ks1, kr; } sr_[SDEPTH];
  const unsigned voV = (unsigned)(sr * ldv + sc) * 2u, voK = (unsigned)(sr * ldk + sc) * 2u, voR = (unsigned)(rr_ * 64 + rc_) * 2u;
#define ATT_SLOAD(i, t) do { const int k0_ = ((t) < NTR ? (t) : NTR - 1) * KVBLK; \
    const char* vt_ = (const char*)(Vh + (long)k0_ * ldv); const char* kt_ = (const char*)(Kn + (long)k0_ * ldk); \
    sr_[i].vs0 = *(const bf16x8*)(vt_ + voV); sr_[i].vs1 = *(const bf16x8*)(vt_ + (long)32 * ldv * 2 + voV); \
    sr_[i].ks0 = *(const bf16x8*)(kt_ + voK); sr_[i].ks1 = *(const bf16x8*)(kt_ + (long)32 * ldk * 2 + voK); \
    if constexpr (DQK == 192) sr_[i].kr = *(const bf16x8*)((const char*)(Kr + (long)k0_ * 64) + voR); } while (0)
#define ATT_SWRITE(b, i) do { *(bf16x8*)(V_lds + (b) * SHM_V + vst0) = sr_[i].vs0; *(bf16x8*)(V_lds + (b) * SHM_V + vst1) = sr_[i].vs1; \
    *(bf16x8*)(K_lds + (b) * SHM_K + kst0) = sr_[i].ks0; *(bf16x8*)(K_lds + (b) * SHM_K + kst1) = sr_[i].ks1; \
    if constexpr (DQK == 192) *(bf16x8*)(K_lds + (b) * SHM_K + kst2) = sr_[i].kr; } while (0)
#define ATT_SWAIT() do { if constexpr (SDEPTH == 1) asm volatile("s_waitcnt vmcnt(0)" ::: "memory"); else if constexpr (DQK == 192) asm volatile("s_waitcnt vmcnt(5)" ::: "memory"); else asm volatile("s_waitcnt vmcnt(4)" ::: "memory"); } while (0)
#define ATT_RESC(a) do { if (__any((a) < 1.f)) { if (hi == 0) al_l[r32] = (a); asm volatile("s_waitcnt lgkmcnt(0)" ::: "memory"); \
    _Pragma("unroll") for (int d = 0; d < 4; ++d) _Pragma("unroll") for (int r = 0; r < 16; ++r) o[d][r] *= al_l[crow(r, hi)]; } } while (0)
  f32x16 pA0, pA1, pB0, pB1; float mnA, mnB, alA, alB; bf16x8 pa0, pa1, pa2, pa3;
  constexpr int SE = 0, SO = SDEPTH - 1;
  ATT_SLOAD(SE, 0); asm volatile("s_waitcnt vmcnt(0)" ::: "memory"); ATT_SWRITE(0, SE); __syncthreads();
  qkt<DQK, 0>(pA0, pA1, kb, qr, qrb); partialSM(pA0, pA1, m_reg, mnA, alA, C, 0 >= tlim);
  ATT_SLOAD(SO, 1); if constexpr (SDEPTH == 2) { if (2 < NT) ATT_SLOAD(SE, 2); }
  ATT_SWAIT(); ATT_SWRITE(1, SO); __syncthreads();
  for (int j = 1; j + 1 < NT; j += 2) {
    ATT_SBAR(); qkt<DQK, SHM_K>(pB0, pB1, kb, qr, qrb);
    finishSM(pA0, pA1, alA, l_reg, pa0, pa1, pa2, pa3); ATT_SBAR();
    ATT_SLOAD(SO, j + SDEPTH); ATT_SBAR();
    pv_d0(o, vb0, pa0, pa1, pa2, pa3); partialSM(pB0, pB1, m_reg, mnB, alB, C, j >= tlim);
    __syncthreads(); ATT_SWAIT(); ATT_SWRITE(0, SE);
    ATT_RESC(alB); __syncthreads();
    ATT_SBAR(); qkt<DQK, 0>(pA0, pA1, kb, qr, qrb);
    finishSM(pB0, pB1, alB, l_reg, pa0, pa1, pa2, pa3); ATT_SBAR();
    if (SDEPTH == 1 || j + 3 < NT) ATT_SLOAD(SE, j + 1 + SDEPTH); ATT_SBAR();
    pv_d0(o, vb0 + SHM_V, pa0, pa1, pa2, pa3); partialSM(pA0, pA1, m_reg, mnA, alA, C, j + 1 >= tlim);
    __syncthreads(); ATT_SWAIT(); ATT_SWRITE(1, SO);
    ATT_RESC(alA); __syncthreads();
  }
  ATT_SBAR(); qkt<DQK, SHM_K>(pB0, pB1, kb, qr, qrb);
  finishSM(pA0, pA1, alA, l_reg, pa0, pa1, pa2, pa3); ATT_SBAR();
  pv_d0(o, vb0, pa0, pa1, pa2, pa3); partialSM(pB0, pB1, m_reg, mnB, alB, C, NT - 1 >= tlim);
  __syncthreads(); ATT_RESC(alB);
  finishSM(pB0, pB1, alB, l_reg, pa0, pa1, pa2, pa3); ATT_SBAR();
  pv_d0(o, vb0 + SHM_V, pa0, pa1, pa2, pa3);
  l_out = l_reg;
#undef ATT_SLOAD
#undef ATT_SWRITE
#undef ATT_SWAIT
#undef ATT_RESC
}
}

constexpr size_t WS_CTL = 0, CTL_BYTES = 1u << 20;
constexpr size_t WS_ROPE = WS_CTL + CTL_BYTES;
constexpr size_t WS_RS = WS_ROPE + (size_t)MP * 32 * 8;
constexpr size_t WS_W1A = WS_RS + (size_t)M * 32 * 4;
constexpr size_t WS_W1D = WS_W1A + (size_t)2 * DFF * D * 2;
constexpr size_t WS_WIG = WS_W1D + (size_t)D * DFF * 2;
constexpr size_t WS_WUQ = WS_WIG + (size_t)8192 * D * 2;
constexpr size_t WS_WKV = WS_WUQ + (size_t)3072 * QL * 2;
constexpr size_t WS_WPL = WS_WKV + (size_t)4096 * KVL * 2;
constexpr size_t WS_WMK = WS_WPL + (size_t)D * PWD * 2;
constexpr size_t WS_WO = WS_WMK + (size_t)2560 * D * 2;
constexpr size_t WS_W2A = WS_WO + (size_t)D * D * 2;
constexpr size_t WS_W2D = WS_W2A + (size_t)2 * DFF * D * 2;
constexpr size_t WS_XB = WS_W2D + (size_t)D * DFF * 2;
constexpr size_t WS_MB = WS_XB + (size_t)M * D * 2;
constexpr size_t WS_MKVRAW = WS_MB + (size_t)NMEM * D * 2;
constexpr size_t WS_MEMKP = WS_MKVRAW + (size_t)NMEM * 2560 * 4;
constexpr size_t WS_MEMVP = WS_MEMKP + (size_t)NMEM * 512 * 2;
constexpr size_t WS_MEMKS = WS_MEMVP + (size_t)NMEM * D * 2;
constexpr size_t WS_MEMVS = WS_MEMKS + (size_t)DB * NMEM * 512 * 2;
constexpr size_t WS_KRP = WS_MEMVS + (size_t)DB * NMEM * D * 2;
constexpr size_t WS_KRS = WS_KRP + (size_t)MP * RD * 2;
constexpr size_t WS_QRAW = WS_KRS + (size_t)DB * SKS * RD * 2;
constexpr size_t WS_CKV = WS_QRAW + (size_t)M * 3072 * 2;
constexpr size_t WS_MERGED = WS_CKV + (size_t)SALL * KVL * 2;
constexpr size_t WS_CQ = WS_MERGED + (size_t)M * D * 2;
constexpr size_t WS_POOLED = WS_CQ + (size_t)M * QL * 2;
constexpr size_t WS_QM = WS_POOLED + (size_t)M * PWD * 2;
constexpr size_t WS_GA = WS_QM + (size_t)M * MQD * 2;
constexpr size_t WS_BIG = WS_GA + (size_t)M * D * 2;
constexpr size_t WS_GP = WS_BIG, WS_GM = WS_GP + (size_t)M * D * 2, WS_INPROJ = WS_GM + (size_t)M * D * 2, WS_EARLY_END = WS_INPROJ + (size_t)M * D * 4;
constexpr size_t WS_KP = WS_BIG, WS_VP = WS_KP + (size_t)MP * D * 2, WS_KS = WS_VP + (size_t)MP * D * 2, WS_VS = WS_KS + (size_t)CHROWS * D * 2, WS_LATE_END = WS_VS + (size_t)CHROWS * D * 2;
static_assert(WS_GP == WS_GA + (size_t)M * D * 2 && WS_GM == WS_GP + (size_t)M * D * 2, "gates contiguous");
constexpr size_t WS_ACT = WS_BIG, WS_ACT_END = WS_ACT + (size_t)M * DFF * 2;
constexpr size_t WS_END = WS_LATE_END > WS_EARLY_END ? (WS_LATE_END > WS_ACT_END ? WS_LATE_END : WS_ACT_END) : (WS_EARLY_END > WS_ACT_END ? WS_EARLY_END : WS_ACT_END);
constexpr int CW_BAR = 4096;
constexpr size_t O_Y = 0, O_CKVP = (size_t)M * D, O_KRP = O_CKVP + (size_t)DEPTH * MP * KVL, O_POOLP = O_KRP + (size_t)DEPTH * MP * RD, O_MKP = O_POOLP + (size_t)DEPTH * PPAD * PWD,
                 O_MVP = O_MKP + (size_t)DEPTH * NMEM * 512, O_CKVS = O_MVP + (size_t)DEPTH * NMEM * D, O_KRS = O_CKVS + (size_t)DEPTH * MS * KVL, O_POOLS = O_KRS + (size_t)DEPTH * MS * RD,
                 O_END = O_POOLS + (size_t)DEPTH * DB * PPAD * PWD;
constexpr int RING_BYTES = 131072, LDSX_OFF = RING_BYTES  , MISC_OFF = LDSX_OFF + 8192, LDS_BYTES = 147456;

#define LAS __attribute__((address_space(3)))
typedef unsigned short bf16;
typedef float f32x4 __attribute__((ext_vector_type(4)));
typedef unsigned u32x4 __attribute__((ext_vector_type(4)));
typedef unsigned u32x2 __attribute__((ext_vector_type(2)));
typedef float f32x2 __attribute__((ext_vector_type(2)));
#define LDS_WAIT() asm volatile("s_waitcnt lgkmcnt(0)" ::: "memory")
__device__ __forceinline__ unsigned pk2(float lo, float hi) { return pg8::cvt_pk_bf16(lo, hi); }
template <int CTRL> __device__ __forceinline__ float dpp_f(float v) { return __uint_as_float(__builtin_amdgcn_update_dpp(0u, __float_as_uint(v), CTRL, 0xf, 0xf, false)); }
__device__ __forceinline__ float sum16(float v) { v += dpp_f<0x128>(v); v += dpp_f<0x124>(v); v += dpp_f<0x122>(v); v += dpp_f<0x121>(v); return v; }
__device__ __forceinline__ float wave_sum(float v) { return pg8::xsum_fq(sum16(v)); }
__device__ __forceinline__ float sum_x32(float v) { const auto b = __builtin_amdgcn_permlane32_swap(__float_as_uint(v), __float_as_uint(v), false, false); return __uint_as_float(b[0]) + __uint_as_float(b[1]); }
__device__ __forceinline__ float other_x32(float v, bool upper) { const auto b = __builtin_amdgcn_permlane32_swap(__float_as_uint(v), __float_as_uint(v), false, false); return __uint_as_float(upper ? b[0] : b[1]); }

#define XB_TMO      128
#define XB_XCNT(j)  (256  + 64 * (j))
#define XB_XSUB(j)  (1280 + 64 * (j))
#define XB_XGEN(j)  (2304 + 64 * (j))
#define XB_TOP      3328
#define XB_TOPGEN   3392
#define XCD_BAR_WORDS 3456
#define XB_SPIN_CAP (1u << 22)

__device__ __forceinline__ unsigned xb_ld(unsigned* p)              { return __hip_atomic_load(p, __ATOMIC_RELAXED, __HIP_MEMORY_SCOPE_AGENT); }
__device__ __forceinline__ unsigned xb_add(unsigned* p, unsigned v) { return __hip_atomic_fetch_add(p, v, __ATOMIC_RELAXED, __HIP_MEMORY_SCOPE_AGENT); }
__device__ __forceinline__ unsigned xb_xcc_id() { return (unsigned)__builtin_amdgcn_s_getreg((3 << 11) | 20) & 0xFu; }
#define XB_SPIN(cond, bar) do { unsigned _sp = 0; while (cond) { __builtin_amdgcn_s_sleep(1); \
    if ((++_sp & 255u) == 0u) { if (xb_ld(&(bar)[XB_TMO])) break; if (_sp > XB_SPIN_CAP) { atomicAdd(&(bar)[XB_TMO], 1u); break; } } } } while (0)

struct XcdBarrier {
    unsigned* bar; unsigned x;
    volatile LAS unsigned* st;
};

__device__ __forceinline__ XcdBarrier xcd_barrier_post(unsigned* bar, volatile LAS unsigned* st) {
    XcdBarrier b; b.bar = bar; b.x = xb_xcc_id(); b.st = st;
    if (threadIdx.x == 0) (void)xb_add(&bar[XB_XCNT(b.x)], 1u);
    return b;
}
__device__ __forceinline__ void xcd_barrier_complete(unsigned* bar, unsigned x, unsigned& nloc, unsigned& nx) {
    const unsigned G = gridDim.x * gridDim.y * gridDim.z;
    unsigned sum, cnt, mine, sp = 0u;
    for (;;) {
        sum = 0u; cnt = 0u; mine = 0u;
#pragma unroll
        for (unsigned j = 0; j < 16; ++j) { const unsigned c = xb_ld(&bar[XB_XCNT(j)]); sum += c; cnt += (c > 0u) ? 1u : 0u; mine = (j == x) ? c : mine; }
        if (sum == G) break;
        __builtin_amdgcn_s_sleep(1);
        if ((++sp & 255u) == 0u) { if (xb_ld(&bar[XB_TMO])) break; if (sp > XB_SPIN_CAP) { atomicAdd(&bar[XB_TMO], 1u); break; } }
    }
    nloc = mine > 0u ? mine : 1u; nx = cnt > 0u ? cnt : 1u;
}

__device__ __forceinline__ void xcd_barrier(const XcdBarrier& b) {
    asm volatile("s_waitcnt vmcnt(0)" ::: "memory");
    __syncthreads();
    if (threadIdx.x == 0) {
        unsigned* bar = b.bar;
        __builtin_amdgcn_s_waitcnt(0);
        unsigned nloc = b.st[0], nx = b.st[1];
        if (nloc == 0u) { xcd_barrier_complete(bar, b.x, nloc, nx); b.st[0] = nloc; b.st[1] = nx; }
        const unsigned old = xb_add(&bar[XB_XSUB(b.x)], 1u);
        const unsigned gen = old / nloc;
        if (old + 1u == (gen + 1u) * nloc) {
            __builtin_amdgcn_fence(__ATOMIC_RELEASE, "agent");
            asm volatile("s_waitcnt vmcnt(0)" ::: "memory");
            const unsigned og = xb_add(&bar[XB_TOP], 1u);
            const unsigned tg = og / nx;
            if (og + 1u == (tg + 1u) * nx) xb_add(&bar[XB_TOPGEN], 1u);
            else XB_SPIN(xb_ld(&bar[XB_TOPGEN]) == tg, bar);
            __builtin_amdgcn_fence(__ATOMIC_ACQUIRE, "agent");
            xb_add(&bar[XB_XGEN(b.x)], 1u);
            asm volatile("s_waitcnt vmcnt(0)" ::: "memory");
        } else {
            XB_SPIN(xb_ld(&bar[XB_XGEN(b.x)]) == gen, bar);
            __builtin_amdgcn_fence(__ATOMIC_ACQUIRE, "agent");
            asm volatile("s_waitcnt vmcnt(0)" ::: "memory");
        }
    }
    __syncthreads();
}


enum { PH_PREP = 0, PH_MEMKV, PH_F1A, PH_F1D, PH_ING, PH_POST, PH_POOL, PH_MEMATT, PH_UQ, PH_KV0, PH_ATT0, PH_KV1, PH_ATT1, PH_WO, PH_F2A, PH_F2D, NPH };
enum { I_XP = 0, I_XS, I_MEMP, I_CCKV, I_CKR, I_SPOOL, I_CMK, I_CMV, I_F1N, I_F1G, I_F1U, I_F1D, I_MIXN, I_WIN, I_QLN, I_KVLN, I_WUQ, I_WUQR, I_WUK, I_WUV, I_QN, I_KN, I_QRN, I_KRN,
       I_POOLW, I_POOLS, I_MEMN, I_WMK, I_WMV, I_MQN, I_MKN, I_WG, I_BG, I_WOUT, I_F2N, I_F2G, I_F2U, I_F2D, N_IN };
struct Params { const float* in[N_IN]; float* out; unsigned char* ws; double inv[32]; int ph_lo, ph_hi, li, pad; };
constexpr int PT_OFF = MISC_OFF + 256, PT_OUT = N_IN, PT_WS = N_IN + 1, PT_INV = PT_OFF + 8 * (N_IN + 2);
__device__ __forceinline__ const float* ldp(LAS unsigned char* lds, int i) {
    const LAS unsigned* t = (const LAS unsigned*)(lds + PT_OFF) + 2 * i;
    const unsigned lo = __builtin_amdgcn_readfirstlane(t[0]), hi = __builtin_amdgcn_readfirstlane(t[1]);
    return (const float*)(const __attribute__((address_space(1))) float*)(((unsigned long long)hi << 32) | (unsigned long long)lo);
}
__device__ __forceinline__ unsigned char* ldws(LAS unsigned char* lds) { return (unsigned char*)ldp(lds, PT_WS); }
__device__ __forceinline__ float* ldout(LAS unsigned char* lds) { return (float*)ldp(lds, PT_OUT); }

__device__ __forceinline__ void tr_item(const float* W, int N, const float* gain, bf16* dst, int ldt, int mode, int item, LAS float* scr, int lane) {
    const int nblk = N >> 6, kb = item / nblk, nb = item - kb * nblk, k0 = kb << 6, n0 = nb << 6;
    const int drow0 = mode == 0 ? n0 : (((n0 >> 7) << 8) + (n0 & 127) + (mode == 2 ? 128 : 0));
    const float* src = W + (size_t)k0 * N + n0 + lane;
    float v[64];
#pragma unroll
    for (int i = 0; i < 64; ++i) v[i] = src[(size_t)i * N];
    if (gain) {
#pragma unroll
        for (int i = 0; i < 64; ++i) v[i] *= gain[k0 + i]; }
#pragma unroll
    for (int i = 0; i < 64; ++i) scr[i * 65 + lane] = v[i];
    LDS_WAIT(); asm volatile("" ::: "memory");
    const int c = lane & 7;
#pragma unroll
    for (int j = 0; j < 8; ++j) { const int n = (lane >> 3) + 8 * j; const LAS float* s = scr + (8 * c) * 65 + n;
        u32x4 o; o.x = pk2(s[0 * 65], s[1 * 65]); o.y = pk2(s[2 * 65], s[3 * 65]); o.z = pk2(s[4 * 65], s[5 * 65]); o.w = pk2(s[6 * 65], s[7 * 65]);
        *(u32x4*)(dst + (size_t)(drow0 + n) * ldt + k0 + 8 * c) = o; }
    LDS_WAIT(); asm volatile("" ::: "memory");
}
__device__ __forceinline__ u32x4 cvt8(const float* p) { const f32x4 a = *(const f32x4*)p, b = *(const f32x4*)(p + 4); u32x4 o; o.x = pk2(a[0], a[1]); o.y = pk2(a[2], a[3]); o.z = pk2(b[0], b[1]); o.w = pk2(b[2], b[3]); return o; }

__device__ __forceinline__ void phase_prep(int l, LAS unsigned char* lds, const int wv) {
    int tid_ = wv * 64 + lane_id_fresh(); asm volatile("" : "+v"(tid_));     const int lane = tid_ & 63, wave = __builtin_amdgcn_readfirstlane(tid_ >> 6);
    unsigned char* ws = ldws(lds);
    LAS float* scr = (LAS float*)(lds + wave * 16640);
    const int gw = blockIdx.x * 8 + wave, NGW = gridDim.x * 8;
    constexpr int C_FA = (D / 64) * (DFF / 64), C_FD = (DFF / 64) * (D / 64), C_IN = (D / 64) * (INW / 64), C_G = (D / 64) * (3 * D / 64), C_UQ = (QL / 64) * (D / 64), C_UQR = (QL / 64) * (1024 / 64),
                  C_UK = (KVL / 64) * (D / 64), C_PL = 4 * 2 * 8, C_MK = (D / 64) * (512 / 64), C_MV = (D / 64) * (D / 64), C_WO = (D / 64) * (D / 64), C_ZIG = 192, C_ZPL = D;
    constexpr int NITEMS = 4 * C_FA + 2 * C_FD + C_IN + C_G + C_UQ + C_UQR + 2 * C_UK + C_PL + C_MK + C_MV + C_WO + C_ZIG + C_ZPL;
    for (int it = gw; it < NITEMS; it += NGW) {
        int r = it;
        if (r < C_FA) { tr_item(ldp(lds, I_F1G) + (size_t)l * D * DFF, DFF, ldp(lds, I_F1N) + l * D, (bf16*)(ws + WS_W1A), D, 1, r, scr, lane); continue; } r -= C_FA;
        if (r < C_FA) { tr_item(ldp(lds, I_F1U) + (size_t)l * D * DFF, DFF, ldp(lds, I_F1N) + l * D, (bf16*)(ws + WS_W1A), D, 2, r, scr, lane); continue; } r -= C_FA;
        if (r < C_FD) { tr_item(ldp(lds, I_F1D) + (size_t)l * D * DFF, D, nullptr, (bf16*)(ws + WS_W1D), DFF, 0, r, scr, lane); continue; } r -= C_FD;
        if (r < C_FA) { tr_item(ldp(lds, I_F2G) + (size_t)l * D * DFF, DFF, ldp(lds, I_F2N) + l * D, (bf16*)(ws + WS_W2A), D, 1, r, scr, lane); continue; } r -= C_FA;
        if (r < C_FA) { tr_item(ldp(lds, I_F2U) + (size_t)l * D * DFF, DFF, ldp(lds, I_F2N) + l * D, (bf16*)(ws + WS_W2A), D, 2, r, scr, lane); continue; } r -= C_FA;
        if (r < C_FD) { tr_item(ldp(lds, I_F2D) + (size_t)l * D * DFF, D, nullptr, (bf16*)(ws + WS_W2D), DFF, 0, r, scr, lane); continue; } r -= C_FD;
        if (r < C_IN) { tr_item(ldp(lds, I_WIN) + (size_t)l * D * INW, INW, ldp(lds, I_MIXN) + l * D, (bf16*)(ws + WS_WIG), D, 0, r, scr, lane); continue; } r -= C_IN;
        if (r < C_G) { tr_item(ldp(lds, I_WG) + (size_t)l * D * 3 * D, 3 * D, ldp(lds, I_MIXN) + l * D, (bf16*)(ws + WS_WIG) + (size_t)D * D, D, 0, r, scr, lane); continue; } r -= C_G;
        if (r < C_UQ) { tr_item(ldp(lds, I_WUQ) + (size_t)l * QL * D, D, nullptr, (bf16*)(ws + WS_WUQ), QL, 0, r, scr, lane); continue; } r -= C_UQ;
        if (r < C_UQR) { tr_item(ldp(lds, I_WUQR) + (size_t)l * QL * 1024, 1024, nullptr, (bf16*)(ws + WS_WUQ) + (size_t)D * QL, QL, 0, r, scr, lane); continue; } r -= C_UQR;
        if (r < C_UK) { tr_item(ldp(lds, I_WUK) + (size_t)l * KVL * D, D, nullptr, (bf16*)(ws + WS_WKV), KVL, 0, r, scr, lane); continue; } r -= C_UK;
        if (r < C_UK) { tr_item(ldp(lds, I_WUV) + (size_t)l * KVL * D, D, nullptr, (bf16*)(ws + WS_WKV) + (size_t)D * KVL, KVL, 0, r, scr, lane); continue; } r -= C_UK;
        if (r < C_PL) { const int g = r >> 4; tr_item(ldp(lds, I_POOLW) + ((size_t)l * 4 + g) * 128 * 512, 512, nullptr, (bf16*)(ws + WS_WPL) + (size_t)(g * 512) * PWD + g * 128, PWD, 0, r & 15, scr, lane); continue; } r -= C_PL;
        if (r < C_MK) { tr_item(ldp(lds, I_WMK) + (size_t)l * D * 512, 512, nullptr, (bf16*)(ws + WS_WMK), D, 0, r, scr, lane); continue; } r -= C_MK;
        if (r < C_MV) { tr_item(ldp(lds, I_WMV) + (size_t)l * D * D, D, nullptr, (bf16*)(ws + WS_WMK) + (size_t)512 * D, D, 0, r, scr, lane); continue; } r -= C_MV;
        if (r < C_WO) { tr_item(ldp(lds, I_WOUT) + (size_t)l * D * D, D, nullptr, (bf16*)(ws + WS_WO), D, 0, r, scr, lane); continue; } r -= C_WO;
        if (r < C_ZIG) { u32x4* o = (u32x4*)((bf16*)(ws + WS_WIG) + (size_t)(INW + r) * D) + lane; const u32x4 z = {0u, 0u, 0u, 0u}; o[0] = z; o[64] = z; o[128] = z; o[192] = z; continue; } r -= C_ZIG;
        { if ((lane >> 4) != (r >> 9)) { const u32x4 z = {0u, 0u, 0u, 0u}; *((u32x4*)((bf16*)(ws + WS_WPL) + (size_t)r * PWD) + lane) = z; } }
    }
    const size_t tix = (size_t)gw * 64 + lane, tst = (size_t)NGW * 64;
    { const float* src = ldp(lds, I_CCKV) + (size_t)l * DB * PAST * KVL; bf16* dst = (bf16*)(ws + WS_CKV);
      for (size_t e0 = tix; e0 < (size_t)DB * PAST * (KVL / 8); e0 += 4 * tst) { u32x4 t[4];
#pragma unroll
          for (int q = 0; q < 4; ++q) { const size_t e = e0 + q * tst; if (e < (size_t)DB * PAST * (KVL / 8)) t[q] = cvt8(src + e * 8); }
#pragma unroll
          for (int q = 0; q < 4; ++q) { const size_t e = e0 + q * tst; if (e < (size_t)DB * PAST * (KVL / 8)) { const size_t row = e >> 5, c8 = e & 31, b = row >> 12, s = row & 4095; *(u32x4*)(dst + ((size_t)MP + b * SKS + s) * KVL + c8 * 8) = t[q]; } } } }
    { const float* src = ldp(lds, I_CKR) + (size_t)l * DB * PAST * RD; bf16* dst = (bf16*)(ws + WS_KRS);
      for (size_t e0 = tix; e0 < (size_t)DB * PAST * (RD / 8); e0 += 4 * tst) { u32x4 t[4];
#pragma unroll
          for (int q = 0; q < 4; ++q) { const size_t e = e0 + q * tst; if (e < (size_t)DB * PAST * (RD / 8)) t[q] = cvt8(src + e * 8); }
#pragma unroll
          for (int q = 0; q < 4; ++q) { const size_t e = e0 + q * tst; if (e < (size_t)DB * PAST * (RD / 8)) { const size_t row = e >> 3, c8 = e & 7, b = row >> 12, s = row & 4095; *(u32x4*)(dst + (b * SKS + s) * RD + c8 * 8) = t[q]; } } } }
    { const float* src = ldp(lds, I_CMK) + (size_t)l * DB * NMEM * 512; bf16* dst = (bf16*)(ws + WS_MEMKS);
      for (size_t e0 = tix; e0 < (size_t)DB * NMEM * 512 / 8; e0 += 4 * tst) { u32x4 t[4];
#pragma unroll
          for (int q = 0; q < 4; ++q) { const size_t e = e0 + q * tst; if (e < (size_t)DB * NMEM * 512 / 8) t[q] = cvt8(src + e * 8); }
#pragma unroll
          for (int q = 0; q < 4; ++q) { const size_t e = e0 + q * tst; if (e < (size_t)DB * NMEM * 512 / 8) *(u32x4*)(dst + e * 8) = t[q]; } } }
    { const float* src = ldp(lds, I_CMV) + (size_t)l * DB * NMEM * D; bf16* dst = (bf16*)(ws + WS_MEMVS);
      for (size_t e0 = tix; e0 < (size_t)DB * NMEM * D / 8; e0 += 4 * tst) { u32x4 t[4];
#pragma unroll
          for (int q = 0; q < 4; ++q) { const size_t e = e0 + q * tst; if (e < (size_t)DB * NMEM * D / 8) t[q] = cvt8(src + e * 8); }
#pragma unroll
          for (int q = 0; q < 4; ++q) { const size_t e = e0 + q * tst; if (e < (size_t)DB * NMEM * D / 8) *(u32x4*)(dst + e * 8) = t[q]; } } }
    { const float* mn = ldp(lds, I_MEMN) + l * D; const float* memp = ldp(lds, I_MEMP); bf16* MBp = (bf16*)(ws + WS_MB);
      for (int row = gw; row < NMEM; row += NGW) { const float* x = memp + (size_t)row * D; f32x4 v[8]; float ss = 0.f;
#pragma unroll
          for (int j = 0; j < 8; ++j) { v[j] = *(const f32x4*)(x + j * 256 + lane * 4); ss += pg8::dot4(v[j]); }
          const float r = rsqrtf(wave_sum(ss) * (1.0f / D) + EPS);
#pragma unroll
          for (int j = 0; j < 8; ++j) { const f32x4 g = *(const f32x4*)(mn + j * 256 + lane * 4); const f32x4 y = v[j] * r * g; u32x2 o; o.x = pk2(y[0], y[1]); o.y = pk2(y[2], y[3]); *(u32x2*)(MBp + (size_t)row * D + j * 256 + lane * 4) = o; } } }
    if (l == 0) {
        bf16* XB = (bf16*)(ws + WS_XB); float* RS = (float*)(ws + WS_RS); const float* xp = ldp(lds, I_XP); const float* xs = ldp(lds, I_XS);
        for (int row = gw; row < M; row += NGW) { const float* x = row < MP ? xp + (size_t)row * D : xs + (size_t)(row - MP) * D; float ss = 0.f;
#pragma unroll
            for (int j = 0; j < 8; ++j) { const f32x4 v = *(const f32x4*)(x + j * 256 + lane * 4); ss += pg8::dot4(v); u32x2 o; o.x = pk2(v[0], v[1]); o.y = pk2(v[2], v[3]); *(u32x2*)(XB + (size_t)row * D + j * 256 + lane * 4) = o; }
            ss = wave_sum(ss); if (lane < 32) RS[(size_t)row * 32 + lane] = lane == 0 ? ss : 0.f; }
        f32x2* tab = (f32x2*)(ws + WS_ROPE);
        for (size_t e = tix; e < (size_t)MP * 32; e += tst) { const int pos = (int)(e >> 5), i = (int)(e & 31);
            const double ang = (double)pos * ((const LAS double*)(lds + PT_INV))[i]; const double n = __builtin_rint(ang * 0.15915494309189535); const double rr = __builtin_fma(-n, 6.283185307179586, ang) - n * 2.4492935982947064e-16;
            const double x2 = rr * rr; double sn = 0.0, cs = 0.0;
#pragma unroll
            for (int k = 14; k >= 1; --k) { sn = (sn + 1.0) * (x2 * (-1.0 / (double)((2 * k) * (2 * k + 1)))); cs = (cs + 1.0) * (x2 * (-1.0 / (double)((2 * k - 1) * (2 * k)))); }
            sn = (sn + 1.0) * rr; cs = cs + 1.0;
            tab[e] = (f32x2){(float)cs, (float)sn}; }
    }
}

__device__ __forceinline__ void phase_post(int l, LAS unsigned char* lds, const int wv) {
    int tid_ = wv * 64 + lane_id_fresh(); asm volatile("" : "+v"(tid_));     const int lane = tid_ & 63, wave = __builtin_amdgcn_readfirstlane(tid_ >> 6);
    unsigned char* ws = ldws(lds); const int gw = blockIdx.x * 8 + wave, NGW = gridDim.x * 8;
    const float* INP = (const float*)(ws + WS_INPROJ); const f32x2* tab = (const f32x2*)(ws + WS_ROPE);
    bf16* CQ = (bf16*)(ws + WS_CQ); bf16* CKV = (bf16*)(ws + WS_CKV); bf16* KRP = (bf16*)(ws + WS_KRP); bf16* KRS = (bf16*)(ws + WS_KRS); bf16* POOLED = (bf16*)(ws + WS_POOLED); bf16* QM = (bf16*)(ws + WS_QM);
    const float* qln = ldp(lds, I_QLN) + l * QL; const float* kvln = ldp(lds, I_KVLN) + l * KVL; const float* krn = ldp(lds, I_KRN) + l * RD; const float* mqn = ldp(lds, I_MQN) + l * 128;
    float* out = ldout(lds); const float* spool = ldp(lds, I_SPOOL); const float* mkn = ldp(lds, I_MKN) + l * 128;
    const f32x4 gq0 = *(const f32x4*)(qln + 8 * lane), gq1 = *(const f32x4*)(qln + 8 * lane + 4), gkv = *(const f32x4*)(kvln + 4 * lane);
    const f32x4 gm0 = *(const f32x4*)(mqn + ((8 * lane) & 127)), gm1 = *(const f32x4*)(mqn + ((8 * lane) & 127) + 4); const float gkr = krn[lane];
    const int NBLK = M / 4;
    for (int blk = gw; blk < NBLK + NMEM; blk += NGW) {
        if (blk >= NBLK) {
            const int j = blk - NBLK; const float* raw = (const float*)(ws + WS_MKVRAW) + (size_t)j * 2560;
            { const f32x4 a = *(const f32x4*)(raw + 8 * lane), b = *(const f32x4*)(raw + 8 * lane + 4); const float r = rsqrtf(sum16(pg8::dot4(a) + pg8::dot4(b)) * (1.0f / 128) + EPS);
              const f32x4 g0 = *(const f32x4*)(mkn + ((8 * lane) & 127)), g1 = *(const f32x4*)(mkn + ((8 * lane) & 127) + 4); const f32x4 y0 = a * r * g0, y1 = b * r * g1;
              float* o = out + O_MKP + ((size_t)l * NMEM + j) * 512 + 8 * lane; *(f32x4*)o = y0; *(f32x4*)(o + 4) = y1;
              *(u32x4*)((bf16*)(ws + WS_MEMKP) + (size_t)j * 512 + 8 * lane) = pg8::pack8(y0, y1); }
#pragma unroll
            for (int q = 0; q < 4; ++q) { const f32x4 a = *(const f32x4*)(raw + 512 + q * 512 + 8 * lane), b = *(const f32x4*)(raw + 512 + q * 512 + 8 * lane + 4);
              float* o = out + O_MVP + ((size_t)l * NMEM + j) * D + q * 512 + 8 * lane; *(f32x4*)o = a; *(f32x4*)(o + 4) = b;
              *(u32x4*)((bf16*)(ws + WS_MEMVP) + (size_t)j * D + q * 512 + 8 * lane) = pg8::pack8(a, b); }
            continue;
        }
        const int r0 = blk * 4; const bool samp = r0 >= MP; const int b = samp ? (r0 - MP) >> 6 : 0; const int s0 = samp ? MP + b * DS : 0; const int t0 = r0 - s0;
        const int w = 2 << (lane >> 4);
        f32x4 acc[4][2], cur[4][2];
#pragma unroll
        for (int k = 0; k < 4; ++k) { acc[k][0] = (f32x4){0.f, 0.f, 0.f, 0.f}; acc[k][1] = acc[k][0]; cur[k][0] = acc[k][0]; cur[k][1] = acc[k][0]; }
        for (int dj = 0; dj < 19; ++dj) { const int t = t0 + 3 - dj;
            if (dj < w + 3) { f32x4 a = {0.f, 0.f, 0.f, 0.f}, bb = a;
                if (t >= 0) { const float* src = INP + (size_t)(s0 + t) * D + 832 + 8 * lane; a = *(const f32x4*)src; bb = *(const f32x4*)(src + 4); }
                else if (samp) { const float* src = spool + (((size_t)l * DB + b) * PPAD + (PPAD + t)) * PWD + 8 * lane; a = *(const f32x4*)src; bb = *(const f32x4*)(src + 4); }
#pragma unroll
                for (int k = 0; k < 4; ++k) { const int d = k - (3 - dj);
                    if (d >= 0 && d < w) { acc[k][0] += a; acc[k][1] += bb; } if (d == 0) { cur[k][0] = a; cur[k][1] = bb; } } } }
#pragma unroll
        for (int k = 0; k < 4; ++k) { const int t = t0 + k; const int cnt = samp ? w : (t + 1 < w ? t + 1 : w); const float ic = 1.0f / (float)cnt;
            *(u32x4*)(POOLED + (size_t)(r0 + k) * PWD + 8 * lane) = pg8::pack8(acc[k][0] * ic - cur[k][0], acc[k][1] * ic - cur[k][1]);
            const int T = samp ? DS : MP;
            if (t >= T - PPAD) { float* o = samp ? out + O_POOLS + (((size_t)l * DB + b) * PPAD + (t - (T - PPAD))) * PWD + 8 * lane : out + O_POOLP + ((size_t)l * PPAD + (t - (T - PPAD))) * PWD + 8 * lane;
                *(f32x4*)o = cur[k][0]; *(f32x4*)(o + 4) = cur[k][1]; } }
#pragma unroll 1
        for (int k = 0; k < 4; ++k) { const int row = r0 + k, t = t0 + k; const float* ip = INP + (size_t)row * D;
            { const f32x4 a = *(const f32x4*)(ip + 8 * lane), bb = *(const f32x4*)(ip + 8 * lane + 4); const float r = rsqrtf(wave_sum(pg8::dot4(a) + pg8::dot4(bb)) * (1.0f / QL) + EPS);
              *(u32x4*)(CQ + (size_t)row * QL + 8 * lane) = pg8::pack8(a * r * gq0, bb * r * gq1); }
            { const f32x4 a = *(const f32x4*)(ip + 512 + 4 * lane); const float r = rsqrtf(wave_sum(pg8::dot4(a)) * (1.0f / KVL) + EPS); const f32x4 y = a * r * gkv;
              float* o = samp ? out + O_CKVS + ((size_t)l * MS + (row - MP)) * KVL + 4 * lane : out + O_CKVP + ((size_t)l * MP + row) * KVL + 4 * lane; *(f32x4*)o = y;
              const size_t crow = samp ? (size_t)MP + (size_t)b * SKS + PAST + t : (size_t)row; u32x2 o2; o2.x = pk2(y[0], y[1]); o2.y = pk2(y[2], y[3]); *(u32x2*)(CKV + crow * KVL + 4 * lane) = o2; }
            { const float x = ip[768 + lane]; const float r = rsqrtf(wave_sum(x * x) * (1.0f / RD) + EPS); const float v = x * r * gkr; const float pv = other_x32(v, lane >= 32);
              const int pos = samp ? PAST + t : t; const f32x2 cs = tab[(size_t)pos * 32 + (lane & 31)];
              const float y = lane < 32 ? v * cs.x - pv * cs.y : pv * cs.y + v * cs.x;
              float* o = samp ? out + O_KRS + ((size_t)l * MS + (row - MP)) * RD + lane : out + O_KRP + ((size_t)l * MP + row) * RD + lane; *o = y;
              bf16* ko = samp ? KRS + ((size_t)b * SKS + PAST + t) * RD + lane : KRP + (size_t)row * RD + lane; *ko = (bf16)(pk2(y, 0.f) & 0xffffu); }
            { const f32x4 a = *(const f32x4*)(ip + 1344 + 8 * lane), bb = *(const f32x4*)(ip + 1344 + 8 * lane + 4); const float r = rsqrtf(sum16(pg8::dot4(a) + pg8::dot4(bb)) * (1.0f / 128) + EPS);
              *(u32x4*)(QM + (size_t)row * MQD + 8 * lane) = pg8::pack8(a * r * gm0, bb * r * gm1); }
        }
    }
}

__device__ __forceinline__ void attn_store(att::f32x16* o, float l_reg, const bf16* gate, bf16* merged, bool store, float* li_l, int r32, int hi) {
    if (hi == 0) li_l[r32] = l_reg; LDS_WAIT();
    if (store) {
#pragma unroll
        for (int r = 0; r < 16; ++r) { const int row = att::crow(r, hi); const float rl = __builtin_amdgcn_rcpf(li_l[row]);
#pragma unroll
            for (int d0 = 0; d0 < 4; ++d0) { const size_t idx = (size_t)row * D + d0 * 32 + r32; const float g = __uint_as_float((unsigned)gate[idx] << 16), mo = __uint_as_float((unsigned)merged[idx] << 16);
                merged[idx] = (bf16)(pk2(mo + g * o[d0][r] * rl, 0.f) & 0xffffu); }
            asm volatile("" ::: "memory"); } }
}
__device__ __forceinline__ void phase_mematt(int l, LAS unsigned char* ldsl, char* lds, const int wv) {
    int tid_ = wv * 64 + lane_id_fresh(); asm volatile("" : "+v"(tid_));     const int lane = tid_ & 63, wave = __builtin_amdgcn_readfirstlane(tid_ >> 6);
    unsigned char* ws = ldws(ldsl); const int r32 = lane & 31, hi = lane >> 5;
    const bf16* QM = (const bf16*)(ws + WS_QM); const bf16* GM = (const bf16*)(ws + WS_GM); bf16* MERGED = (bf16*)(ws + WS_MERGED);
    float* li_l = (float*)(lds + 2 * 16384 + 2 * 16384) + wave * 64;
    const float C = 0.08838834764831845f * LOG2E;
    for (int it = blockIdx.x; it < 1024 + 256; it += gridDim.x) {
        const bool samp = it >= 1024; const int ii = samp ? it - 1024 : it; const int hc = ii & 15, h = hc >> 2, c = hc & 3, qb = ii >> 4;
        const int rowbase = samp ? MP + qb * DS + (wave & 1) * 32 : qb * 256 + wave * 32;
        const bf16* Kb = samp ? (const bf16*)(ws + WS_MEMKS) + (size_t)qb * NMEM * 512 + h * 128 : (const bf16*)(ws + WS_MEMKP) + h * 128;
        const bf16* Vb = samp ? (const bf16*)(ws + WS_MEMVS) + (size_t)qb * NMEM * D + h * 512 + c * 128 : (const bf16*)(ws + WS_MEMVP) + h * 512 + c * 128;
        att::bf16x8 qr[8];
        const bf16* qp = QM + (size_t)(rowbase + r32) * MQD + h * 128 + hi * 8;
#pragma unroll
        for (int d0 = 0; d0 < 8; ++d0) qr[d0] = *(const att::bf16x8*)(qp + d0 * 16);
        att::f32x16 o[4] = {}; float l_reg;
        int nt = 4; asm volatile("" : "+s"(nt)); att::attn_item<128, ATT_SD_MEM, 512, D>(qr, Kb, nullptr, Vb, nt, nt, nt, C, lds, o, l_reg, wv);
        const size_t ob = (size_t)rowbase * D + h * 512 + c * 128;
        attn_store(o, l_reg, GM + ob, MERGED + ob, !samp || wave < 2, li_l, r32, hi);
        __syncthreads();
    }
}
__device__ __forceinline__ void main_attn_item(int l, LAS unsigned char* ldsl, char* lds, bool samp, int qb_or_b, int h, const int wv) {
    int tid_ = wv * 64 + lane_id_fresh(); asm volatile("" : "+v"(tid_));     const int lane = tid_ & 63, wave = __builtin_amdgcn_readfirstlane(tid_ >> 6);
    unsigned char* ws = ldws(ldsl); const int r32 = lane & 31, hi = lane >> 5;
    const bf16* QRAW = (const bf16*)(ws + WS_QRAW); const bf16* GA = (const bf16*)(ws + WS_GA); bf16* MERGED = (bf16*)(ws + WS_MERGED); const f32x2* tab = (const f32x2*)(ws + WS_ROPE);
    float* li_l = (float*)(lds + 2 * 16384 + 2 * 24576) + wave * 64;
    const float C = 0.07216878364870322f * LOG2E;
    const int rowbase = samp ? MP + qb_or_b * DS + (wave & 1) * 32 : qb_or_b * 256 + wave * 32;
    const int row = rowbase + r32; const int pos = samp ? PAST + (row - MP - qb_or_b * DS) : row;
    att::bf16x8 qr[8]; char* qrl = lds + 2 * 16384 + 2 * 24576 + 2048 + wave * 4096 + lane * 16;
    { const bf16* qn = QRAW + (size_t)row * 3072 + h * 128 + hi * 8; const bf16* qrp = QRAW + (size_t)row * 3072 + D + h * 64 + hi * 8;
      const float* gn = ldp(ldsl, I_QN) + l * 128 + hi * 8; const float* gr = ldp(ldsl, I_QRN) + l * 64 + hi * 8;
      u32x4 rn[8]; float ss = 0.f;
#pragma unroll
      for (int d0 = 0; d0 < 8; ++d0) { rn[d0] = *(const u32x4*)(qn + d0 * 16);
#pragma unroll
          for (int q = 0; q < 4; ++q) { const float a = att::bflo(rn[d0][q]), bb = att::bfhi(rn[d0][q]); ss += a * a + bb * bb; } }
      ss = sum_x32(ss); const float rs_n = rsqrtf(ss * (1.0f / 128) + EPS);
#pragma unroll
      for (int d0 = 0; d0 < 8; ++d0) { const f32x4 g0 = *(const f32x4*)(gn + d0 * 16), g1 = *(const f32x4*)(gn + d0 * 16 + 4); u32x4 w;
          w.x = pk2(att::bflo(rn[d0].x) * rs_n * g0[0], att::bfhi(rn[d0].x) * rs_n * g0[1]); w.y = pk2(att::bflo(rn[d0].y) * rs_n * g0[2], att::bfhi(rn[d0].y) * rs_n * g0[3]);
          w.z = pk2(att::bflo(rn[d0].z) * rs_n * g1[0], att::bfhi(rn[d0].z) * rs_n * g1[1]); w.w = pk2(att::bflo(rn[d0].w) * rs_n * g1[2], att::bfhi(rn[d0].w) * rs_n * g1[3]);
          qr[d0] = *reinterpret_cast<att::bf16x8*>(&w); }
      u32x4 rr[4]; float sr = 0.f;
#pragma unroll
      for (int d = 0; d < 4; ++d) { rr[d] = *(const u32x4*)(qrp + d * 16);
#pragma unroll
          for (int q = 0; q < 4; ++q) { const float a = att::bflo(rr[d][q]), bb = att::bfhi(rr[d][q]); sr += a * a + bb * bb; } }
      sr = sum_x32(sr); const float rs_r = rsqrtf(sr * (1.0f / 64) + EPS);
#pragma unroll
      for (int d = 0; d < 2; ++d) { float x1[8], x2[8], y1[8], y2[8];
          const f32x4 ga0 = *(const f32x4*)(gr + d * 16), ga1 = *(const f32x4*)(gr + d * 16 + 4), gb0 = *(const f32x4*)(gr + 32 + d * 16), gb1 = *(const f32x4*)(gr + 32 + d * 16 + 4);
#pragma unroll
          for (int q = 0; q < 4; ++q) { x1[2 * q] = att::bflo(rr[d][q]) * rs_r * (q < 2 ? ga0[2 * q] : ga1[2 * q - 4]); x1[2 * q + 1] = att::bfhi(rr[d][q]) * rs_r * (q < 2 ? ga0[2 * q + 1] : ga1[2 * q - 3]);
                                        x2[2 * q] = att::bflo(rr[d + 2][q]) * rs_r * (q < 2 ? gb0[2 * q] : gb1[2 * q - 4]); x2[2 * q + 1] = att::bfhi(rr[d + 2][q]) * rs_r * (q < 2 ? gb0[2 * q + 1] : gb1[2 * q - 3]); }
          const f32x4* tp = (const f32x4*)(tab + (size_t)pos * 32 + d * 16 + hi * 8);
#pragma unroll
          for (int q = 0; q < 4; ++q) { const f32x4 cs = tp[q];
              y1[2 * q] = x1[2 * q] * cs[0] - x2[2 * q] * cs[1]; y2[2 * q] = x1[2 * q] * cs[1] + x2[2 * q] * cs[0];
              y1[2 * q + 1] = x1[2 * q + 1] * cs[2] - x2[2 * q + 1] * cs[3]; y2[2 * q + 1] = x1[2 * q + 1] * cs[3] + x2[2 * q + 1] * cs[2]; }
          u32x4 w1, w2; w1.x = pk2(y1[0], y1[1]); w1.y = pk2(y1[2], y1[3]); w1.z = pk2(y1[4], y1[5]); w1.w = pk2(y1[6], y1[7]);
          w2.x = pk2(y2[0], y2[1]); w2.y = pk2(y2[2], y2[3]); w2.z = pk2(y2[4], y2[5]); w2.w = pk2(y2[6], y2[7]);
          *(u32x4*)(qrl + d * 1024) = w1; *(u32x4*)(qrl + (2 + d) * 1024) = w2; }
    }
    const bf16* Kn; const bf16* Kr; const bf16* Vh; int NT, NTR, tlim;
    if (samp) { const int bl = qb_or_b & (CHB - 1); Kn = (const bf16*)(ws + WS_KS) + (size_t)bl * SKS * D + h * 128; Vh = (const bf16*)(ws + WS_VS) + (size_t)bl * SKS * D + h * 128;
                Kr = (const bf16*)(ws + WS_KRS) + (size_t)qb_or_b * SKS * RD; NT = 66; NTR = 65; tlim = 65; }
    else { Kn = (const bf16*)(ws + WS_KP) + h * 128; Vh = (const bf16*)(ws + WS_VP) + h * 128; Kr = (const bf16*)(ws + WS_KRP); NT = 4 * qb_or_b + 4; NTR = NT; tlim = 4 * qb_or_b + (wave >> 1) + 1; }
    att::f32x16 o[4] = {}; float l_reg;
    att::attn_item<192, ATT_SD_MAIN, D, D>(qr, Kn, Kr, Vh, NT, NTR, tlim, C, lds, o, l_reg, wv);
    const size_t ob = (size_t)rowbase * D + h * 128;
    attn_store(o, l_reg, GA + ob, MERGED + ob, !samp || wave < 2, li_l, r32, hi);
    __syncthreads();
}
__device__ __forceinline__ void phase_attn(int l, int half, LAS unsigned char* ldsl, char* lds, const int wv) {
    const int w = blockIdx.x, pp = half * 256 + w, h = pp & 15, x = pp >> 4, si = half == 0 ? w : w - 128;
    const int nit = (w < 256 ? 2 : 0) + ((si >= 0 && si < 128 && w < 256) ? 1 : 0);
#pragma unroll 1
    for (int it = 0; it < nit; ++it) {
        const bool samp = it == 2; const int qb = samp ? half * CHB + (si >> 4) : (it == 0 ? 63 - x : x); const int hh = samp ? (si & 15) : h;
        main_attn_item(l, ldsl, lds, samp, qb, hh, wv);
    }
}
#ifndef PHMASK
#define PHMASK 0xFFFF
#endif
#define GEMM_PHASE(EpiT, E, Ap, Bp, Mr, Nc, Kd) do { pg8::Gemm g_{(const pg8::bf16_t*)(Ap), (const pg8::bf16_t*)(Bp), (Mr), (Nc), (Kd)}; pg8::StaticOrder S_; S_.init((Mr), (Nc), G, (int)blockIdx.x); \
        pg8::gemm_phase<EpiT, pg8::StaticOrder, true, true>(lds, g_, S_, E, wv); } while (0)
template <int l> __device__ __forceinline__ void layer_program(LAS unsigned char* lds, unsigned char* lds_raw, const XcdBarrier& bar, const int lo, const int hi, const int G, const int wv) {
        const int pb = l * NPH;
#define WSP ldws(lds)
#define RP (ldout(lds) + O_Y)
#define IN(k) (((PHMASK >> (k)) & 1) && lo <= pb + (k) && pb + (k) < hi)
#define SEAM(k) do { if (pb + (k) + 1 < hi) xcd_barrier(bar); } while (0)
        if (IN(PH_PREP)) { phase_prep(l, lds, wv); SEAM(PH_PREP); }
        if (IN(PH_MEMKV)) { unsigned char* ws = WSP; pg8::EpiStoreF32 E{(float*)(ws + WS_MKVRAW), 2560}; GEMM_PHASE(pg8::EpiStoreF32, E, ws + WS_MB, ws + WS_WMK, NMEM, 2560, D); SEAM(PH_MEMKV); }
        if (IN(PH_F1A)) { unsigned char* ws = WSP; pg8::EpiSwiGLU E{(bf16*)(ws + WS_ACT), (const float*)(ws + WS_RS)}; GEMM_PHASE(pg8::EpiSwiGLU, E, ws + WS_XB, ws + WS_W1A, M, 2 * DFF, D); SEAM(PH_F1A); }
        if (IN(PH_F1D)) { unsigned char* ws = WSP; float* R = RP; pg8::EpiResid E{l == 0 ? ldp(lds, I_XP) : R, l == 0 ? ldp(lds, I_XS) : R + (size_t)MP * D, R, (bf16*)(ws + WS_XB), (float*)(ws + WS_RS), 0.5f}; GEMM_PHASE(pg8::EpiResid, E, ws + WS_ACT, ws + WS_W1D, M, D, DFF); SEAM(PH_F1D); }
        if (IN(PH_ING)) { unsigned char* ws = WSP; pg8::EpiInGate E{(float*)(ws + WS_INPROJ), (bf16*)(ws + WS_GA), (const float*)(ws + WS_RS), ldp(lds, I_BG) + (size_t)l * 3 * D};
            GEMM_PHASE(pg8::EpiInGate, E, ws + WS_XB, ws + WS_WIG, M, 8192, D); SEAM(PH_ING); }
        if (IN(PH_POST)) { phase_post(l, lds, wv); SEAM(PH_POST); }
        if (IN(PH_POOL)) { unsigned char* ws = WSP;
#ifdef DBG_POOL_STORE
            pg8::EpiStore E{(bf16*)(ws + WS_MERGED), D}; GEMM_PHASE(pg8::EpiStore, E, ws + WS_POOLED, ws + WS_WPL, M, D, PWD);
#else
            pg8::EpiPool E{(const bf16*)(ws + WS_GP), (bf16*)(ws + WS_MERGED), ldp(lds, I_POOLS) + (size_t)l * D}; GEMM_PHASE(pg8::EpiPool, E, ws + WS_POOLED, ws + WS_WPL, M, D, PWD);
#endif
 SEAM(PH_POOL); }
        if (IN(PH_MEMATT)) { phase_mematt(l, lds, (char*)lds_raw, wv); SEAM(PH_MEMATT); }
        if (IN(PH_UQ)) { unsigned char* ws = WSP; pg8::EpiStore E{(bf16*)(ws + WS_QRAW), 3072}; GEMM_PHASE(pg8::EpiStore, E, ws + WS_CQ, ws + WS_WUQ, M, 3072, QL); SEAM(PH_UQ); }
        if (IN(PH_KV0)) { unsigned char* ws = WSP; pg8::EpiKV E{(bf16*)(ws + WS_KP), (bf16*)(ws + WS_VP), (bf16*)(ws + WS_KS), (bf16*)(ws + WS_VS), MP, ldp(lds, I_KN) + l * 128, (LAS float*)(lds + LDSX_OFF)};
            GEMM_PHASE(pg8::EpiKV, E, ws + WS_CKV, ws + WS_WKV, MP + CHROWS, 4096, KVL); SEAM(PH_KV0); }
        if (IN(PH_ATT0)) { phase_attn(l, 0, lds, (char*)lds_raw, wv); SEAM(PH_ATT0); }
        if (IN(PH_KV1)) { unsigned char* ws = WSP; pg8::EpiKV E{(bf16*)(ws + WS_KS), (bf16*)(ws + WS_VS), (bf16*)(ws + WS_KS), (bf16*)(ws + WS_VS), 0, ldp(lds, I_KN) + l * 128, (LAS float*)(lds + LDSX_OFF)};
            GEMM_PHASE(pg8::EpiKV, E, (const bf16*)(ws + WS_CKV) + (size_t)(MP + CHROWS) * KVL, ws + WS_WKV, CHROWS, 4096, KVL); SEAM(PH_KV1); }
        if (IN(PH_ATT1)) { phase_attn(l, 1, lds, (char*)lds_raw, wv); SEAM(PH_ATT1); }
        if (IN(PH_WO)) { unsigned char* ws = WSP; float* R = RP; pg8::EpiResid E{R, R + (size_t)MP * D, R, (bf16*)(ws + WS_XB), (float*)(ws + WS_RS), 1.0f}; GEMM_PHASE(pg8::EpiResid, E, ws + WS_MERGED, ws + WS_WO, M, D, D); SEAM(PH_WO); }
        if (IN(PH_F2A)) { unsigned char* ws = WSP; pg8::EpiSwiGLU E{(bf16*)(ws + WS_ACT), (const float*)(ws + WS_RS)}; GEMM_PHASE(pg8::EpiSwiGLU, E, ws + WS_XB, ws + WS_W2A, M, 2 * DFF, D); SEAM(PH_F2A); }
        if (IN(PH_F2D)) { unsigned char* ws = WSP; float* R = RP; pg8::EpiResid E{R, R + (size_t)MP * D, R, (bf16*)(ws + WS_XB), (float*)(ws + WS_RS), 0.5f}; GEMM_PHASE(pg8::EpiResid, E, ws + WS_ACT, ws + WS_W2D, M, D, DFF); SEAM(PH_F2D); }
#undef IN
#undef SEAM
#undef WSP
#undef RP
}
__global__ void __launch_bounds__(512, 2) mega_fwd(Params p) {
    extern __shared__ __attribute__((aligned(16))) unsigned char lds_raw[];
    LAS unsigned char* lds = (LAS unsigned char*)lds_raw;
    const int tid = threadIdx.x, wv = __builtin_amdgcn_readfirstlane(tid >> 6);
    const int G = gridDim.x;
    volatile LAS unsigned* MISC = (volatile LAS unsigned*)(lds + MISC_OFF);
    if (tid < 64) MISC[tid] = 0u;
    if (tid == 64) { LAS unsigned long long* t = (LAS unsigned long long*)(lds + PT_OFF);
#pragma unroll
        for (int i = 0; i < N_IN; ++i) t[i] = (unsigned long long)p.in[i];
        t[PT_OUT] = (unsigned long long)p.out; t[PT_WS] = (unsigned long long)p.ws;
        LAS double* iv = (LAS double*)(lds + PT_INV);
#pragma unroll
        for (int i = 0; i < 32; ++i) iv[i] = p.inv[i]; }
    __syncthreads();
    XcdBarrier bar = xcd_barrier_post((unsigned*)(p.ws + WS_CTL) + CW_BAR + p.li * XCD_BAR_WORDS, MISC + 8);
    const int lo = p.ph_lo, hi = p.ph_hi;
    layer_program<0>(lds, lds_raw, bar, lo, hi, G, wv);
    layer_program<1>(lds, lds_raw, bar, lo, hi, G, wv);
}


#ifdef DBG_COPY_OFF
__global__ void dbg_copy(const unsigned char* ws, unsigned char* out, size_t bytes) { for (size_t i = ((size_t)blockIdx.x * 256 + threadIdx.x) * 16; i < bytes; i += (size_t)gridDim.x * 256 * 16) *(uint4*)(out + i) = *(const uint4*)(ws + i); }
#endif
#ifndef MK_N_LAUNCHES
#define MK_N_LAUNCHES 1
#endif
extern "C" void kernel_launch(void* const* d_in, const int* in_sizes, int n_in, void* d_out, int out_size, void* d_ws, size_t ws_size, hipStream_t stream) {
    static int grid = 0;
    if (grid == 0) {
        if (n_in != N_IN || (size_t)out_size != O_END || ws_size < WS_END) { fprintf(stderr, "kernel_launch: built for %d inputs, %zu outputs, >= %zu bytes of workspace; got %d, %d, %zu; nothing launched\n", (int)N_IN, (size_t)O_END, (size_t)WS_END, n_in, out_size, ws_size); grid = -1; return; }
        int dev = 0, cus = 0, per_cu = 0;
        if (hipGetDevice(&dev) != hipSuccess || hipDeviceGetAttribute(&cus, hipDeviceAttributeMultiprocessorCount, dev) != hipSuccess) { fprintf(stderr, "kernel_launch: device query failed\n"); grid = -1; return; }
        if (hipFuncSetAttribute((const void*)mega_fwd, hipFuncAttributeMaxDynamicSharedMemorySize, LDS_BYTES) != hipSuccess) { fprintf(stderr, "kernel_launch: hipFuncSetAttribute failed\n"); grid = -1; return; }
        if (hipOccupancyMaxActiveBlocksPerMultiprocessor(&per_cu, (const void*)mega_fwd, 512, LDS_BYTES) != hipSuccess || per_cu < 1) fprintf(stderr, "kernel_launch: note: occupancy query reports %d workgroups per CU\n", per_cu);
        (void)hipGetLastError();
        grid = cus;
    }
    if (grid < 0) return;
#ifdef DBG_MEMSET_ALL
    (void)hipMemsetAsync((char*)d_ws, 0, WS_END, stream);
#endif
    if (hipMemsetAsync((char*)d_ws + WS_CTL, 0, CTL_BYTES, stream) != hipSuccess) { fprintf(stderr, "kernel_launch: memset failed\n"); return; }
    Params p{};
    for (int i = 0; i < N_IN; ++i) p.in[i] = (const float*)d_in[i];
    p.out = (float*)d_out; p.ws = (unsigned char*)d_ws;
    for (int i = 0; i < 32; ++i) p.inv[i] = std::pow(10000.0, -(double)i / 32.0);
    p.pad = 0;
#ifdef DBG_NPH
    const int total = DBG_NPH;
#else
    const int total = DEPTH * NPH;
#endif
#if MK_N_LAUNCHES == 1
    p.ph_lo = 0; p.ph_hi = total; p.li = 0;
    hipLaunchKernelGGL(mega_fwd, dim3(grid), dim3(512), LDS_BYTES, stream, p);
#else
#ifdef DBG_PHLIST
    { const int lst[] = DBG_PHLIST; for (int k : lst) { p.ph_lo = k; p.ph_hi = k + 1; p.li = 0; hipLaunchKernelGGL(mega_fwd, dim3(grid), dim3(512), LDS_BYTES, stream, p); } (void)total; }
#else
    for (int k = 0; k < total; ++k) { p.ph_lo = k; p.ph_hi = k + 1; p.li = 0; hipLaunchKernelGGL(mega_fwd, dim3(grid), dim3(512), LDS_BYTES, stream, p); }
#endif
#endif
#ifdef DBG_COPY_OFF
    hipLaunchKernelGGL(dbg_copy, dim3(2048), dim3(256), 0, stream, (const unsigned char*)d_ws + (DBG_COPY_OFF), (unsigned char*)d_out, (size_t)(DBG_COPY_BYTES));
#endif
    const hipError_t le = hipPeekAtLastError();
    if (le != hipSuccess) fprintf(stderr, "kernel_launch: launch failed: %s\n", hipGetErrorName(le));
}
```

```cpp
#include <hip/hip_runtime.h>
#include <cstdio>
#include <cstdint>
#include <cmath>

constexpr int D = 2048, DFF = 5632, MP = 16384, MS = 1024, M = MP + MS, DEPTH = 2;
constexpr int NH = 16, HD = 128, RD = 64, QL = 512, KVL = 256, PWD = 512, MQD = 512, INW = 1856;
constexpr int NMEM = 256, MH = 4, MVD = 512;
constexpr int PAST = 4096, DB = 16, DS = 64, SKS = PAST + DS;
constexpr int SALL = MP + DB * SKS;
constexpr int PPAD = 15;
constexpr float EPS = 1e-6f;
#define LOG2E 1.4426950408889634f

__device__ __forceinline__ int lane_id_fresh() { int x; asm volatile("v_mbcnt_lo_u32_b32 %0, -1, 0\n\tv_mbcnt_hi_u32_b32 %0, -1, %0" : "=v"(x)); return x; }
__device__ __forceinline__ const char* uni64(const char* p) { const unsigned long long v = (unsigned long long)p; const unsigned lo = __builtin_amdgcn_readfirstlane((unsigned)v), hi = __builtin_amdgcn_readfirstlane((unsigned)(v >> 32));
    return (const char*)(const __attribute__((address_space(1))) char*)(((unsigned long long)hi << 32) | (unsigned long long)lo); }
namespace pg8 {
#define PG8_LAS __attribute__((address_space(3)))
typedef unsigned short bf16_t;
typedef short bf16x8 __attribute__((ext_vector_type(8)));
typedef float f32x4 __attribute__((ext_vector_type(4)));
typedef unsigned u32x4 __attribute__((ext_vector_type(4)));
constexpr int BM = 256, BK = 64, HALF = 128, HTB = HALF * BK * 2  , STAGE_BYTES = 8 * HTB, NXCD = 8, WGM = 8;

__host__ __device__ __forceinline__ int lds_byte(int r, int c) { const int st = (r >> 4) * 2 + (c >> 5), rr = r & 15, cc = c & 31, ob = rr * 64 + cc * 2; return st * 1024 + (ob ^ (((ob >> 9) & 1) << 5)); }
__host__ __device__ __forceinline__ void stage_rc(int b, int& R, int& C) { const int st = b / 1024, sb = b % 1024, swz = sb ^ (((sb >> 9) & 1) << 5); R = (st >> 1) * 16 + swz / 64; C = (st & 1) * 32 + (swz % 64) / 2; }
__host__ __device__ __forceinline__ int perm32(int rho) { const int n = rho >> 4, i = rho & 15; return 8 * (i >> 2) + 4 * n + (i & 3); }

struct Unit { int pm, pn, kt0, nkt, kc; };
struct Gemm { const bf16_t* A; const bf16_t* Bt; int M, N, K; };

struct StaticOrder {
    static constexpr bool KSPLIT = false;
    int nM, nN, nwg, G, c;
    __host__ __device__ void init(int M, int N, int G_, int c_) { nM = M / BM; nN = N / BM; nwg = nM * nN; G = G_; c = c_; }
    __device__ bool next(int i, Unit& u) const {
        const long L = (long)i * G + c; if (L >= nwg) return false;
        int wgid = (int)L; { const int q = nwg / NXCD, r = nwg % NXCD, xcd = wgid % NXCD, off = wgid / NXCD; wgid = (xcd < r ? xcd * (q + 1) : r * (q + 1) + (xcd - r) * q) + off; }
        const int nig = WGM * nN, gid = wgid / nig, fm = gid * WGM, gsz = (nM - fm) < WGM ? (nM - fm) : WGM;
        u.pm = __builtin_amdgcn_readfirstlane(fm + ((wgid % nig) % gsz)); u.pn = __builtin_amdgcn_readfirstlane((wgid % nig) / gsz); return true;
    }
    __device__ __forceinline__ void a_ready(const Unit&) const {}
    __device__ __forceinline__ void done(const Unit&) const {}
};

struct SplitKOrder {
    static constexpr bool KSPLIT = true;
    int nM, nN, S, T, G, c;
    __device__ void init(int M, int N, int K, int S_, int G_, int c_) { nM = M / BM; nN = N / BM; S = S_; T = K / BK; G = G_; c = c_; }
    __device__ bool next(int i, Unit& u) const {
        const int L = i * G + c; if (L >= nM * nN * S) return false;
        const int kc = L % S, tile = L / S, s0 = 2 * ((kc * T) / (2 * S)), s1 = 2 * (((kc + 1) * T) / (2 * S));
        u.pm = __builtin_amdgcn_readfirstlane(tile % nM); u.pn = __builtin_amdgcn_readfirstlane(tile / nM); u.kt0 = __builtin_amdgcn_readfirstlane(s0); u.nkt = __builtin_amdgcn_readfirstlane(s1 - s0); u.kc = __builtin_amdgcn_readfirstlane(kc); return true;
    }
    __device__ __forceinline__ void a_ready(const Unit&) const {}
    __device__ __forceinline__ void done(const Unit&) const {}
};
typedef float f32x2_t __attribute__((ext_vector_type(2)));
typedef __bf16 bf16x2_t __attribute__((ext_vector_type(2)));
__device__ __forceinline__ unsigned cvt_pk_bf16(float lo, float hi) { const f32x2_t v = {lo, hi}; const bf16x2_t r = __builtin_convertvector(v, bf16x2_t); return __builtin_bit_cast(unsigned, r); }
__device__ __forceinline__ u32x4 pack8(const f32x4 a, const f32x4 b) { u32x4 w; w.x = cvt_pk_bf16(a[0], a[1]); w.y = cvt_pk_bf16(a[2], a[3]); w.z = cvt_pk_bf16(b[0], b[1]); w.w = cvt_pk_bf16(b[2], b[3]); return w; }
__device__ __forceinline__ float bf_lo(unsigned w) { return __uint_as_float(w << 16); }
__device__ __forceinline__ float bf_hi(unsigned w) { return __uint_as_float(w & 0xffff0000u); }
__device__ __forceinline__ float dot4(const f32x4 a) { return (a[0] * a[0] + a[1] * a[1]) + (a[2] * a[2] + a[3] * a[3]); }
__device__ __forceinline__ float xsum_fq(float v) {
    { const auto a = __builtin_amdgcn_permlane16_swap(__float_as_uint(v), __float_as_uint(v), false, false); v = __uint_as_float(a[0]) + __uint_as_float(a[1]); }
    { const auto b = __builtin_amdgcn_permlane32_swap(__float_as_uint(v), __float_as_uint(v), false, false); v = __uint_as_float(b[0]) + __uint_as_float(b[1]); }
    return v;
}
__device__ __forceinline__ float row_rstd(const float* rs, int row, int fq) {
    const f32x4* p = (const f32x4*)(rs + (size_t)row * 32 + fq * 8); const f32x4 a = p[0], b = p[1];
    float s = ((a[0] + a[1]) + (a[2] + a[3])) + ((b[0] + b[1]) + (b[2] + b[3]));
    s = xsum_fq(s);
    return rsqrtf(s * (1.0f / D) + EPS);
}
__device__ __forceinline__ float silu_f(float g) { return g * __builtin_amdgcn_rcpf(1.0f + __builtin_amdgcn_exp2f(-LOG2E * g)); }
__device__ __forceinline__ float sigm_f(float g) { return __builtin_amdgcn_rcpf(1.0f + __builtin_amdgcn_exp2f(-LOG2E * g)); }

struct EpiSwiGLU { static constexpr bool PERM = true, AFTER_DRAIN = false;
    bf16_t* act; const float* rs;
    __device__ __forceinline__ void operator()(const f32x4 (&acc)[2][2][4][2], const Unit& u, int wr, int wc, int fr, int fq) const {
        { int ln_ = lane_id_fresh(); asm volatile("" : "+v"(ln_)); fr = ln_ & 15; fq = ln_ >> 4; }
        const int row0 = u.pm * BM + wr * 64 + fr, col0 = u.pn * HALF + wc * 32 + 8 * fq;
#pragma unroll
        for (int ai = 0; ai < 2; ++ai)
#pragma unroll
            for (int m = 0; m < 4; ++m) { const int row = row0 + ai * HALF + m * 16; const float r = row_rstd(rs, row, fq);
                f32x4 y[2];
#pragma unroll
                for (int n = 0; n < 2; ++n) { const f32x4 g = acc[ai][0][m][n] * r, uu = acc[ai][1][m][n] * r;
#pragma unroll
                    for (int j = 0; j < 4; ++j) y[n][j] = silu_f(g[j]) * uu[j]; }
                *(u32x4*)(act + (size_t)row * DFF + col0) = pack8(y[0], y[1]); }
    }
};
template <bool F32SRC, bool F32OUT> struct EpiResid { static constexpr bool PERM = true, AFTER_DRAIN = false;
    const float* res_lo; const float* res_hi; float* Rout; bf16_t* xb; float* rs; float alpha;
    __device__ __forceinline__ void operator()(const f32x4 (&acc)[2][2][4][2], const Unit& u, int wr, int wc, int fr, int fq) const {
        { int ln_ = lane_id_fresh(); asm volatile("" : "+v"(ln_)); fr = ln_ & 15; fq = ln_ >> 4; }
        const int row0 = u.pm * BM + wr * 64 + fr, col0 = u.pn * BM + wc * 32 + 8 * fq;
        const float* src = (u.pm < MP / BM) ? res_lo : (res_hi - (size_t)MP * D);
#pragma unroll
        for (int ai = 0; ai < 2; ++ai) {
            f32x4 x[4][2][2];
#pragma unroll
            for (int m = 0; m < 4; ++m)
#pragma unroll
                for (int bj = 0; bj < 2; ++bj) { const size_t off = (size_t)(row0 + ai * HALF + m * 16) * D + col0 + bj * HALF;
                    if constexpr (F32SRC) { x[m][bj][0] = *(const f32x4*)(src + off); x[m][bj][1] = *(const f32x4*)(src + off + 4); }
                    else { const u32x4 w = *(const u32x4*)(xb + off); x[m][bj][0] = (f32x4){bf_lo(w.x), bf_hi(w.x), bf_lo(w.y), bf_hi(w.y)}; x[m][bj][1] = (f32x4){bf_lo(w.z), bf_hi(w.z), bf_lo(w.w), bf_hi(w.w)}; } }
            asm volatile("" ::: "memory");
#pragma unroll
            for (int m = 0; m < 4; ++m) { const int row = row0 + ai * HALF + m * 16; const size_t off = (size_t)row * D + col0; float ss = 0.f;
#pragma unroll
                for (int bj = 0; bj < 2; ++bj) {
                    const f32x4 o0 = x[m][bj][0] + acc[ai][bj][m][0] * alpha, o1 = x[m][bj][1] + acc[ai][bj][m][1] * alpha;
                    if constexpr (F32OUT) { *(f32x4*)(Rout + off + bj * HALF) = o0; *(f32x4*)(Rout + off + bj * HALF + 4) = o1; }
                    *(u32x4*)(xb + off + bj * HALF) = pack8(o0, o1); ss += dot4(o0) + dot4(o1); }
                ss = xsum_fq(ss);
                if (fq == 0) rs[(size_t)row * 32 + u.pn * 4 + wc] = ss; }
            asm volatile("" ::: "memory");
        }
    }
};
struct EpiInGate { static constexpr bool PERM = true, AFTER_DRAIN = false;
    float* inproj; bf16_t* gates; const float* rs; const float* bgate;
    __device__ __forceinline__ void operator()(const f32x4 (&acc)[2][2][4][2], const Unit& u, int wr, int wc, int fr, int fq) const {
        { int ln_ = lane_id_fresh(); asm volatile("" : "+v"(ln_)); fr = ln_ & 15; fq = ln_ >> 4; }
        const int row0 = u.pm * BM + wr * 64 + fr;
        if (u.pn < 8) { const int col0 = u.pn * BM + wc * 32 + 8 * fq;
#pragma unroll
            for (int ai = 0; ai < 2; ++ai)
#pragma unroll
                for (int m = 0; m < 4; ++m) { const int row = row0 + ai * HALF + m * 16; const float r = row_rstd(rs, row, fq); float* o = inproj + (size_t)row * D + col0;
#pragma unroll
                    for (int bj = 0; bj < 2; ++bj) { *(f32x4*)(o + bj * HALF) = acc[ai][bj][m][0] * r; *(f32x4*)(o + bj * HALF + 4) = acc[ai][bj][m][1] * r; } }
        } else { const int t = u.pn - 8, j = t >> 3, col0 = (t & 7) * BM + wc * 32 + 8 * fq; bf16_t* G = gates + (size_t)j * M * D;
            f32x4 bv[2][2];
#pragma unroll
            for (int bj = 0; bj < 2; ++bj)
#pragma unroll
                for (int n = 0; n < 2; ++n) bv[bj][n] = *(const f32x4*)(bgate + j * D + col0 + bj * HALF + 4 * n);
#pragma unroll
            for (int ai = 0; ai < 2; ++ai)
#pragma unroll
                for (int m = 0; m < 4; ++m) { const int row = row0 + ai * HALF + m * 16; const float r = row_rstd(rs, row, fq);
#pragma unroll
                    for (int bj = 0; bj < 2; ++bj) { f32x4 v0 = acc[ai][bj][m][0] * r + bv[bj][0], v1 = acc[ai][bj][m][1] * r + bv[bj][1];
#ifndef DBG_NOSIG
#pragma unroll
                        for (int q = 0; q < 4; ++q) { v0[q] = sigm_f(v0[q]); v1[q] = sigm_f(v1[q]); }
#endif

                        *(u32x4*)(G + (size_t)row * D + col0 + bj * HALF) = pack8(v0, v1); } }
        }
    }
};
struct EpiPool { static constexpr bool PERM = true, AFTER_DRAIN = false;
    const bf16_t* gp; bf16_t* merged; const float* pscale;
    __device__ __forceinline__ void operator()(const f32x4 (&acc)[2][2][4][2], const Unit& u, int wr, int wc, int fr, int fq) const {
        { int ln_ = lane_id_fresh(); asm volatile("" : "+v"(ln_)); fr = ln_ & 15; fq = ln_ >> 4; }
        const int row0 = u.pm * BM + wr * 64 + fr, col0 = u.pn * BM + wc * 32 + 8 * fq;
        f32x4 ps[2][2];
#pragma unroll
        for (int bj = 0; bj < 2; ++bj)
#pragma unroll
            for (int n = 0; n < 2; ++n) ps[bj][n] = *(const f32x4*)(pscale + col0 + bj * HALF + 4 * n);
#pragma unroll
        for (int ai = 0; ai < 2; ++ai)
#pragma unroll
            for (int m = 0; m < 4; ++m) { const size_t off = (size_t)(row0 + ai * HALF + m * 16) * D + col0;
#pragma unroll
                for (int bj = 0; bj < 2; ++bj) { const u32x4 g = *(const u32x4*)(gp + off + bj * HALF);
                    f32x4 g0 = {bf_lo(g.x), bf_hi(g.x), bf_lo(g.y), bf_hi(g.y)}, g1 = {bf_lo(g.z), bf_hi(g.z), bf_lo(g.w), bf_hi(g.w)};
#ifdef DBG_NOGATE
                    g0 = (f32x4){1.f, 1.f, 1.f, 1.f}; g1 = g0;
#endif
                    *(u32x4*)(merged + off + bj * HALF) = pack8(acc[ai][bj][m][0] * ps[bj][0] * g0, acc[ai][bj][m][1] * ps[bj][1] * g1); } }
    }
};
struct EpiStore { static constexpr bool PERM = true, AFTER_DRAIN = false;
    bf16_t* O; int ldc;
    __device__ __forceinline__ void operator()(const f32x4 (&acc)[2][2][4][2], const Unit& u, int wr, int wc, int fr, int fq) const {
        { int ln_ = lane_id_fresh(); asm volatile("" : "+v"(ln_)); fr = ln_ & 15; fq = ln_ >> 4; }
        const int row0 = u.pm * BM + wr * 64 + fr, col0 = u.pn * BM + wc * 32 + 8 * fq;
#pragma unroll
        for (int ai = 0; ai < 2; ++ai)
#pragma unroll
            for (int m = 0; m < 4; ++m) { bf16_t* o = O + (size_t)(row0 + ai * HALF + m * 16) * ldc + col0;
#pragma unroll
                for (int bj = 0; bj < 2; ++bj) *(u32x4*)(o + bj * HALF) = pack8(acc[ai][bj][m][0], acc[ai][bj][m][1]); }
    }
};
struct EpiStoreF32 { static constexpr bool PERM = true, AFTER_DRAIN = false;
    float* O; int ldc;
    __device__ __forceinline__ void operator()(const f32x4 (&acc)[2][2][4][2], const Unit& u, int wr, int wc, int fr, int fq) const {
        { int ln_ = lane_id_fresh(); asm volatile("" : "+v"(ln_)); fr = ln_ & 15; fq = ln_ >> 4; }
        const int row0 = u.pm * BM + wr * 64 + fr, col0 = u.pn * BM + wc * 32 + 8 * fq;
#pragma unroll
        for (int ai = 0; ai < 2; ++ai)
#pragma unroll
            for (int m = 0; m < 4; ++m) { float* o = O + (size_t)(row0 + ai * HALF + m * 16) * ldc + col0;
#pragma unroll
                for (int bj = 0; bj < 2; ++bj) { *(f32x4*)(o + bj * HALF) = acc[ai][bj][m][0]; *(f32x4*)(o + bj * HALF + 4) = acc[ai][bj][m][1]; } }
    }
};
struct EpiSlab { static constexpr bool PERM = true, AFTER_DRAIN = false;
    float* slab;
    __device__ __forceinline__ void operator()(const f32x4 (&acc)[2][2][4][2], const Unit& u, int wr, int wc, int fr, int fq) const {
        { int ln_ = lane_id_fresh(); asm volatile("" : "+v"(ln_)); fr = ln_ & 15; fq = ln_ >> 4; }
        const int row0 = u.pm * BM + wr * 64 + fr, col0 = u.pn * BM + wc * 32 + 8 * fq; float* base = slab + (size_t)u.kc * MS * D;
#pragma unroll
        for (int ai = 0; ai < 2; ++ai)
#pragma unroll
            for (int m = 0; m < 4; ++m) { float* o = base + (size_t)(row0 + ai * HALF + m * 16) * D + col0;
#pragma unroll
                for (int bj = 0; bj < 2; ++bj) { *(f32x4*)(o + bj * HALF) = acc[ai][bj][m][0]; *(f32x4*)(o + bj * HALF + 4) = acc[ai][bj][m][1]; } }
    }
};
struct EpiKV { static constexpr bool PERM = true, AFTER_DRAIN = false;
    bf16_t *K0, *V0, *K1, *V1; int split; const float* knorm; PG8_LAS float* P;
    __device__ __forceinline__ void operator()(const f32x4 (&acc)[2][2][4][2], const Unit& u, int wr, int wc, int fr, int fq) const {
        { int ln_ = lane_id_fresh(); asm volatile("" : "+v"(ln_)); fr = ln_ & 15; fq = ln_ >> 4; }
        const int grow = u.pm * BM; const bool second = grow >= split; const int orow0 = (second ? grow - split : grow) + wr * 64 + fr;
        bf16_t* Kd = second ? K1 : K0; bf16_t* Vd = second ? V1 : V0;
        if (u.pn >= 8) { const int col0 = (u.pn - 8) * BM + wc * 32 + 8 * fq;
#pragma unroll
            for (int ai = 0; ai < 2; ++ai)
#pragma unroll
                for (int m = 0; m < 4; ++m) { bf16_t* o = Vd + (size_t)(orow0 + ai * HALF + m * 16) * D + col0;
#pragma unroll
                    for (int bj = 0; bj < 2; ++bj) *(u32x4*)(o + bj * HALF) = pack8(acc[ai][bj][m][0], acc[ai][bj][m][1]); }
        } else { const int col0 = u.pn * BM + wc * 32 + 8 * fq, rt0 = wr * 64 + fr;
#pragma unroll
            for (int ai = 0; ai < 2; ++ai)
#pragma unroll
                for (int m = 0; m < 4; ++m)
#pragma unroll
                    for (int bj = 0; bj < 2; ++bj) { float ss = dot4(acc[ai][bj][m][0]) + dot4(acc[ai][bj][m][1]); ss = xsum_fq(ss);
                        if (fq == 0) P[((rt0 + ai * HALF + m * 16) * 2 + bj) * 4 + wc] = ss; __builtin_amdgcn_sched_barrier(0); }
            asm volatile("s_waitcnt lgkmcnt(0)" ::: "memory"); __builtin_amdgcn_s_barrier(); asm volatile("" ::: "memory");
            const f32x4 g0 = *(const f32x4*)(knorm + wc * 32 + 8 * fq), g1 = *(const f32x4*)(knorm + wc * 32 + 8 * fq + 4);
#pragma unroll
            for (int ai = 0; ai < 2; ++ai)
#pragma unroll
                for (int m = 0; m < 4; ++m) { bf16_t* o = Kd + (size_t)(orow0 + ai * HALF + m * 16) * D + col0;
#pragma unroll
                    for (int bj = 0; bj < 2; ++bj) { const f32x4 p4 = *(const PG8_LAS f32x4*)(P + ((rt0 + ai * HALF + m * 16) * 2 + bj) * 4);
                        const float r = rsqrtf(((p4[0] + p4[1]) + (p4[2] + p4[3])) * (1.0f / HD) + EPS);
                        *(u32x4*)(o + bj * HALF) = pack8(acc[ai][bj][m][0] * r * g0, acc[ai][bj][m][1] * r * g1); }
                    asm volatile("" ::: "memory"); __builtin_amdgcn_sched_barrier(0); }
        }
    }
};

template <class Epi, class Sched, bool ALIGN_EPI = false, bool SP2 = false>
__device__ __forceinline__ void gemm_phase(PG8_LAS unsigned char* lds, const Gemm g, const Sched& S, const Epi& E, const int wv  ) {
    int tid_ = wv * 64 + lane_id_fresh(); asm volatile("" : "+v"(tid_));
    const int tid = tid_, wid = __builtin_amdgcn_readfirstlane(tid >> 6), lane = tid & 63, wr = wid >> 2, wc = wid & 3, fr = lane & 15, fq = lane >> 4;
    const int K = g.K; int nt = K / BK;
    unsigned voffA[2], voffB[2];
#pragma unroll
    for (int i = 0; i < 2; ++i) { int R, C; stage_rc(tid * 16 + i * 8192, R, C); const int Rb = Epi::PERM ? ((R & ~31) + perm32(R & 31)) : R;
        voffA[i] = (unsigned)(R * K + C) * 2u; voffB[i] = (unsigned)(Rb * K + C) * 2u; }
    const size_t kstep = (size_t)(BK * 2);
    const size_t hstep = (size_t)HALF * K * 2;
    const size_t tstep = 2 * hstep;
    const unsigned ldsw = (unsigned)wid * 1024u;
    const int aoff = lds_byte(wr * 64 + fr, fq * 8), boff = lds_byte(wc * 32 + fr, fq * 8);
#define PG8_SA(b, h) (((b) * 2 + (h)) * HTB)
#define PG8_SB(b, h) ((4 + (b) * 2 + (h)) * HTB)
#define PG8_STAGE(bufoff, gbase, voff) do { const char* gb_ = uni64((const char*)(gbase)); _Pragma("unroll") for (int _i = 0; _i < 2; ++_i) \
        __builtin_amdgcn_global_load_lds((const unsigned*)(gb_ + (voff)[_i]), (PG8_LAS unsigned*)(lds + (bufoff) + ldsw + _i * 8192), 16, 0, 0); } while (0)
#define PG8_LDA(dst, b, h) do { _Pragma("unroll") for (int m = 0; m < 4; ++m) _Pragma("unroll") for (int k = 0; k < 2; ++k) dst[m][k] = *(const PG8_LAS bf16x8*)(lds + PG8_SA(b, h) + aoff + m * 2048 + k * 1024); } while (0)
#define PG8_LDB(dst, b, h) do { _Pragma("unroll") for (int n = 0; n < 2; ++n) _Pragma("unroll") for (int k = 0; k < 2; ++k) dst[n][k] = *(const PG8_LAS bf16x8*)(lds + PG8_SB(b, h) + boff + n * 2048 + k * 1024); } while (0)
#define PG8_MMA(ai, bj, At, Bt) do { __builtin_amdgcn_s_setprio(1); _Pragma("unroll") for (int m = 0; m < 4; ++m) _Pragma("unroll") for (int n = 0; n < 2; ++n) _Pragma("unroll") for (int k = 0; k < 2; ++k) \
        acc[ai][bj][m][n] = __builtin_amdgcn_mfma_f32_16x16x32_bf16(Bt[n][k], At[m][k], acc[ai][bj][m][n], 0, 0, 0); __builtin_amdgcn_s_setprio(0); } while (0)
#define PG8_WAIT_V(n) asm volatile("s_waitcnt vmcnt(" #n ")" ::: "memory")
#define PG8_WAIT_L(n) asm volatile("s_waitcnt lgkmcnt(" #n ")" ::: "memory")
#define PG8_BAR __builtin_amdgcn_s_barrier()
#define PG8_SCHED __builtin_amdgcn_sched_barrier(0)
    Unit cur, nxt; int ui = 0;
    if (!S.next(0, cur)) return;
    f32x4 acc[2][2][4][2];
#pragma unroll
    for (int a = 0; a < 2; ++a)
#pragma unroll
        for (int b = 0; b < 2; ++b)
#pragma unroll
            for (int m = 0; m < 4; ++m)
#pragma unroll
                for (int n = 0; n < 2; ++n) acc[a][b][m][n] = (f32x4){0.f, 0.f, 0.f, 0.f};
    bf16x8 At[4][2], B0[2][2], B1[2][2];
    const char* cA = (const char*)g.A + (size_t)cur.pm * tstep; const char* cB = (const char*)g.Bt + (size_t)cur.pn * tstep;
    if constexpr (Sched::KSPLIT) { cA += (size_t)cur.kt0 * kstep; cB += (size_t)cur.kt0 * kstep; nt = cur.nkt; }
    S.a_ready(cur);
    if constexpr (SP2) {
        PG8_STAGE(PG8_SB(0, 0), cB, voffB); PG8_STAGE(PG8_SB(0, 1), cB + hstep, voffB); PG8_STAGE(PG8_SA(0, 0), cA, voffA); PG8_STAGE(PG8_SA(0, 1), cA + hstep, voffA);
        if (wr == 1) PG8_BAR;
        PG8_WAIT_V(2); PG8_BAR;
        PG8_STAGE(PG8_SB(1, 0), cB + kstep, voffB); PG8_STAGE(PG8_SA(1, 0), cA + kstep, voffA); PG8_STAGE(PG8_SB(1, 1), cB + hstep + kstep, voffB);
        PG8_WAIT_V(6); PG8_BAR;
    } else {
        PG8_STAGE(PG8_SB(0, 0), cB, voffB); PG8_STAGE(PG8_SA(0, 0), cA, voffA); PG8_STAGE(PG8_SB(0, 1), cB + hstep, voffB); PG8_STAGE(PG8_SA(0, 1), cA + hstep, voffA);
        if (wr == 1) PG8_BAR;
        PG8_WAIT_V(4); PG8_BAR;
        PG8_STAGE(PG8_SB(1, 0), cB + kstep, voffB); PG8_STAGE(PG8_SA(1, 0), cA + kstep, voffA); PG8_STAGE(PG8_SB(1, 1), cB + hstep + kstep, voffB);
        PG8_WAIT_V(6); PG8_BAR;
    }
    for (;;) {
        const bool has_next = S.next(ui + 1, nxt);
        const char* nA = has_next ? (const char*)g.A + (size_t)nxt.pm * tstep + (Sched::KSPLIT ? (size_t)nxt.kt0 * kstep : (size_t)0) : cA; const char* nB = has_next ? (const char*)g.Bt + (size_t)nxt.pn * tstep + (Sched::KSPLIT ? (size_t)nxt.kt0 * kstep : (size_t)0) : cB;
        for (int t = 0; t < nt; t += 2) {
            const bool last = (t == nt - 2);
            const char* a1 = cA + (size_t)(t + 1) * kstep;
            const char* a2 = last ? nA : cA + (size_t)(t + 2) * kstep; const char* b2 = last ? nB : cB + (size_t)(t + 2) * kstep;
            const char* a3 = a2 + kstep; const char* b3 = b2 + kstep;
            if (last && has_next) S.a_ready(nxt);
            if constexpr (SP2) {
            PG8_LDB(B0, 0, 0); PG8_LDB(B1, 0, 1); PG8_SCHED; PG8_LDA(At, 0, 0); PG8_STAGE(PG8_SA(1, 1), a1 + hstep, voffA);
            PG8_WAIT_V(8); PG8_WAIT_L(0); PG8_BAR; PG8_MMA(0, 0, At, B0); PG8_MMA(0, 1, At, B1); PG8_BAR; PG8_SCHED;
            PG8_LDA(At, 0, 1); PG8_STAGE(PG8_SB(0, 0), b2, voffB); PG8_STAGE(PG8_SB(0, 1), b2 + hstep, voffB); PG8_STAGE(PG8_SA(0, 0), a2, voffA);
            PG8_WAIT_V(8); PG8_WAIT_L(0); PG8_BAR; PG8_MMA(1, 0, At, B0); PG8_MMA(1, 1, At, B1); PG8_BAR; PG8_SCHED;
            PG8_LDB(B0, 1, 0); PG8_LDB(B1, 1, 1); PG8_SCHED; PG8_LDA(At, 1, 0); PG8_STAGE(PG8_SA(0, 1), a2 + hstep, voffA);
            PG8_WAIT_V(8); PG8_WAIT_L(0); PG8_BAR; PG8_MMA(0, 0, At, B0); PG8_MMA(0, 1, At, B1); PG8_BAR; PG8_SCHED;
            PG8_LDA(At, 1, 1); PG8_STAGE(PG8_SB(1, 0), b3, voffB); PG8_STAGE(PG8_SB(1, 1), b3 + hstep, voffB); PG8_STAGE(PG8_SA(1, 0), a3, voffA);
            PG8_WAIT_V(8); PG8_WAIT_L(0); PG8_BAR; PG8_MMA(1, 0, At, B0); PG8_MMA(1, 1, At, B1); PG8_BAR; PG8_SCHED;
            } else {
            PG8_LDB(B0, 0, 0); PG8_SCHED; PG8_LDA(At, 0, 0); PG8_STAGE(PG8_SA(1, 1), a1 + hstep, voffA);
            PG8_WAIT_L(8); PG8_BAR; PG8_WAIT_L(0); PG8_MMA(0, 0, At, B0); PG8_BAR; PG8_SCHED;
            PG8_LDB(B1, 0, 1); PG8_STAGE(PG8_SB(0, 0), b2, voffB);
            PG8_BAR; PG8_WAIT_L(0); PG8_MMA(0, 1, At, B1); PG8_BAR;
            PG8_LDA(At, 0, 1); PG8_STAGE(PG8_SA(0, 0), a2, voffA);
            PG8_BAR; PG8_WAIT_L(0); PG8_MMA(1, 0, At, B0); PG8_BAR; PG8_SCHED;
            PG8_STAGE(PG8_SB(0, 1), b2 + hstep, voffB);
            PG8_WAIT_V(6); PG8_BAR; PG8_MMA(1, 1, At, B1); PG8_BAR;
            PG8_LDB(B0, 1, 0); PG8_SCHED; PG8_LDA(At, 1, 0); PG8_STAGE(PG8_SA(0, 1), a2 + hstep, voffA);
            PG8_WAIT_L(8); PG8_BAR; PG8_WAIT_L(0); PG8_MMA(0, 0, At, B0); PG8_BAR; PG8_SCHED;
            PG8_LDB(B1, 1, 1); PG8_STAGE(PG8_SB(1, 0), b3, voffB);
            PG8_BAR; PG8_WAIT_L(0); PG8_MMA(0, 1, At, B1); PG8_BAR;
            PG8_LDA(At, 1, 1); PG8_STAGE(PG8_SA(1, 0), a3, voffA);
            PG8_BAR; PG8_WAIT_L(0); PG8_MMA(1, 0, At, B0); PG8_BAR; PG8_SCHED;
            PG8_STAGE(PG8_SB(1, 1), b3 + hstep, voffB);
            PG8_WAIT_V(6); PG8_BAR; PG8_MMA(1, 1, At, B1); PG8_BAR;
            }
        }
        if constexpr (ALIGN_EPI) { if (wr == 0) PG8_BAR; }
        if constexpr (!Epi::AFTER_DRAIN) { E(acc, cur, wr, wc, fr, fq); S.done(cur); }
        if (!has_next) break;
#pragma unroll
        for (int a = 0; a < 2; ++a)
#pragma unroll
            for (int b = 0; b < 2; ++b)
#pragma unroll
                for (int m = 0; m < 4; ++m)
#pragma unroll
                    for (int n = 0; n < 2; ++n) acc[a][b][m][n] = (f32x4){0.f, 0.f, 0.f, 0.f};
        cur = nxt; cA = nA; cB = nB; ++ui; if constexpr (Sched::KSPLIT) nt = cur.nkt;
        if constexpr (ALIGN_EPI) { if (wr == 1) PG8_BAR; }
    }
    PG8_WAIT_V(0);
    if constexpr (!ALIGN_EPI) { if (wr == 0) PG8_BAR; }
    PG8_BAR;
    if constexpr (Epi::AFTER_DRAIN) { E.fused(acc, cur, wr, wc, fr, fq, lds, wid, lane); S.done(cur); }
#undef PG8_SA
#undef PG8_SB
#undef PG8_STAGE
#undef PG8_LDA
#undef PG8_LDB
#undef PG8_MMA
#undef PG8_WAIT_V
#undef PG8_WAIT_L
#undef PG8_BAR
#undef PG8_SCHED
}
}

#ifndef ATT_SD_MEM
#define ATT_SD_MEM 1
#endif
#ifndef ATT_SD_MAIN
#define ATT_SD_MAIN 1
#endif
namespace att {
typedef unsigned short bf16_t;
using bf16x8 = __attribute__((ext_vector_type(8))) short;
using s16x4  = __attribute__((ext_vector_type(4))) short;
using f32x16 = __attribute__((ext_vector_type(16))) float;
using f32x4  = __attribute__((ext_vector_type(4))) float;
using u32x4  = __attribute__((ext_vector_type(4))) unsigned;
constexpr int KVBLK = 64;
constexpr int ATT_WS_OFF = 116736;
constexpr float THR = 8.f;
#define ATT_SBAR() __builtin_amdgcn_sched_barrier(0)
__device__ __forceinline__ int crow(int r, int hi) { return (r & 3) + 8 * (r >> 2) + 4 * hi; }
__device__ __forceinline__ unsigned cvtpk(float lo, float hi) { return pg8::cvt_pk_bf16(lo, hi); }
__device__ __forceinline__ float bflo(unsigned w) { return __uint_as_float(w << 16); }
__device__ __forceinline__ float bfhi(unsigned w) { return __uint_as_float(w & 0xffff0000u); }
template <int DQK> __device__ __forceinline__ int kswz(int row, int cb) { if constexpr (DQK == 128) return row * 256 + (cb ^ ((row & 7) << 4)); else return row * 384 + (cb ^ (((row >> 1) & 7) << 4)); }
__device__ __forceinline__ int v_st(int k, int c) { const int kk = (k & ~0xC) | ((k & 4) << 1) | ((k & 8) >> 1); return ((kk >> 3) * 4 + (c >> 5)) * 512 + ((kk & 7) * 32 + (c & 31)) * 2; }
__device__ __forceinline__ int v_rd_base(int lane) { return ((lane & 3) << 3) | (((lane >> 2) & 3) << 6) | (((lane >> 4) & 1) << 5) | (((lane >> 5) & 1) << 8); }
constexpr int v_rd_off(int d0, int ks, int half) { return d0 * 512 + ks * 4096 + half * 2048; }
template <int OFF> __device__ __forceinline__ s16x4 tr_read(int vb) { s16x4 r; asm volatile("ds_read_b64_tr_b16 %0, %1 offset:%2" : "=&v"(r) : "v"(vb), "i"(OFF) : "memory"); return r; }
template <int D0> __device__ __forceinline__ void pv_one(f32x16& od, int vb, bf16x8 pa0, bf16x8 pa1, bf16x8 pa2, bf16x8 pa3) {
  const s16x4 l0 = tr_read<v_rd_off(D0, 0, 0)>(vb), h0 = tr_read<v_rd_off(D0, 0, 1)>(vb), l1 = tr_read<v_rd_off(D0, 1, 0)>(vb), h1 = tr_read<v_rd_off(D0, 1, 1)>(vb);
  const s16x4 l2 = tr_read<v_rd_off(D0, 2, 0)>(vb), h2 = tr_read<v_rd_off(D0, 2, 1)>(vb), l3 = tr_read<v_rd_off(D0, 3, 0)>(vb), h3 = tr_read<v_rd_off(D0, 3, 1)>(vb);
  asm volatile("s_waitcnt lgkmcnt(0)" ::: "memory"); ATT_SBAR();
#define ATT_PK(L, H) (bf16x8){L[0], L[1], L[2], L[3], H[0], H[1], H[2], H[3]}
  od = __builtin_amdgcn_mfma_f32_32x32x16_bf16(pa0, ATT_PK(l0, h0), od, 0, 0, 0);
  od = __builtin_amdgcn_mfma_f32_32x32x16_bf16(pa1, ATT_PK(l1, h1), od, 0, 0, 0);
  od = __builtin_amdgcn_mfma_f32_32x32x16_bf16(pa2, ATT_PK(l2, h2), od, 0, 0, 0);
  od = __builtin_amdgcn_mfma_f32_32x32x16_bf16(pa3, ATT_PK(l3, h3), od, 0, 0, 0);
#undef ATT_PK
}
__device__ __forceinline__ void pv_d0(f32x16* o, int vb, bf16x8 pa0, bf16x8 pa1, bf16x8 pa2, bf16x8 pa3) {
  pv_one<0>(o[0], vb, pa0, pa1, pa2, pa3); pv_one<1>(o[1], vb, pa0, pa1, pa2, pa3); pv_one<2>(o[2], vb, pa0, pa1, pa2, pa3); pv_one<3>(o[3], vb, pa0, pa1, pa2, pa3);
}
__device__ __forceinline__ void partialSM(f32x16& p0, f32x16& p1, float& m_reg, float& mn, float& alpha, const float C, const bool masked) {
  if (masked) {
    asm volatile("" ::: "memory");
#pragma unroll
    for (int r = 0; r < 16; ++r) { p0[r] = -__builtin_inff(); p1[r] = -__builtin_inff(); } }
  float pmax = p0[0];
#pragma unroll
  for (int r = 1; r < 16; ++r) pmax = fmaxf(pmax, p0[r]);
#pragma unroll
  for (int r = 0; r < 16; ++r) pmax = fmaxf(pmax, p1[r]);
  { auto rr = __builtin_amdgcn_permlane32_swap(__float_as_uint(pmax), __float_as_uint(pmax), false, false);
    pmax = fmaxf(__uint_as_float(rr[0]), __uint_as_float(rr[1])); }
  if (__builtin_expect(__all((pmax - m_reg) * C <= THR * LOG2E), 1)) { mn = m_reg; alpha = 1.f; }
  else { mn = fmaxf(m_reg, pmax); alpha = __builtin_amdgcn_exp2f((m_reg - mn) * C); m_reg = mn; }
  const float mnC = -mn * C;
#pragma unroll
  for (int r = 0; r < 16; ++r) p0[r] = fmaf(p0[r], C, mnC);
#pragma unroll
  for (int r = 0; r < 16; ++r) p1[r] = fmaf(p1[r], C, mnC);
#pragma unroll
  for (int r = 0; r < 16; ++r) p0[r] = __builtin_amdgcn_exp2f(p0[r]);
}
__device__ __forceinline__ void finishSM(f32x16& p0, f32x16& p1, float alpha, float& l_reg, bf16x8& pa0, bf16x8& pa1, bf16x8& pa2, bf16x8& pa3) {
#pragma unroll
  for (int r = 0; r < 16; ++r) p1[r] = __builtin_amdgcn_exp2f(p1[r]);
  float ps = 0;
#pragma unroll
  for (int r = 0; r < 16; ++r) ps += p0[r];
#pragma unroll
  for (int r = 0; r < 16; ++r) ps += p1[r];
  { auto rr = __builtin_amdgcn_permlane32_swap(__float_as_uint(ps), __float_as_uint(ps), false, false);
    ps = __uint_as_float(rr[0]) + __uint_as_float(rr[1]); }
  l_reg = l_reg * alpha + ps;
#define ATT_PK4(P, BASE, OUT) do { unsigned a0 = cvtpk(P[BASE + 0], P[BASE + 1]), a1 = cvtpk(P[BASE + 2], P[BASE + 3]);   \
    unsigned b0 = cvtpk(P[BASE + 4], P[BASE + 5]), b1 = cvtpk(P[BASE + 6], P[BASE + 7]);                              \
    auto r0 = __builtin_amdgcn_permlane32_swap(a0, b0, false, false); auto r1 = __builtin_amdgcn_permlane32_swap(a1, b1, false, false); \
    u32x4 w = {r0[0], r1[0], r0[1], r1[1]}; OUT = *reinterpret_cast<bf16x8*>(&w); } while (0)
  ATT_PK4(p0, 0, pa0); ATT_PK4(p0, 8, pa1); ATT_PK4(p1, 0, pa2); ATT_PK4(p1, 8, pa3);
#undef ATT_PK4
}
template <int DQK, int BUFOFF> __device__ __forceinline__ void qkt(f32x16& p0, f32x16& p1, const int (&kb)[4], const bf16x8* qr, const int qrb) {
  typedef const __attribute__((address_space(3))) bf16x8* lp;
  constexpr int ROWB = DQK * 2;
  p0 = f32x16{}; p1 = f32x16{};
#pragma unroll
  for (int d0 = 0; d0 < DQK / 16; ++d0) {
    const bf16x8 b0 = *(lp)(kb[d0 & 3] + (d0 >> 2) * 128 + BUFOFF);
    const bf16x8 b1 = *(lp)(kb[d0 & 3] + (d0 >> 2) * 128 + BUFOFF + 32 * ROWB);
    const bf16x8 q = d0 < 8 ? qr[d0 < 8 ? d0 : 0] : *(lp)(qrb + (d0 - 8) * 1024);
    p0 = __builtin_amdgcn_mfma_f32_32x32x16_bf16(b0, q, p0, 0, 0, 0);
    p1 = __builtin_amdgcn_mfma_f32_32x32x16_bf16(b1, q, p1, 0, 0, 0); }
}
__device__ __forceinline__ void softmax_fixed(f32x16& p0, f32x16& p1, float& l_reg, bf16x8& pa0, bf16x8& pa1, bf16x8& pa2, bf16x8& pa3, const bool masked) {
  if (masked) { asm volatile("" ::: "memory");
#pragma unroll
    for (int r = 0; r < 16; ++r) { p0[r] = -__builtin_inff(); p1[r] = -__builtin_inff(); } }
#pragma unroll
  for (int r = 0; r < 16; ++r) { p0[r] = __builtin_amdgcn_exp2f(p0[r]); p1[r] = __builtin_amdgcn_exp2f(p1[r]); }
  float ps = 0;
#pragma unroll
  for (int r = 0; r < 16; ++r) ps += p0[r];
#pragma unroll
  for (int r = 0; r < 16; ++r) ps += p1[r];
  { auto rr = __builtin_amdgcn_permlane32_swap(__float_as_uint(ps), __float_as_uint(ps), false, false); ps = __uint_as_float(rr[0]) + __uint_as_float(rr[1]); }
  l_reg += ps;
#define ATT_PK4(P, BASE, OUT) do { unsigned a0 = cvtpk(P[BASE + 0], P[BASE + 1]), a1 = cvtpk(P[BASE + 2], P[BASE + 3]);   \
    unsigned b0 = cvtpk(P[BASE + 4], P[BASE + 5]), b1 = cvtpk(P[BASE + 6], P[BASE + 7]);                              \
    auto r0 = __builtin_amdgcn_permlane32_swap(a0, b0, false, false); auto r1 = __builtin_amdgcn_permlane32_swap(a1, b1, false, false); \
    u32x4 w = {r0[0], r1[0], r0[1], r1[1]}; OUT = *reinterpret_cast<bf16x8*>(&w); } while (0)
  ATT_PK4(p0, 0, pa0); ATT_PK4(p0, 8, pa1); ATT_PK4(p1, 0, pa2); ATT_PK4(p1, 8, pa3);
#undef ATT_PK4
}

template <int DQK, int KOFF, int VOFF>
__device__ __forceinline__ void mseg(f32x16& p0, f32x16& p1, f32x16* o, const int (&kb)[4], const bf16x8* qr, const int qrb, const int vb, const bf16x8 pa0, const bf16x8 pa1, const bf16x8 pa2, const bf16x8 pa3, const bool doq) {
  typedef const __attribute__((address_space(3))) bf16x8* lp;
  typedef __attribute__((address_space(3))) s16x4* tp;
  constexpr int ROWB = DQK * 2;
#define MS_PV(KS, PA) do { _Pragma("unroll") for (int d0 = 0; d0 < 4; ++d0) { \
      const s16x4 l_ = __builtin_amdgcn_ds_read_tr16_b64_v4i16((tp)(vb + VOFF + v_rd_off(d0, KS, 0))), h_ = __builtin_amdgcn_ds_read_tr16_b64_v4i16((tp)(vb + VOFF + v_rd_off(d0, KS, 1))); \
      o[d0] = __builtin_amdgcn_mfma_f32_32x32x16_bf16(PA, (bf16x8){l_[0], l_[1], l_[2], l_[3], h_[0], h_[1], h_[2], h_[3]}, o[d0], 0, 0, 0); } } while (0)
#define MS_QK(D0) do { if (doq) { const bf16x8 b0_ = *(lp)(kb[(D0) & 3] + ((D0) >> 2) * 128 + KOFF), b1_ = *(lp)(kb[(D0) & 3] + ((D0) >> 2) * 128 + KOFF + 32 * ROWB); \
      const bf16x8 q_ = (D0) < 8 ? qr[(D0) < 8 ? (D0) : 0] : *(lp)(qrb + ((D0) - 8) * 1024); \
      p0 = __builtin_amdgcn_mfma_f32_32x32x16_bf16(b0_, q_, p0, 0, 0, 0); p1 = __builtin_amdgcn_mfma_f32_32x32x16_bf16(b1_, q_, p1, 0, 0, 0); } } while (0)
  if (doq) { p0 = f32x16{}; p1 = f32x16{}; }
  __builtin_amdgcn_s_setprio(1);
  MS_PV(0, pa0); MS_QK(0); MS_QK(1); MS_PV(1, pa1); MS_QK(2); MS_QK(3); MS_PV(2, pa2); MS_QK(4); MS_QK(5); MS_PV(3, pa3); MS_QK(6); MS_QK(7);
  if constexpr (DQK == 192) { MS_QK(8); MS_QK(9); MS_QK(10); MS_QK(11); }
  __builtin_amdgcn_s_setprio(0);
#ifndef ATT_NO_SGB
  __builtin_amdgcn_sched_group_barrier(0x100, 14, 0);
#pragma unroll
  for (int i = 0; i < 6; ++i) { __builtin_amdgcn_sched_group_barrier(0x008, 1, 0); __builtin_amdgcn_sched_group_barrier(0x100, 2, 0); }
#pragma unroll
  for (int i = 6; i < (DQK == 192 ? 40 : 32); ++i) { __builtin_amdgcn_sched_group_barrier(0x008, 1, 0); __builtin_amdgcn_sched_group_barrier(0x100, 1, 0); }
#endif
#undef MS_PV
#undef MS_QK
}

template <int DQK, int ldk, int ldv, bool FIXM>
__device__ __forceinline__ void attn_item_pp(const bf16x8* qr, const bf16_t* __restrict__ Kn, const bf16_t* __restrict__ Kr, const bf16_t* __restrict__ Vh,
                                             int NT, int NTR, int tlim, float C, char* lds, f32x16* o, float& l_out, const int wv, const bool act) {
  constexpr int SHM_V = KVBLK * 128 * 2, SHM_K = KVBLK * DQK * 2;
  int tid_ = wv * 64 + lane_id_fresh(); asm volatile("" : "+v"(tid_));
  const int tid = tid_, wid = tid >> 6, lane = tid & 63, r32 = lane & 31, hi = lane >> 5; const bool lead = wv < 4;
  char* V_lds = lds; char* K_lds = lds + 2 * SHM_V;
  float* ws = (float*)(lds + ATT_WS_OFF) + wid * 64; float* al_l = ws + 32;
  float m_reg = -1e30f, l_reg = 0;
  const int sr = tid >> 4, sc = (tid & 15) * 8, vst0 = v_st(sr, sc), vst1 = v_st(32 + sr, sc);
  const int kst0 = kswz<DQK>(sr, sc * 2), kst1 = kswz<DQK>(32 + sr, sc * 2);
  const int rr_ = tid >> 3, rc_ = (tid & 7) * 8, kst2 = kswz<DQK>(rr_, 256 + rc_ * 2);
  const int vb0 = (int)(uintptr_t)V_lds + v_rd_base(lane);
  int kb[4];
#pragma unroll
  for (int q = 0; q < 4; ++q) { kb[q] = (int)(uintptr_t)K_lds + kswz<DQK>(r32, q * 32 + hi * 16); asm volatile("" : "+v"(kb[q])); }
  int qrb = (int)(uintptr_t)lds + 2 * SHM_V + 2 * SHM_K + 2048 + wid * 4096 + lane * 16; asm volatile("" : "+v"(qrb));
  bf16x8 vs0, vs1, ks0, ks1, kr = {};
  const unsigned voV = (unsigned)(sr * ldv + sc) * 2u, voK = (unsigned)(sr * ldk + sc) * 2u, voR = (unsigned)(rr_ * 64 + rc_) * 2u;
#define PP_LOADK(t) do { const int k0_ = ((t) < NTR ? (t) : NTR - 1) * KVBLK; const char* kt_ = (const char*)(Kn + (long)k0_ * ldk); \
    ks0 = *(const bf16x8*)(kt_ + voK); ks1 = *(const bf16x8*)(kt_ + (long)32 * ldk * 2 + voK); if constexpr (DQK == 192) kr = *(const bf16x8*)((const char*)(Kr + (long)k0_ * 64) + voR); } while (0)
#define PP_LOADV(t) do { const int k0_ = ((t) < NTR ? (t) : NTR - 1) * KVBLK; const char* vt_ = (const char*)(Vh + (long)k0_ * ldv); \
    vs0 = *(const bf16x8*)(vt_ + voV); vs1 = *(const bf16x8*)(vt_ + (long)32 * ldv * 2 + voV); } while (0)
#define PP_WRITEK(b) do { *(bf16x8*)(K_lds + (b) * SHM_K + kst0) = ks0; *(bf16x8*)(K_lds + (b) * SHM_K + kst1) = ks1; if constexpr (DQK == 192) *(bf16x8*)(K_lds + (b) * SHM_K + kst2) = kr; } while (0)
#define PP_WRITEV(b) do { *(bf16x8*)(V_lds + (b) * SHM_V + vst0) = vs0; *(bf16x8*)(V_lds + (b) * SHM_V + vst1) = vs1; } while (0)
#define PP_RESC(a) do { if (__any((a) < 1.f)) { if (hi == 0) al_l[r32] = (a); asm volatile("s_waitcnt lgkmcnt(0)" ::: "memory"); \
    _Pragma("unroll") for (int d = 0; d < 4; ++d) _Pragma("unroll") for (int r = 0; r < 16; ++r) o[d][r] *= al_l[crow(r, hi)]; } } while (0)
#define PP_SOFTMAX(t) do { if constexpr (FIXM) softmax_fixed(p0, p1, l_reg, pa0, pa1, pa2, pa3, (t) >= tlim); else { partialSM(p0, p1, m_reg, mn, al, C, (t) >= tlim); finishSM(p0, p1, al, l_reg, pa0, pa1, pa2, pa3); PP_RESC(al); } } while (0)
  f32x16 p0 = {}, p1 = {}; float mn = 0.f, al = 1.f; bf16x8 pa0 = {}, pa1 = {}, pa2 = {}, pa3 = {};
  PP_LOADK(0); PP_LOADV(0); asm volatile("s_waitcnt vmcnt(0)" ::: "memory"); PP_WRITEK(0); PP_WRITEV(0);
  PP_LOADK(1); asm volatile("s_waitcnt vmcnt(0)" ::: "memory"); PP_WRITEK(1);
  PP_LOADK(2); PP_LOADV(1);
  __syncthreads();
  if (!lead) __syncthreads();
  if (act) qkt<DQK, 0>(p0, p1, kb, qr, qrb);
  __syncthreads();
  if (!lead) { PP_WRITEK(0); PP_WRITEV(1); PP_LOADK(3); PP_LOADV(2); }
  if (act) PP_SOFTMAX(0);
  __syncthreads();
  for (int s = 1; s < NT; s += 2) {
    if (act) { ATT_SBAR(); mseg<DQK, SHM_K, 0>(p0, p1, o, kb, qr, qrb, vb0, pa0, pa1, pa2, pa3, true); ATT_SBAR(); }
    __syncthreads();
    if (lead) { PP_WRITEK(0); PP_WRITEV(1); PP_LOADK(s + 2); PP_LOADV(s + 1); } else { PP_WRITEK(1); PP_WRITEV(0); PP_LOADK(s + 3); PP_LOADV(s + 2); }
    if (act) PP_SOFTMAX(s);
    __syncthreads();
    if (act) { ATT_SBAR(); mseg<DQK, 0, SHM_V>(p0, p1, o, kb, qr, qrb, vb0, pa0, pa1, pa2, pa3, s + 1 < NT); ATT_SBAR(); }
    __syncthreads();
    if (lead) { PP_WRITEK(1); PP_WRITEV(0); PP_LOADK(s + 3); PP_LOADV(s + 2); } else { PP_WRITEK(0); PP_WRITEV(1); PP_LOADK(s + 4); PP_LOADV(s + 3); }
    if (act && s + 1 < NT) PP_SOFTMAX(s + 1);
    __syncthreads();
  }
  if (lead) __syncthreads();
  l_out = l_reg;
#undef PP_LOADK
#undef PP_LOADV
#undef PP_WRITEK
#undef PP_WRITEV
#undef PP_RESC
#undef PP_SOFTMAX
}

constexpr int SI_CK = 0, SI_KT = 65536, SI_VT = 90112, SI_PX = 106496, SI_QR = 107520, SI_WS = 123904;
__device__ __forceinline__ int ckswz(int row, int cb) { return row * 512 + (cb ^ ((row & 15) << 4)); }
__device__ __forceinline__ void sample_item(const bf16x8* qr, const bf16_t* __restrict__ ckv, const bf16_t* __restrict__ krs, const bf16_t* __restrict__ Wk, const bf16_t* __restrict__ Wv,
                                            const float* __restrict__ knorm, const float C, char* lds, f32x16* o, float& l_out, const int wv) {
  typedef const __attribute__((address_space(3))) bf16x8* lp;
  typedef __attribute__((address_space(3))) s16x4* tp;
  constexpr int NTS = SKS / KVBLK;
  int tid_ = wv * 64 + lane_id_fresh(); asm volatile("" : "+v"(tid_));
  const int tid = tid_, lane = tid & 63, r32 = lane & 31, hi = lane >> 5; const bool isV = wv >= 4; const int cw = (wv & 3) * 32;
  float* ws = (float*)(lds + SI_WS) + wv * 64; float* al_l = ws + 32; float* PX = (float*)(lds + SI_PX);
  bf16x8 wf[16];
  { const bf16_t* wsrc = (isV ? Wv : Wk) + (size_t)(cw + r32) * KVL + hi * 8;
#pragma unroll
    for (int ks = 0; ks < 16; ++ks) wf[ks] = *(const bf16x8*)(wsrc + ks * 16); }
  const float* gkp = knorm + cw + 4 * hi;
  int cb8[8];
#pragma unroll
  for (int q = 0; q < 8; ++q) { cb8[q] = (int)(uintptr_t)lds + SI_CK + ckswz(r32, q * 32 + hi * 16); asm volatile("" : "+v"(cb8[q])); }
  const int kh = (wv >> 1) & 1;
  int kb[4];
#pragma unroll
  for (int q = 0; q < 4; ++q) { kb[q] = (int)(uintptr_t)lds + SI_KT + kswz<192>(32 * kh + r32, q * 32 + hi * 16); asm volatile("" : "+v"(kb[q])); }
  int qrb = (int)(uintptr_t)lds + SI_QR + (wv & 3) * 4096 + lane * 16; asm volatile("" : "+v"(qrb));
  const int vb = (int)(uintptr_t)lds + SI_VT + v_rd_base(lane);
  bf16x8 sr_;
  const unsigned goR = (unsigned)(((tid >> 3) * RD + (tid & 7) * 8) * 2);
  const int kro = kswz<192>(tid >> 3, 256 + (tid & 7) * 16);
#define SI_LOAD(t, b) do { const int t_ = (t) < NTS ? (t) : NTS - 1; const char* cb_ = uni64((const char*)(ckv + (long)t_ * KVBLK * KVL)); \
    _Pragma("unroll") for (int j = 0; j < 4; ++j) { const int row_ = (wv * 4 + j) * 2 + (lane >> 5); const unsigned go_ = (unsigned)(row_ * 512 + (((lane & 31) ^ (row_ & 15)) << 4)); \
      __builtin_amdgcn_global_load_lds((const unsigned*)(cb_ + go_), (__attribute__((address_space(3))) unsigned*)((__attribute__((address_space(3))) char*)lds + SI_CK + (b) * 32768 + (wv * 4 + j) * 1024), 16, 0, 0); } \
    sr_ = *(const bf16x8*)((const char*)(krs + (long)t_ * KVBLK * RD) + goR); } while (0)
#define SI_WRITE_ROPE() do { *(bf16x8*)(lds + SI_KT + kro) = sr_; } while (0)
  float m_reg = -1e30f, l_reg = 0.f;
  SI_LOAD(0, 0); asm volatile("s_waitcnt vmcnt(0)" ::: "memory"); SI_WRITE_ROPE(); SI_LOAD(1, 1);
  asm volatile("s_waitcnt vmcnt(0)" ::: "memory"); __syncthreads();
#pragma unroll 1
  for (int t = 0; t < NTS; ++t) {
    const int bo = (t & 1) * 32768;
    f32x16 a0 = {}, a1 = {};
#pragma unroll
    for (int ks = 0; ks < 16; ++ks) { const bf16x8 b0 = *(lp)(cb8[ks & 7] + (ks >> 3) * 256 + bo), b1 = *(lp)(cb8[ks & 7] + (ks >> 3) * 256 + bo + 32 * 512);
      a0 = __builtin_amdgcn_mfma_f32_32x32x16_bf16(wf[ks], b0, a0, 0, 0, 0); a1 = __builtin_amdgcn_mfma_f32_32x32x16_bf16(wf[ks], b1, a1, 0, 0, 0); }
    if (!isV) { float s0 = 0.f, s1 = 0.f;
#pragma unroll
      for (int r = 0; r < 16; ++r) { s0 += a0[r] * a0[r]; s1 += a1[r] * a1[r]; }
      { auto rr = __builtin_amdgcn_permlane32_swap(__float_as_uint(s0), __float_as_uint(s0), false, false); s0 = __uint_as_float(rr[0]) + __uint_as_float(rr[1]); }
      { auto rr = __builtin_amdgcn_permlane32_swap(__float_as_uint(s1), __float_as_uint(s1), false, false); s1 = __uint_as_float(rr[0]) + __uint_as_float(rr[1]); }
      if (hi == 0) { PX[r32 * 4 + (wv & 3)] = s0; PX[(32 + r32) * 4 + (wv & 3)] = s1; } }
    __syncthreads();
    if (!isV) {
      const f32x4 x0 = *(const f32x4*)(PX + r32 * 4), x1 = *(const f32x4*)(PX + (32 + r32) * 4);
      const float r0 = rsqrtf(((x0[0] + x0[1]) + (x0[2] + x0[3])) * (1.0f / 128) + 1e-6f), r1 = rsqrtf(((x1[0] + x1[1]) + (x1[2] + x1[3])) * (1.0f / 128) + 1e-6f);
#pragma unroll
      for (int q = 0; q < 4; ++q) { const int cbt = (cw + 8 * q + 4 * hi) * 2; const f32x4 gq = *(const f32x4*)(gkp + 8 * q);
        unsigned long long w0 = (unsigned long long)cvtpk(a0[4 * q] * r0 * gq[0], a0[4 * q + 1] * r0 * gq[1]) | ((unsigned long long)cvtpk(a0[4 * q + 2] * r0 * gq[2], a0[4 * q + 3] * r0 * gq[3]) << 32);
        unsigned long long w1 = (unsigned long long)cvtpk(a1[4 * q] * r1 * gq[0], a1[4 * q + 1] * r1 * gq[1]) | ((unsigned long long)cvtpk(a1[4 * q + 2] * r1 * gq[2], a1[4 * q + 3] * r1 * gq[3]) << 32);
        *(unsigned long long*)(lds + SI_KT + kswz<192>(r32, cbt)) = w0; *(unsigned long long*)(lds + SI_KT + kswz<192>(32 + r32, cbt)) = w1; }
    } else {
#pragma unroll
      for (int q = 0; q < 4; ++q) { const int c = cw + 8 * q + 4 * hi;
        unsigned long long w0 = (unsigned long long)cvtpk(a0[4 * q], a0[4 * q + 1]) | ((unsigned long long)cvtpk(a0[4 * q + 2], a0[4 * q + 3]) << 32);
        unsigned long long w1 = (unsigned long long)cvtpk(a1[4 * q], a1[4 * q + 1]) | ((unsigned long long)cvtpk(a1[4 * q + 2], a1[4 * q + 3]) << 32);
        *(unsigned long long*)(lds + SI_VT + v_st(r32, c)) = w0; *(unsigned long long*)(lds + SI_VT + v_st(32 + r32, c)) = w1; }
    }
    __syncthreads();
    if (wv < 4) {
      f32x16 p = {};
#pragma unroll
      for (int d0 = 0; d0 < 12; ++d0) { const bf16x8 kf = *(lp)(kb[d0 & 3] + (d0 >> 2) * 128); const bf16x8 qf = d0 < 8 ? qr[d0 < 8 ? d0 : 0] : *(lp)(qrb + (d0 - 8) * 1024);
        p = __builtin_amdgcn_mfma_f32_32x32x16_bf16(kf, qf, p, 0, 0, 0); }
      float pmax = p[0];
#pragma unroll
      for (int r = 1; r < 16; ++r) pmax = fmaxf(pmax, p[r]);
      { auto rr = __builtin_amdgcn_permlane32_swap(__float_as_uint(pmax), __float_as_uint(pmax), false, false); pmax = fmaxf(__uint_as_float(rr[0]), __uint_as_float(rr[1])); }
      float mn, alpha;
      if (__builtin_expect(__all((pmax - m_reg) * C <= THR * LOG2E), 1)) { mn = m_reg; alpha = 1.f; }
      else { mn = fmaxf(m_reg, pmax); alpha = __builtin_amdgcn_exp2f((m_reg - mn) * C); m_reg = mn; }
      const float mnC = -mn * C; float ps = 0.f;
#pragma unroll
      for (int r = 0; r < 16; ++r) { p[r] = __builtin_amdgcn_exp2f(fmaf(p[r], C, mnC)); ps += p[r]; }
      { auto rr = __builtin_amdgcn_permlane32_swap(__float_as_uint(ps), __float_as_uint(ps), false, false); ps = __uint_as_float(rr[0]) + __uint_as_float(rr[1]); }
      l_reg = l_reg * alpha + ps;
      bf16x8 pa0, pa1;
#define SI_PK4(P, BASE, OUT) do { unsigned a0_ = cvtpk(P[BASE + 0], P[BASE + 1]), a1_ = cvtpk(P[BASE + 2], P[BASE + 3]); unsigned b0_ = cvtpk(P[BASE + 4], P[BASE + 5]), b1_ = cvtpk(P[BASE + 6], P[BASE + 7]); \
    auto r0_ = __builtin_amdgcn_permlane32_swap(a0_, b0_, false, false); auto r1_ = __builtin_amdgcn_permlane32_swap(a1_, b1_, false, false); u32x4 w_ = {r0_[0], r1_[0], r0_[1], r1_[1]}; OUT = *reinterpret_cast<bf16x8*>(&w_); } while (0)
      SI_PK4(p, 0, pa0); SI_PK4(p, 8, pa1);
#undef SI_PK4
      if (__any(alpha < 1.f)) { if (hi == 0) al_l[r32] = alpha; asm volatile("s_waitcnt lgkmcnt(0)" ::: "memory");
#pragma unroll
        for (int d = 0; d < 4; ++d)
#pragma unroll
          for (int r = 0; r < 16; ++r) o[d][r] *= al_l[crow(r, hi)]; }
#pragma unroll
      for (int d0 = 0; d0 < 4; ++d0) {
        const int of0 = d0 * 512 + (2 * kh) * 4096, of1 = d0 * 512 + (2 * kh + 1) * 4096;
        const s16x4 l0 = __builtin_amdgcn_ds_read_tr16_b64_v4i16((tp)(vb + of0)), h0 = __builtin_amdgcn_ds_read_tr16_b64_v4i16((tp)(vb + of0 + 2048));
        const s16x4 l1 = __builtin_amdgcn_ds_read_tr16_b64_v4i16((tp)(vb + of1)), h1 = __builtin_amdgcn_ds_read_tr16_b64_v4i16((tp)(vb + of1 + 2048));
        o[d0] = __builtin_amdgcn_mfma_f32_32x32x16_bf16(pa0, (bf16x8){l0[0], l0[1], l0[2], l0[3], h0[0], h0[1], h0[2], h0[3]}, o[d0], 0, 0, 0);
        o[d0] = __builtin_amdgcn_mfma_f32_32x32x16_bf16(pa1, (bf16x8){l1[0], l1[1], l1[2], l1[3], h1[0], h1[1], h1[2], h1[3]}, o[d0], 0, 0, 0); }
    }
    __syncthreads();
    SI_WRITE_ROPE(); SI_LOAD(t + 2, t & 1);
  }
  float* CMB_O = (float*)(lds + 32768); float* CMB_ML = (float*)(lds + SI_PX);
  if (wv == 2 || wv == 3) { if (hi == 0) { CMB_ML[(wv & 1) * 64 + r32 * 2] = m_reg; CMB_ML[(wv & 1) * 64 + r32 * 2 + 1] = l_reg; }
#pragma unroll
    for (int d = 0; d < 4; ++d)
#pragma unroll
      for (int r = 0; r < 16; ++r) CMB_O[(wv & 1) * 4096 + (d * 16 + r) * 64 + lane] = o[d][r]; }
  __syncthreads();
  if (wv < 2) { const float m1 = CMB_ML[wv * 64 + r32 * 2], l1 = CMB_ML[wv * 64 + r32 * 2 + 1]; const float m = fmaxf(m_reg, m1);
    const float e0 = __builtin_amdgcn_exp2f((m_reg - m) * C), e1 = __builtin_amdgcn_exp2f((m1 - m) * C); l_reg = l_reg * e0 + l1 * e1;
    if (hi == 0) { al_l[r32] = e0; ws[r32] = e1; } asm volatile("s_waitcnt lgkmcnt(0)" ::: "memory");
#pragma unroll
    for (int d = 0; d < 4; ++d)
#pragma unroll
      for (int r = 0; r < 16; ++r) o[d][r] = o[d][r] * al_l[crow(r, hi)] + CMB_O[wv * 4096 + (d * 16 + r) * 64 + lane] * ws[crow(r, hi)];
    asm volatile("s_waitcnt lgkmcnt(0)" ::: "memory"); }
  l_out = l_reg;
  __syncthreads();
#undef SI_LOAD
#undef SI_WRITE_ROPE
}
}

constexpr size_t WS_CTL = 0, CTL_BYTES = 1u << 20;
constexpr size_t WS_ROPE = WS_CTL + CTL_BYTES;
constexpr size_t WS_RS = WS_ROPE + (size_t)MP * 32 * 8;
constexpr size_t WS_W1A = WS_RS + (size_t)M * 32 * 4;
constexpr size_t WS_W1D = WS_W1A + (size_t)2 * DFF * D * 2;
constexpr size_t WS_WIG = WS_W1D + (size_t)D * DFF * 2;
constexpr size_t WS_WUQ = WS_WIG + (size_t)8192 * D * 2;
constexpr size_t WS_WKV = WS_WUQ + (size_t)3072 * QL * 2;
constexpr size_t WS_WPL = WS_WKV + (size_t)4096 * KVL * 2;
constexpr size_t WS_WMK = WS_WPL + (size_t)D * PWD * 2;
constexpr size_t WS_WO = WS_WMK + (size_t)2560 * D * 2;
constexpr size_t WS_W2A = WS_WO + (size_t)D * D * 2;
constexpr size_t WS_W2D = WS_W2A + (size_t)2 * DFF * D * 2;
constexpr size_t WS_XB = WS_W2D + (size_t)D * DFF * 2;
constexpr size_t WS_MB = WS_XB + (size_t)M * D * 2;
constexpr size_t WS_MKVRAW = WS_MB + (size_t)NMEM * D * 2;
constexpr size_t WS_MEMKP = WS_MKVRAW + (size_t)NMEM * 2560 * 4;
constexpr size_t WS_MEMVP = WS_MEMKP + (size_t)NMEM * 512 * 2;
constexpr size_t WS_MEMKS = WS_MEMVP + (size_t)NMEM * D * 2;
constexpr size_t WS_MEMVS = WS_MEMKS + (size_t)DB * NMEM * 512 * 2;
constexpr size_t WS_KRP = WS_MEMVS + (size_t)DB * NMEM * D * 2;
constexpr size_t WS_KRS = WS_KRP + (size_t)MP * RD * 2;
constexpr size_t WS_QRAW = WS_KRS + (size_t)DB * SKS * RD * 2;
constexpr size_t WS_CKV = WS_QRAW + (size_t)M * 3072 * 2;
constexpr size_t WS_MERGED = WS_CKV + (size_t)SALL * KVL * 2;
constexpr size_t WS_CQ = WS_MERGED + (size_t)M * D * 2;
constexpr size_t WS_POOLED = WS_CQ + (size_t)M * QL * 2;
constexpr size_t WS_QM = WS_POOLED + (size_t)M * PWD * 2;
constexpr size_t WS_GA = WS_QM + (size_t)M * MQD * 2;
constexpr size_t WS_BIG = WS_GA + (size_t)M * D * 2;
constexpr size_t WS_GP = WS_BIG, WS_GM = WS_GP + (size_t)M * D * 2, WS_INPROJ = WS_GM + (size_t)M * D * 2, WS_EARLY_END = WS_INPROJ + (size_t)M * D * 4;
constexpr size_t WS_KP = WS_INPROJ, WS_VP = WS_KP + (size_t)MP * D * 2, WS_LATE_END = WS_VP + (size_t)MP * D * 2;
static_assert(WS_GP == WS_GA + (size_t)M * D * 2 && WS_GM == WS_GP + (size_t)M * D * 2, "gates contiguous");
constexpr size_t WS_ACT = WS_BIG, WS_ACT_END = WS_ACT + (size_t)M * DFF * 2;
constexpr size_t WS_END = WS_LATE_END > WS_EARLY_END ? (WS_LATE_END > WS_ACT_END ? WS_LATE_END : WS_ACT_END) : (WS_EARLY_END > WS_ACT_END ? WS_EARLY_END : WS_ACT_END);
constexpr int CW_QUEUE = 2048;
constexpr int CW_BAR = 4096;
constexpr size_t O_Y = 0, O_CKVP = (size_t)M * D, O_KRP = O_CKVP + (size_t)DEPTH * MP * KVL, O_POOLP = O_KRP + (size_t)DEPTH * MP * RD, O_MKP = O_POOLP + (size_t)DEPTH * PPAD * PWD,
                 O_MVP = O_MKP + (size_t)DEPTH * NMEM * 512, O_CKVS = O_MVP + (size_t)DEPTH * NMEM * D, O_KRS = O_CKVS + (size_t)DEPTH * MS * KVL, O_POOLS = O_KRS + (size_t)DEPTH * MS * RD,
                 O_END = O_POOLS + (size_t)DEPTH * DB * PPAD * PWD;
constexpr int STAMP_OFF = 131072 + 8192 + 2048;
constexpr int RING_BYTES = 131072, LDSX_OFF = RING_BYTES  , MISC_OFF = LDSX_OFF + 8192, LDS_BYTES = 147456;

#define LAS __attribute__((address_space(3)))
typedef unsigned short bf16;
typedef float f32x4 __attribute__((ext_vector_type(4)));
typedef unsigned u32x4 __attribute__((ext_vector_type(4)));
typedef unsigned u32x2 __attribute__((ext_vector_type(2)));
typedef float f32x2 __attribute__((ext_vector_type(2)));
#define LDS_WAIT() asm volatile("s_waitcnt lgkmcnt(0)" ::: "memory")
__device__ __forceinline__ unsigned pk2(float lo, float hi) { return pg8::cvt_pk_bf16(lo, hi); }
template <int CTRL> __device__ __forceinline__ float dpp_f(float v) { return __uint_as_float(__builtin_amdgcn_update_dpp(0u, __float_as_uint(v), CTRL, 0xf, 0xf, false)); }
__device__ __forceinline__ float sum16(float v) { v += dpp_f<0x128>(v); v += dpp_f<0x124>(v); v += dpp_f<0x122>(v); v += dpp_f<0x121>(v); return v; }
__device__ __forceinline__ float wave_sum(float v) { return pg8::xsum_fq(sum16(v)); }
__device__ __forceinline__ float sum_x32(float v) { const auto b = __builtin_amdgcn_permlane32_swap(__float_as_uint(v), __float_as_uint(v), false, false); return __uint_as_float(b[0]) + __uint_as_float(b[1]); }
__device__ __forceinline__ float other_x32(float v, bool upper) { const auto b = __builtin_amdgcn_permlane32_swap(__float_as_uint(v), __float_as_uint(v), false, false); return __uint_as_float(upper ? b[0] : b[1]); }

#define XB_TMO      128
#define XB_XCNT(j)  (256  + 64 * (j))
#define XB_XSUB(j)  (1280 + 64 * (j))
#define XB_XGEN(j)  (2304 + 64 * (j))
#define XB_TOP      3328
#define XB_TOPGEN   3392
#define XCD_BAR_WORDS 3456
#define XB_SPIN_CAP (1u << 22)

__device__ __forceinline__ unsigned xb_ld(unsigned* p)              { return __hip_atomic_load(p, __ATOMIC_RELAXED, __HIP_MEMORY_SCOPE_AGENT); }
__device__ __forceinline__ unsigned xb_add(unsigned* p, unsigned v) { return __hip_atomic_fetch_add(p, v, __ATOMIC_RELAXED, __HIP_MEMORY_SCOPE_AGENT); }
__device__ __forceinline__ unsigned xb_xcc_id() { return (unsigned)__builtin_amdgcn_s_getreg((3 << 11) | 20) & 0xFu; }
#define XB_SPIN(cond, bar) do { unsigned _sp = 0; while (cond) { __builtin_amdgcn_s_sleep(1); \
    if ((++_sp & 255u) == 0u) { if (xb_ld(&(bar)[XB_TMO])) break; if (_sp > XB_SPIN_CAP) { atomicAdd(&(bar)[XB_TMO], 1u); break; } } } } while (0)

struct XcdBarrier {
    unsigned* bar; unsigned x;
    volatile LAS unsigned* st;
};

__device__ __forceinline__ XcdBarrier xcd_barrier_post(unsigned* bar, volatile LAS unsigned* st) {
    XcdBarrier b; b.bar = bar; b.x = xb_xcc_id(); b.st = st;
    if (threadIdx.x == 0) (void)xb_add(&bar[XB_XCNT(b.x)], 1u);
    return b;
}
__device__ __forceinline__ void xcd_barrier_complete(unsigned* bar, unsigned x, unsigned& nloc, unsigned& nx) {
    const unsigned G = gridDim.x * gridDim.y * gridDim.z;
    unsigned sum, cnt, mine, sp = 0u;
    for (;;) {
        sum = 0u; cnt = 0u; mine = 0u;
#pragma unroll
        for (unsigned j = 0; j < 16; ++j) { const unsigned c = xb_ld(&bar[XB_XCNT(j)]); sum += c; cnt += (c > 0u) ? 1u : 0u; mine = (j == x) ? c : mine; }
        if (sum == G) break;
        __builtin_amdgcn_s_sleep(1);
        if ((++sp & 255u) == 0u) { if (xb_ld(&bar[XB_TMO])) break; if (sp > XB_SPIN_CAP) { atomicAdd(&bar[XB_TMO], 1u); break; } }
    }
    nloc = mine > 0u ? mine : 1u; nx = cnt > 0u ? cnt : 1u;
}

__device__ __forceinline__ void xcd_barrier(const XcdBarrier& b) {
    asm volatile("s_waitcnt vmcnt(0)" ::: "memory");
    __syncthreads();
    if (threadIdx.x == 0) {
        unsigned* bar = b.bar;
        __builtin_amdgcn_s_waitcnt(0);
        unsigned nloc = b.st[0], nx = b.st[1];
        if (nloc == 0u) { xcd_barrier_complete(bar, b.x, nloc, nx); b.st[0] = nloc; b.st[1] = nx; }
        const unsigned old = xb_add(&bar[XB_XSUB(b.x)], 1u);
        const unsigned gen = old / nloc;
        if (old + 1u == (gen + 1u) * nloc) {
            __builtin_amdgcn_fence(__ATOMIC_RELEASE, "agent");
            asm volatile("s_waitcnt vmcnt(0)" ::: "memory");
            const unsigned og = xb_add(&bar[XB_TOP], 1u);
            const unsigned tg = og / nx;
            if (og + 1u == (tg + 1u) * nx) xb_add(&bar[XB_TOPGEN], 1u);
            else XB_SPIN(xb_ld(&bar[XB_TOPGEN]) == tg, bar);
            __builtin_amdgcn_fence(__ATOMIC_ACQUIRE, "agent");
            xb_add(&bar[XB_XGEN(b.x)], 1u);
            asm volatile("s_waitcnt vmcnt(0)" ::: "memory");
        } else {
            XB_SPIN(xb_ld(&bar[XB_XGEN(b.x)]) == gen, bar);
            __builtin_amdgcn_fence(__ATOMIC_ACQUIRE, "agent");
            asm volatile("s_waitcnt vmcnt(0)" ::: "memory");
        }
    }
    __syncthreads();
}


enum { PH_PREP = 0, PH_F1A, PH_F1D, PH_F1C, PH_ING, PH_POST, PH_UQP, PH_KV0, PH_ATT0, PH_WO, PH_WOC, PH_F2A, PH_F2D, PH_F2C, NPH };
enum { I_XP = 0, I_XS, I_MEMP, I_CCKV, I_CKR, I_SPOOL, I_CMK, I_CMV, I_F1N, I_F1G, I_F1U, I_F1D, I_MIXN, I_WIN, I_QLN, I_KVLN, I_WUQ, I_WUQR, I_WUK, I_WUV, I_QN, I_KN, I_QRN, I_KRN,
       I_POOLW, I_POOLS, I_MEMN, I_WMK, I_WMV, I_MQN, I_MKN, I_WG, I_BG, I_WOUT, I_F2N, I_F2G, I_F2U, I_F2D, N_IN };
struct Params { const float* in[N_IN]; float* out; unsigned char* ws; double inv[32]; int ph_lo, ph_hi, li, pad; };
constexpr int PT_OFF = MISC_OFF + 256, PT_OUT = N_IN, PT_WS = N_IN + 1, PT_INV = PT_OFF + 8 * (N_IN + 2);
__device__ __forceinline__ const float* ldp(LAS unsigned char* lds, int i) {
    const LAS unsigned* t = (const LAS unsigned*)(lds + PT_OFF) + 2 * i;
    const unsigned lo = __builtin_amdgcn_readfirstlane(t[0]), hi = __builtin_amdgcn_readfirstlane(t[1]);
    return (const float*)(const __attribute__((address_space(1))) float*)(((unsigned long long)hi << 32) | (unsigned long long)lo);
}
__device__ __forceinline__ unsigned char* ldws(LAS unsigned char* lds) { return (unsigned char*)ldp(lds, PT_WS); }
__device__ __forceinline__ float* ldout(LAS unsigned char* lds) { return (float*)ldp(lds, PT_OUT); }

__device__ __forceinline__ void tr_item(const float* W, int N, const float* gain, bf16* dst, int ldt, int mode, int item, LAS float* scr, int lane) {
    const int nblk = N >> 6, kb = item / nblk, nb = item - kb * nblk, k0 = kb << 6, n0 = nb << 6;
    const int drow0 = mode == 0 ? n0 : (((n0 >> 7) << 8) + (n0 & 127) + (mode == 2 ? 128 : 0));
    const float* src = W + (size_t)k0 * N + n0 + lane;
    float v[64];
#pragma unroll
    for (int i = 0; i < 64; ++i) v[i] = src[(size_t)i * N];
    if (gain) {
#pragma unroll
        for (int i = 0; i < 64; ++i) v[i] *= gain[k0 + i]; }
#pragma unroll
    for (int i = 0; i < 64; ++i) scr[i * 65 + lane] = v[i];
    LDS_WAIT(); asm volatile("" ::: "memory");
    const int c = lane & 7;
#pragma unroll
    for (int j = 0; j < 8; ++j) { const int n = (lane >> 3) + 8 * j; const LAS float* s = scr + (8 * c) * 65 + n;
        u32x4 o; o.x = pk2(s[0 * 65], s[1 * 65]); o.y = pk2(s[2 * 65], s[3 * 65]); o.z = pk2(s[4 * 65], s[5 * 65]); o.w = pk2(s[6 * 65], s[7 * 65]);
        *(u32x4*)(dst + (size_t)(drow0 + n) * ldt + k0 + 8 * c) = o; }
    LDS_WAIT(); asm volatile("" ::: "memory");
}
__device__ __forceinline__ u32x4 cvt8(const float* p) { const f32x4 a = *(const f32x4*)p, b = *(const f32x4*)(p + 4); u32x4 o; o.x = pk2(a[0], a[1]); o.y = pk2(a[2], a[3]); o.z = pk2(b[0], b[1]); o.w = pk2(b[2], b[3]); return o; }

__device__ __forceinline__ void phase_prep(int l, LAS unsigned char* lds, const int wv) {
    int tid_ = wv * 64 + lane_id_fresh(); asm volatile("" : "+v"(tid_));     const int lane = tid_ & 63, wave = __builtin_amdgcn_readfirstlane(tid_ >> 6);
    unsigned char* ws = ldws(lds);
    LAS float* scr = (LAS float*)(lds + wave * 16640);
    const int gw = blockIdx.x * 8 + wave, NGW = gridDim.x * 8;
    constexpr int C_FA = (D / 64) * (DFF / 64), C_FD = (DFF / 64) * (D / 64), C_IN = (D / 64) * (INW / 64), C_G = (D / 64) * (3 * D / 64), C_UQ = (QL / 64) * (D / 64), C_UQR = (QL / 64) * (1024 / 64),
                  C_UK = (KVL / 64) * (D / 64), C_PL = 4 * 2 * 8, C_MK = (D / 64) * (512 / 64), C_MV = (D / 64) * (D / 64), C_WO = (D / 64) * (D / 64), C_ZIG = 192, C_ZPL = D;
    constexpr int NITEMS = 4 * C_FA + 2 * C_FD + C_IN + C_G + C_UQ + C_UQR + 2 * C_UK + C_PL + C_MK + C_MV + C_WO + C_ZIG + C_ZPL;
    for (int it = gw; it < NITEMS; it += NGW) {
        int r = it;
        if (r < C_FA) { tr_item(ldp(lds, I_F1G) + (size_t)l * D * DFF, DFF, ldp(lds, I_F1N) + l * D, (bf16*)(ws + WS_W1A), D, 1, r, scr, lane); continue; } r -= C_FA;
        if (r < C_FA) { tr_item(ldp(lds, I_F1U) + (size_t)l * D * DFF, DFF, ldp(lds, I_F1N) + l * D, (bf16*)(ws + WS_W1A), D, 2, r, scr, lane); continue; } r -= C_FA;
        if (r < C_FD) { tr_item(ldp(lds, I_F1D) + (size_t)l * D * DFF, D, nullptr, (bf16*)(ws + WS_W1D), DFF, 0, r, scr, lane); continue; } r -= C_FD;
        if (r < C_FA) { tr_item(ldp(lds, I_F2G) + (size_t)l * D * DFF, DFF, ldp(lds, I_F2N) + l * D, (bf16*)(ws + WS_W2A), D, 1, r, scr, lane); continue; } r -= C_FA;
        if (r < C_FA) { tr_item(ldp(lds, I_F2U) + (size_t)l * D * DFF, DFF, ldp(lds, I_F2N) + l * D, (bf16*)(ws + WS_W2A), D, 2, r, scr, lane); continue; } r -= C_FA;
        if (r < C_FD) { tr_item(ldp(lds, I_F2D) + (size_t)l * D * DFF, D, nullptr, (bf16*)(ws + WS_W2D), DFF, 0, r, scr, lane); continue; } r -= C_FD;
        if (r < C_IN) { tr_item(ldp(lds, I_WIN) + (size_t)l * D * INW, INW, ldp(lds, I_MIXN) + l * D, (bf16*)(ws + WS_WIG), D, 0, r, scr, lane); continue; } r -= C_IN;
        if (r < C_G) { tr_item(ldp(lds, I_WG) + (size_t)l * D * 3 * D, 3 * D, ldp(lds, I_MIXN) + l * D, (bf16*)(ws + WS_WIG) + (size_t)D * D, D, 0, r, scr, lane); continue; } r -= C_G;
        if (r < C_UQ) { tr_item(ldp(lds, I_WUQ) + (size_t)l * QL * D, D, nullptr, (bf16*)(ws + WS_WUQ), QL, 0, r, scr, lane); continue; } r -= C_UQ;
        if (r < C_UQR) { tr_item(ldp(lds, I_WUQR) + (size_t)l * QL * 1024, 1024, nullptr, (bf16*)(ws + WS_WUQ) + (size_t)D * QL, QL, 0, r, scr, lane); continue; } r -= C_UQR;
        if (r < C_UK) { tr_item(ldp(lds, I_WUK) + (size_t)l * KVL * D, D, nullptr, (bf16*)(ws + WS_WKV), KVL, 0, r, scr, lane); continue; } r -= C_UK;
        if (r < C_UK) { tr_item(ldp(lds, I_WUV) + (size_t)l * KVL * D, D, nullptr, (bf16*)(ws + WS_WKV) + (size_t)D * KVL, KVL, 0, r, scr, lane); continue; } r -= C_UK;
        if (r < C_PL) { const int g = r >> 4; tr_item(ldp(lds, I_POOLW) + ((size_t)l * 4 + g) * 128 * 512, 512, nullptr, (bf16*)(ws + WS_WPL) + (size_t)(g * 512) * PWD + g * 128, PWD, 0, r & 15, scr, lane); continue; } r -= C_PL;
        if (r < C_MK) { tr_item(ldp(lds, I_WMK) + (size_t)l * D * 512, 512, nullptr, (bf16*)(ws + WS_WMK), D, 0, r, scr, lane); continue; } r -= C_MK;
        if (r < C_MV) { tr_item(ldp(lds, I_WMV) + (size_t)l * D * D, D, nullptr, (bf16*)(ws + WS_WMK) + (size_t)512 * D, D, 0, r, scr, lane); continue; } r -= C_MV;
        if (r < C_WO) { tr_item(ldp(lds, I_WOUT) + (size_t)l * D * D, D, nullptr, (bf16*)(ws + WS_WO), D, 0, r, scr, lane); continue; } r -= C_WO;
        if (r < C_ZIG) { u32x4* o = (u32x4*)((bf16*)(ws + WS_WIG) + (size_t)(INW + r) * D) + lane; const u32x4 z = {0u, 0u, 0u, 0u}; o[0] = z; o[64] = z; o[128] = z; o[192] = z; continue; } r -= C_ZIG;
        { if ((lane >> 4) != (r >> 9)) { const u32x4 z = {0u, 0u, 0u, 0u}; *((u32x4*)((bf16*)(ws + WS_WPL) + (size_t)r * PWD) + lane) = z; } }
    }
    const size_t tix = (size_t)gw * 64 + lane, tst = (size_t)NGW * 64;
    { const float* src = ldp(lds, I_CCKV) + (size_t)l * DB * PAST * KVL; bf16* dst = (bf16*)(ws + WS_CKV);
      for (size_t e0 = tix; e0 < (size_t)DB * PAST * (KVL / 8); e0 += 4 * tst) { u32x4 t[4];
#pragma unroll
          for (int q = 0; q < 4; ++q) { const size_t e = e0 + q * tst; if (e < (size_t)DB * PAST * (KVL / 8)) t[q] = cvt8(src + e * 8); }
#pragma unroll
          for (int q = 0; q < 4; ++q) { const size_t e = e0 + q * tst; if (e < (size_t)DB * PAST * (KVL / 8)) { const size_t row = e >> 5, c8 = e & 31, b = row >> 12, s = row & 4095; *(u32x4*)(dst + ((size_t)MP + b * SKS + s) * KVL + c8 * 8) = t[q]; } } } }
    { const float* src = ldp(lds, I_CKR) + (size_t)l * DB * PAST * RD; bf16* dst = (bf16*)(ws + WS_KRS);
      for (size_t e0 = tix; e0 < (size_t)DB * PAST * (RD / 8); e0 += 4 * tst) { u32x4 t[4];
#pragma unroll
          for (int q = 0; q < 4; ++q) { const size_t e = e0 + q * tst; if (e < (size_t)DB * PAST * (RD / 8)) t[q] = cvt8(src + e * 8); }
#pragma unroll
          for (int q = 0; q < 4; ++q) { const size_t e = e0 + q * tst; if (e < (size_t)DB * PAST * (RD / 8)) { const size_t row = e >> 3, c8 = e & 7, b = row >> 12, s = row & 4095; *(u32x4*)(dst + (b * SKS + s) * RD + c8 * 8) = t[q]; } } } }
    { const float* src = ldp(lds, I_CMK) + (size_t)l * DB * NMEM * 512; bf16* dst = (bf16*)(ws + WS_MEMKS);
      for (size_t e0 = tix; e0 < (size_t)DB * NMEM * 512 / 8; e0 += 4 * tst) { u32x4 t[4];
#pragma unroll
          for (int q = 0; q < 4; ++q) { const size_t e = e0 + q * tst; if (e < (size_t)DB * NMEM * 512 / 8) t[q] = cvt8(src + e * 8); }
#pragma unroll
          for (int q = 0; q < 4; ++q) { const size_t e = e0 + q * tst; if (e < (size_t)DB * NMEM * 512 / 8) *(u32x4*)(dst + e * 8) = t[q]; } } }
    { const float* src = ldp(lds, I_CMV) + (size_t)l * DB * NMEM * D; bf16* dst = (bf16*)(ws + WS_MEMVS);
      for (size_t e0 = tix; e0 < (size_t)DB * NMEM * D / 8; e0 += 4 * tst) { u32x4 t[4];
#pragma unroll
          for (int q = 0; q < 4; ++q) { const size_t e = e0 + q * tst; if (e < (size_t)DB * NMEM * D / 8) t[q] = cvt8(src + e * 8); }
#pragma unroll
          for (int q = 0; q < 4; ++q) { const size_t e = e0 + q * tst; if (e < (size_t)DB * NMEM * D / 8) *(u32x4*)(dst + e * 8) = t[q]; } } }
    { const float* mn = ldp(lds, I_MEMN) + l * D; const float* memp = ldp(lds, I_MEMP); bf16* MBp = (bf16*)(ws + WS_MB);
      for (int row = gw; row < NMEM; row += NGW) { const float* x = memp + (size_t)row * D; f32x4 v[8]; float ss = 0.f;
#pragma unroll
          for (int j = 0; j < 8; ++j) { v[j] = *(const f32x4*)(x + j * 256 + lane * 4); ss += pg8::dot4(v[j]); }
          const float r = rsqrtf(wave_sum(ss) * (1.0f / D) + EPS);
#pragma unroll
          for (int j = 0; j < 8; ++j) { const f32x4 g = *(const f32x4*)(mn + j * 256 + lane * 4); const f32x4 y = v[j] * r * g; u32x2 o; o.x = pk2(y[0], y[1]); o.y = pk2(y[2], y[3]); *(u32x2*)(MBp + (size_t)row * D + j * 256 + lane * 4) = o; } } }
    if (l == 0) {
        bf16* XB = (bf16*)(ws + WS_XB); float* RS = (float*)(ws + WS_RS); const float* xp = ldp(lds, I_XP); const float* xs = ldp(lds, I_XS);
        for (int row = gw; row < M; row += NGW) { const float* x = row < MP ? xp + (size_t)row * D : xs + (size_t)(row - MP) * D; float ss = 0.f;
#pragma unroll
            for (int j = 0; j < 8; ++j) { const f32x4 v = *(const f32x4*)(x + j * 256 + lane * 4); ss += pg8::dot4(v); u32x2 o; o.x = pk2(v[0], v[1]); o.y = pk2(v[2], v[3]); *(u32x2*)(XB + (size_t)row * D + j * 256 + lane * 4) = o; }
            ss = wave_sum(ss); if (lane < 32) RS[(size_t)row * 32 + lane] = lane == 0 ? ss : 0.f; }
        f32x2* tab = (f32x2*)(ws + WS_ROPE);
        for (size_t e = tix; e < (size_t)MP * 32; e += tst) { const int pos = (int)(e >> 5), i = (int)(e & 31);
            const double ang = (double)pos * ((const LAS double*)(lds + PT_INV))[i]; const double n = __builtin_rint(ang * 0.15915494309189535); const double rr = __builtin_fma(-n, 6.283185307179586, ang) - n * 2.4492935982947064e-16;
            const double x2 = rr * rr; double sn = 0.0, cs = 0.0;
#pragma unroll
            for (int k = 14; k >= 1; --k) { sn = (sn + 1.0) * (x2 * (-1.0 / (double)((2 * k) * (2 * k + 1)))); cs = (cs + 1.0) * (x2 * (-1.0 / (double)((2 * k - 1) * (2 * k)))); }
            sn = (sn + 1.0) * rr; cs = cs + 1.0;
            tab[e] = (f32x2){(float)cs, (float)sn}; }
    }
}

constexpr size_t WS_SLAB = WS_QRAW;
template <bool F32SRC, bool F32OUT>
__device__ __forceinline__ void phase_combine(const float* resid  , float alpha, LAS unsigned char* lds, const int wv) {
    int tid_ = wv * 64 + lane_id_fresh(); asm volatile("" : "+v"(tid_)); const int lane = tid_ & 63, wave = __builtin_amdgcn_readfirstlane(tid_ >> 6);
    unsigned char* ws = ldws(lds); const float* slab = (const float*)(ws + WS_SLAB); float* R = ldout(lds) + O_Y + (size_t)MP * D; bf16* XB = (bf16*)(ws + WS_XB) + (size_t)MP * D; float* RS = (float*)(ws + WS_RS) + (size_t)MP * 32;
    const int gw = blockIdx.x * 8 + wave, NGW = gridDim.x * 8;
    for (int row = gw; row < MS; row += NGW) { float ss = 0.f;
#pragma unroll
        for (int j = 0; j < 8; ++j) { const size_t off = (size_t)row * D + j * 256 + lane * 4; f32x4 a = *(const f32x4*)(slab + off);
#pragma unroll
            for (int k = 1; k < 8; ++k) a += *(const f32x4*)(slab + (size_t)k * MS * D + off);
            f32x4 x; if constexpr (F32SRC) x = *(const f32x4*)(resid + off); else { const u32x2 w = *(const u32x2*)(XB + off); x = (f32x4){pg8::bf_lo(w.x), pg8::bf_hi(w.x), pg8::bf_lo(w.y), pg8::bf_hi(w.y)}; }
            const f32x4 o = x + a * alpha; if constexpr (F32OUT) *(f32x4*)(R + off) = o; u32x2 w2; w2.x = pk2(o[0], o[1]); w2.y = pk2(o[2], o[3]); *(u32x2*)(XB + off) = w2; ss += pg8::dot4(o); }
        ss = wave_sum(ss); if (lane < 32) RS[(size_t)row * 32 + lane] = lane == 0 ? ss : 0.f; }
}
__device__ __forceinline__ void phase_post(int l, LAS unsigned char* lds, const int wv) {
    int tid_ = wv * 64 + lane_id_fresh(); asm volatile("" : "+v"(tid_));     const int lane = tid_ & 63, wave = __builtin_amdgcn_readfirstlane(tid_ >> 6);
    unsigned char* ws = ldws(lds); const int gw = blockIdx.x * 8 + wave, NGW = gridDim.x * 8;
    const float* INP = (const float*)(ws + WS_INPROJ); const f32x2* tab = (const f32x2*)(ws + WS_ROPE);
    bf16* CQ = (bf16*)(ws + WS_CQ); bf16* CKV = (bf16*)(ws + WS_CKV); bf16* KRP = (bf16*)(ws + WS_KRP); bf16* KRS = (bf16*)(ws + WS_KRS); bf16* POOLED = (bf16*)(ws + WS_POOLED); bf16* QM = (bf16*)(ws + WS_QM);
    const float* qln = ldp(lds, I_QLN) + l * QL; const float* kvln = ldp(lds, I_KVLN) + l * KVL; const float* krn = ldp(lds, I_KRN) + l * RD; const float* mqn = ldp(lds, I_MQN) + l * 128;
    float* out = ldout(lds); const float* spool = ldp(lds, I_SPOOL); const float* mkn = ldp(lds, I_MKN) + l * 128;
    const f32x4 gq0 = *(const f32x4*)(qln + 8 * lane), gq1 = *(const f32x4*)(qln + 8 * lane + 4), gkv = *(const f32x4*)(kvln + 4 * lane);
    const f32x4 gm0 = *(const f32x4*)(mqn + ((8 * lane) & 127)), gm1 = *(const f32x4*)(mqn + ((8 * lane) & 127) + 4); const float gkr = krn[lane];
    const int NBLK = M / 4;
    for (int blk = gw; blk < NBLK + NMEM; blk += NGW) {
        if (blk >= NBLK) {
            const int j = blk - NBLK; const float* raw = (const float*)(ws + WS_MKVRAW) + (size_t)j * 2560;
            { const f32x4 a = *(const f32x4*)(raw + 8 * lane), b = *(const f32x4*)(raw + 8 * lane + 4); const float r = rsqrtf(sum16(pg8::dot4(a) + pg8::dot4(b)) * (1.0f / 128) + EPS);
              const f32x4 g0 = *(const f32x4*)(mkn + ((8 * lane) & 127)), g1 = *(const f32x4*)(mkn + ((8 * lane) & 127) + 4); const f32x4 y0 = a * r * g0, y1 = b * r * g1;
              float* o = out + O_MKP + ((size_t)l * NMEM + j) * 512 + 8 * lane; *(f32x4*)o = y0; *(f32x4*)(o + 4) = y1;
              *(u32x4*)((bf16*)(ws + WS_MEMKP) + (size_t)j * 512 + 8 * lane) = pg8::pack8(y0, y1); }
#pragma unroll
            for (int q = 0; q < 4; ++q) { const f32x4 a = *(const f32x4*)(raw + 512 + q * 512 + 8 * lane), b = *(const f32x4*)(raw + 512 + q * 512 + 8 * lane + 4);
              float* o = out + O_MVP + ((size_t)l * NMEM + j) * D + q * 512 + 8 * lane; *(f32x4*)o = a; *(f32x4*)(o + 4) = b;
              *(u32x4*)((bf16*)(ws + WS_MEMVP) + (size_t)j * D + q * 512 + 8 * lane) = pg8::pack8(a, b); }
            continue;
        }
        const int r0 = blk * 4; const bool samp = r0 >= MP; const int b = samp ? (r0 - MP) >> 6 : 0; const int s0 = samp ? MP + b * DS : 0; const int t0 = r0 - s0;
        const int w = 2 << (lane >> 4);
        f32x4 acc[4][2], cur[4][2];
#pragma unroll
        for (int k = 0; k < 4; ++k) { acc[k][0] = (f32x4){0.f, 0.f, 0.f, 0.f}; acc[k][1] = acc[k][0]; cur[k][0] = acc[k][0]; cur[k][1] = acc[k][0]; }
        for (int dj = 0; dj < 19; ++dj) { const int t = t0 + 3 - dj;
            if (dj < w + 3) { f32x4 a = {0.f, 0.f, 0.f, 0.f}, bb = a;
                if (t >= 0) { const float* src = INP + (size_t)(s0 + t) * D + 832 + 8 * lane; a = *(const f32x4*)src; bb = *(const f32x4*)(src + 4); }
                else if (samp) { const float* src = spool + (((size_t)l * DB + b) * PPAD + (PPAD + t)) * PWD + 8 * lane; a = *(const f32x4*)src; bb = *(const f32x4*)(src + 4); }
#pragma unroll
                for (int k = 0; k < 4; ++k) { const int d = k - (3 - dj);
                    if (d >= 0 && d < w) { acc[k][0] += a; acc[k][1] += bb; } if (d == 0) { cur[k][0] = a; cur[k][1] = bb; } } } }
#pragma unroll
        for (int k = 0; k < 4; ++k) { const int t = t0 + k; const int cnt = samp ? w : (t + 1 < w ? t + 1 : w); const float ic = 1.0f / (float)cnt;
            *(u32x4*)(POOLED + (size_t)(r0 + k) * PWD + 8 * lane) = pg8::pack8(acc[k][0] * ic - cur[k][0], acc[k][1] * ic - cur[k][1]);
            const int T = samp ? DS : MP;
            if (t >= T - PPAD) { float* o = samp ? out + O_POOLS + (((size_t)l * DB + b) * PPAD + (t - (T - PPAD))) * PWD + 8 * lane : out + O_POOLP + ((size_t)l * PPAD + (t - (T - PPAD))) * PWD + 8 * lane;
                *(f32x4*)o = cur[k][0]; *(f32x4*)(o + 4) = cur[k][1]; } }
#pragma unroll 1
        for (int k = 0; k < 4; ++k) { const int row = r0 + k, t = t0 + k; const float* ip = INP + (size_t)row * D;
            { const f32x4 a = *(const f32x4*)(ip + 8 * lane), bb = *(const f32x4*)(ip + 8 * lane + 4); const float r = rsqrtf(wave_sum(pg8::dot4(a) + pg8::dot4(bb)) * (1.0f / QL) + EPS);
              *(u32x4*)(CQ + (size_t)row * QL + 8 * lane) = pg8::pack8(a * r * gq0, bb * r * gq1); }
            { const f32x4 a = *(const f32x4*)(ip + 512 + 4 * lane); const float r = rsqrtf(wave_sum(pg8::dot4(a)) * (1.0f / KVL) + EPS); const f32x4 y = a * r * gkv;
              float* o = samp ? out + O_CKVS + ((size_t)l * MS + (row - MP)) * KVL + 4 * lane : out + O_CKVP + ((size_t)l * MP + row) * KVL + 4 * lane; *(f32x4*)o = y;
              const size_t crow = samp ? (size_t)MP + (size_t)b * SKS + PAST + t : (size_t)row; u32x2 o2; o2.x = pk2(y[0], y[1]); o2.y = pk2(y[2], y[3]); *(u32x2*)(CKV + crow * KVL + 4 * lane) = o2; }
            { const float x = ip[768 + lane]; const float r = rsqrtf(wave_sum(x * x) * (1.0f / RD) + EPS); const float v = x * r * gkr; const float pv = other_x32(v, lane >= 32);
              const int pos = samp ? PAST + t : t; const f32x2 cs = tab[(size_t)pos * 32 + (lane & 31)];
              const float y = lane < 32 ? v * cs.x - pv * cs.y : pv * cs.y + v * cs.x;
              float* o = samp ? out + O_KRS + ((size_t)l * MS + (row - MP)) * RD + lane : out + O_KRP + ((size_t)l * MP + row) * RD + lane; *o = y;
              bf16* ko = samp ? KRS + ((size_t)b * SKS + PAST + t) * RD + lane : KRP + (size_t)row * RD + lane; *ko = (bf16)(pk2(y, 0.f) & 0xffffu); }
            { const f32x4 a = *(const f32x4*)(ip + 1344 + 8 * lane), bb = *(const f32x4*)(ip + 1344 + 8 * lane + 4); const float r = rsqrtf(sum16(pg8::dot4(a) + pg8::dot4(bb)) * (1.0f / 128) + EPS);
              *(u32x4*)(QM + (size_t)row * MQD + 8 * lane) = pg8::pack8(a * r * gm0, bb * r * gm1); }
        }
    }
}

__device__ __forceinline__ void attn_store(att::f32x16* o, float l_reg, const bf16* gate, bf16* merged, bool store, float* li_l, float* stg, int lane) {
    const int r32 = lane & 31, hi = lane >> 5;
    if (!store) return;
    if (hi == 0) li_l[r32] = l_reg; LDS_WAIT();
    float rl[16];
#pragma unroll
    for (int r = 0; r < 16; ++r) rl[r] = __builtin_amdgcn_rcpf(li_l[att::crow(r, hi)]);
#pragma unroll
    for (int h = 0; h < 2; ++h) {
#pragma unroll
        for (int d = 0; d < 2; ++d)
#pragma unroll
            for (int r = 0; r < 16; ++r) stg[att::crow(r, hi) * 68 + d * 32 + r32] = o[2 * h + d][r] * rl[r];
        LDS_WAIT();
#pragma unroll
        for (int i = 0; i < 4; ++i) { const int p = lane + 64 * i, row = p >> 3, c8 = p & 7; const f32x4 a = *(const f32x4*)(stg + row * 68 + c8 * 8), bq = *(const f32x4*)(stg + row * 68 + c8 * 8 + 4);
            const size_t idx = (size_t)row * D + h * 64 + c8 * 8; const u32x4 g = *(const u32x4*)(gate + idx), m = *(const u32x4*)(merged + idx);
            const f32x4 o0 = {att::bflo(m.x) + att::bflo(g.x) * a[0], att::bfhi(m.x) + att::bfhi(g.x) * a[1], att::bflo(m.y) + att::bflo(g.y) * a[2], att::bfhi(m.y) + att::bfhi(g.y) * a[3]};
            const f32x4 o1 = {att::bflo(m.z) + att::bflo(g.z) * bq[0], att::bfhi(m.z) + att::bfhi(g.z) * bq[1], att::bflo(m.w) + att::bflo(g.w) * bq[2], att::bfhi(m.w) + att::bfhi(g.w) * bq[3]};
            *(u32x4*)(merged + idx) = pg8::pack8(o0, o1); }
        LDS_WAIT(); asm volatile("" ::: "memory");
    }
}
__device__ __forceinline__ void mem_attn_item(int l, LAS unsigned char* ldsl, char* lds, bool samp, int qb, int hc, const int wv) {
    int tid_ = wv * 64 + lane_id_fresh(); asm volatile("" : "+v"(tid_)); const int lane = tid_ & 63, wave = __builtin_amdgcn_readfirstlane(tid_ >> 6);
    unsigned char* ws = ldws(ldsl); const int r32 = lane & 31, hi = lane >> 5;
    const bf16* QM = (const bf16*)(ws + WS_QM); const bf16* GM = (const bf16*)(ws + WS_GM); bf16* MERGED = (bf16*)(ws + WS_MERGED);
    float* li_l = (float*)(lds + att::ATT_WS_OFF) + wave * 64;
    const float C = 0.08838834764831845f * LOG2E;
    const int h = hc >> 2, c = hc & 3;
    const int rowbase = samp ? MP + qb * DS + (wave & 1) * 32 : qb * 256 + wave * 32;
    const bf16* Kb = samp ? (const bf16*)(ws + WS_MEMKS) + (size_t)qb * NMEM * 512 + h * 128 : (const bf16*)(ws + WS_MEMKP) + h * 128;
    const bf16* Vb = samp ? (const bf16*)(ws + WS_MEMVS) + (size_t)qb * NMEM * D + h * 512 + c * 128 : (const bf16*)(ws + WS_MEMVP) + h * 512 + c * 128;
    att::bf16x8 qr[8];
    const bf16* qp = QM + (size_t)(rowbase + r32) * MQD + h * 128 + hi * 8;
#pragma unroll
    for (int d0 = 0; d0 < 8; ++d0) qr[d0] = *(const att::bf16x8*)(qp + d0 * 16);
    att::f32x16 o[4] = {}; float l_reg;
    int nt = 4; asm volatile("" : "+s"(nt)); att::attn_item_pp<128, 512, D, false>(qr, Kb, nullptr, Vb, nt, nt, nt, C, lds, o, l_reg, wv, !samp || wave < 2);
    const size_t ob = (size_t)rowbase * D + h * 512 + c * 128;
    attn_store(o, l_reg, GM + ob, MERGED + ob, !samp || wave < 2, li_l, (float*)(lds + wave * 8704), lane);
    __syncthreads();
}
__device__ __forceinline__ void main_attn_item(int l, LAS unsigned char* ldsl, char* lds, bool samp, int qb_or_b, int h, const int wv) {
    int tid_ = wv * 64 + lane_id_fresh(); asm volatile("" : "+v"(tid_));     const int lane = tid_ & 63, wave = __builtin_amdgcn_readfirstlane(tid_ >> 6);
    unsigned char* ws = ldws(ldsl); const int r32 = lane & 31, hi = lane >> 5;
    const bf16* QRAW = (const bf16*)(ws + WS_QRAW); const bf16* GA = (const bf16*)(ws + WS_GA); bf16* MERGED = (bf16*)(ws + WS_MERGED); const f32x2* tab = (const f32x2*)(ws + WS_ROPE);
    float* li_l = (float*)(lds + (samp ? att::SI_WS : att::ATT_WS_OFF)) + wave * 64;
    const float C = 0.07216878364870322f * LOG2E;
    const int rowbase = samp ? MP + qb_or_b * DS + (wave & 1) * 32 : qb_or_b * 256 + wave * 32;
    const int row = rowbase + r32; const int pos = samp ? PAST + (row - MP - qb_or_b * DS) : row;
    att::bf16x8 qr[8]; char* qrl = lds + (samp ? att::SI_QR + (wave & 3) * 4096 : 2 * 16384 + 2 * 24576 + 2048 + wave * 4096) + lane * 16; const bool qwr = !samp || wave < 4;
    { const bf16* qn = QRAW + (size_t)row * 3072 + h * 128 + hi * 8; const bf16* qrp = QRAW + (size_t)row * 3072 + D + h * 64 + hi * 8;
      const float* gn = ldp(ldsl, I_QN) + l * 128 + hi * 8; const float* gr = ldp(ldsl, I_QRN) + l * 64 + hi * 8;
      u32x4 rn[8]; float ss = 0.f;
#pragma unroll
      for (int d0 = 0; d0 < 8; ++d0) { rn[d0] = *(const u32x4*)(qn + d0 * 16);
#pragma unroll
          for (int q = 0; q < 4; ++q) { const float a = att::bflo(rn[d0][q]), bb = att::bfhi(rn[d0][q]); ss += a * a + bb * bb; } }
      ss = sum_x32(ss); const float rs_n = rsqrtf(ss * (1.0f / 128) + EPS) * (samp ? 1.0f : C);
#pragma unroll
      for (int d0 = 0; d0 < 8; ++d0) { const f32x4 g0 = *(const f32x4*)(gn + d0 * 16), g1 = *(const f32x4*)(gn + d0 * 16 + 4); u32x4 w;
          w.x = pk2(att::bflo(rn[d0].x) * rs_n * g0[0], att::bfhi(rn[d0].x) * rs_n * g0[1]); w.y = pk2(att::bflo(rn[d0].y) * rs_n * g0[2], att::bfhi(rn[d0].y) * rs_n * g0[3]);
          w.z = pk2(att::bflo(rn[d0].z) * rs_n * g1[0], att::bfhi(rn[d0].z) * rs_n * g1[1]); w.w = pk2(att::bflo(rn[d0].w) * rs_n * g1[2], att::bfhi(rn[d0].w) * rs_n * g1[3]);
          qr[d0] = *reinterpret_cast<att::bf16x8*>(&w); }
      u32x4 rr[4]; float sr = 0.f;
#pragma unroll
      for (int d = 0; d < 4; ++d) { rr[d] = *(const u32x4*)(qrp + d * 16);
#pragma unroll
          for (int q = 0; q < 4; ++q) { const float a = att::bflo(rr[d][q]), bb = att::bfhi(rr[d][q]); sr += a * a + bb * bb; } }
      sr = sum_x32(sr); const float rs_r = rsqrtf(sr * (1.0f / 64) + EPS) * (samp ? 1.0f : C);
#pragma unroll
      for (int d = 0; d < 2; ++d) { float x1[8], x2[8], y1[8], y2[8];
          const f32x4 ga0 = *(const f32x4*)(gr + d * 16), ga1 = *(const f32x4*)(gr + d * 16 + 4), gb0 = *(const f32x4*)(gr + 32 + d * 16), gb1 = *(const f32x4*)(gr + 32 + d * 16 + 4);
#pragma unroll
          for (int q = 0; q < 4; ++q) { x1[2 * q] = att::bflo(rr[d][q]) * rs_r * (q < 2 ? ga0[2 * q] : ga1[2 * q - 4]); x1[2 * q + 1] = att::bfhi(rr[d][q]) * rs_r * (q < 2 ? ga0[2 * q + 1] : ga1[2 * q - 3]);
                                        x2[2 * q] = att::bflo(rr[d + 2][q]) * rs_r * (q < 2 ? gb0[2 * q] : gb1[2 * q - 4]); x2[2 * q + 1] = att::bfhi(rr[d + 2][q]) * rs_r * (q < 2 ? gb0[2 * q + 1] : gb1[2 * q - 3]); }
          const f32x4* tp = (const f32x4*)(tab + (size_t)pos * 32 + d * 16 + hi * 8);
#pragma unroll
          for (int q = 0; q < 4; ++q) { const f32x4 cs = tp[q];
              y1[2 * q] = x1[2 * q] * cs[0] - x2[2 * q] * cs[1]; y2[2 * q] = x1[2 * q] * cs[1] + x2[2 * q] * cs[0];
              y1[2 * q + 1] = x1[2 * q + 1] * cs[2] - x2[2 * q + 1] * cs[3]; y2[2 * q + 1] = x1[2 * q + 1] * cs[3] + x2[2 * q + 1] * cs[2]; }
          u32x4 w1, w2; w1.x = pk2(y1[0], y1[1]); w1.y = pk2(y1[2], y1[3]); w1.z = pk2(y1[4], y1[5]); w1.w = pk2(y1[6], y1[7]);
          w2.x = pk2(y2[0], y2[1]); w2.y = pk2(y2[2], y2[3]); w2.z = pk2(y2[4], y2[5]); w2.w = pk2(y2[6], y2[7]);
          if (qwr) { *(u32x4*)(qrl + d * 1024) = w1; *(u32x4*)(qrl + (2 + d) * 1024) = w2; } }
    }
    att::f32x16 o[4] = {}; float l_reg;
    const size_t ob = (size_t)rowbase * D + h * 128;
    if (samp) {
        att::sample_item(qr, (const bf16*)(ws + WS_CKV) + ((size_t)MP + (size_t)qb_or_b * SKS) * KVL, (const bf16*)(ws + WS_KRS) + (size_t)qb_or_b * SKS * RD,
                         (const bf16*)(ws + WS_WKV) + (size_t)(h * 128) * KVL, (const bf16*)(ws + WS_WKV) + (size_t)(D + h * 128) * KVL, ldp(ldsl, I_KN) + l * 128, C, lds, o, l_reg, wv);
        attn_store(o, l_reg, GA + ob, MERGED + ob, wave < 2, li_l, (float*)(lds + wave * 8704), lane);
    } else {
        const bf16* Kn = (const bf16*)(ws + WS_KP) + h * 128; const bf16* Vh = (const bf16*)(ws + WS_VP) + h * 128; const bf16* Kr = (const bf16*)(ws + WS_KRP);
        const int NT = 4 * qb_or_b + 4, tlim = 4 * qb_or_b + (wave >> 1) + 1;
        att::attn_item_pp<192, D, D, true>(qr, Kn, Kr, Vh, NT, NT, tlim, C, lds, o, l_reg, wv, true);
        attn_store(o, l_reg, GA + ob, MERGED + ob, true, li_l, (float*)(lds + wave * 8704), lane);
    }
    __syncthreads();
}
__device__ __forceinline__ int q_pull(unsigned* head, volatile LAS int* slot) {
    if (threadIdx.x == 0) *slot = (int)__hip_atomic_fetch_add(head, 1u, __ATOMIC_RELAXED, __HIP_MEMORY_SCOPE_AGENT);
    __syncthreads();
    const int i = __builtin_amdgcn_readfirstlane(*slot);
    __syncthreads();
    return i;
}
__device__ __forceinline__ void phase_attn(int l, LAS unsigned char* ldsl, char* lds, const int wv) {
    unsigned* qbase = (unsigned*)(ldws(ldsl) + WS_CTL) + CW_QUEUE + (l * 2) * 8 * 64;
    volatile LAS int* slot = (volatile LAS int*)(ldsl + MISC_OFF + 64);
    const int x0 = (int)(xb_xcc_id() & 7u);
#pragma unroll 1
    for (int k = 0; k < 8; ++k) { const int x = (x0 + k) & 7;
#pragma unroll 1
        for (;;) { const int j = q_pull(qbase + x * 64, slot); if (j >= 128) break;
            const int qb = 63 - (j >> 1), h = 2 * x + (j & 1);
            main_attn_item(l, ldsl, lds, false, qb, h, wv);
            mem_attn_item(l, ldsl, lds, false, qb, h, wv); } }
}
__device__ __forceinline__ void phase_sattn(int l, LAS unsigned char* ldsl, char* lds, const int wv) {
    unsigned* qbase = (unsigned*)(ldws(ldsl) + WS_CTL) + CW_QUEUE + (l * 2 + 1) * 8 * 64;
    volatile LAS int* slot = (volatile LAS int*)(ldsl + MISC_OFF + 64); volatile LAS int* list = (volatile LAS int*)(ldsl + MISC_OFF + 80);
    const int x0 = (int)(xb_xcc_id() & 7u); int n = 0;
#pragma unroll 1
    for (int k = 0; k < 8 && n < 32; ++k) { const int x = (x0 + k) & 7;
#pragma unroll 1
        for (; n < 32;) { const int j = q_pull(qbase + x * 64, slot); if (j >= 32) break;
            const int it = x * 32 + j; if (threadIdx.x == 0) list[n] = it; ++n;
            main_attn_item(l, ldsl, lds, true, it >> 4, it & 15, wv); } }
    __syncthreads();
#pragma unroll 1
    for (int t = 0; t < n; ++t) { const int it = __builtin_amdgcn_readfirstlane(list[t]); mem_attn_item(l, ldsl, lds, true, it >> 4, it & 15, wv); }
}
#ifndef PHMASK
#define PHMASK 0xFFFFFFFFu
#endif
#define GEMM_PHASE(EpiT, E, Ap, Bp, Mr, Nc, Kd) do { pg8::Gemm g_{(const pg8::bf16_t*)(Ap), (const pg8::bf16_t*)(Bp), (Mr), (Nc), (Kd)}; pg8::StaticOrder S_; S_.init((Mr), (Nc), G, (int)blockIdx.x); \
        pg8::gemm_phase<EpiT, pg8::StaticOrder, true, true>(lds, g_, S_, E, wv); } while (0)
#define GEMM_PHASE_C(EpiT, E, Ap, Bp, Mr, Nc, Kd, cidx) do { pg8::Gemm g_{(const pg8::bf16_t*)(Ap), (const pg8::bf16_t*)(Bp), (Mr), (Nc), (Kd)}; pg8::StaticOrder S_; S_.init((Mr), (Nc), G, (cidx)); \
        pg8::gemm_phase<EpiT, pg8::StaticOrder, true, true>(lds, g_, S_, E, wv); } while (0)
#define SPLITK_PHASE(E, Ap, Bp, Mr, Nc, Kd) do { pg8::Gemm g_{(const pg8::bf16_t*)(Ap), (const pg8::bf16_t*)(Bp), (Mr), (Nc), (Kd)}; pg8::SplitKOrder S_; S_.init((Mr), (Nc), (Kd), 8, G, (int)blockIdx.x); \
        pg8::gemm_phase<pg8::EpiSlab, pg8::SplitKOrder, true, true>(lds, g_, S_, E, wv); } while (0)
template <int l> __device__ __forceinline__ void layer_program(LAS unsigned char* lds, unsigned char* lds_raw, const XcdBarrier& bar, const int lo, const int hi, const int G, const int wv) {
        const int pb = l * NPH;
#define WSP ldws(lds)
#define RP (ldout(lds) + O_Y)
#define IN(k) (((PHMASK >> (k)) & 1) && lo <= pb + (k) && pb + (k) < hi)
#ifdef DBG_STAMP
#define SEAM(k) do { if (pb + (k) + 1 < hi) xcd_barrier(bar); if (blockIdx.x == 0 && threadIdx.x == 0) ((LAS unsigned long long*)(lds + STAMP_OFF))[pb + (k) + 1] = __builtin_amdgcn_s_memrealtime(); } while (0)
#else
#define SEAM(k) do { if (pb + (k) + 1 < hi) xcd_barrier(bar); } while (0)
#endif
        if (l == 0 && IN(PH_PREP)) { phase_prep(0, lds, wv); SEAM(PH_PREP); }
        if (IN(PH_F1A)) { unsigned char* ws = WSP;
            pg8::EpiStoreF32 E2{(float*)(ws + WS_MKVRAW), 2560}; GEMM_PHASE_C(pg8::EpiStoreF32, E2, ws + WS_MB, ws + WS_WMK, NMEM, 2560, D, G - 1 - (int)blockIdx.x);
            pg8::EpiSwiGLU E{(bf16*)(ws + WS_ACT), (const float*)(ws + WS_RS)}; GEMM_PHASE(pg8::EpiSwiGLU, E, ws + WS_XB, ws + WS_W1A, M, 2 * DFF, D); SEAM(PH_F1A); }
        if (IN(PH_F1D)) { unsigned char* ws = WSP; typedef pg8::EpiResid<l == 0, false> ER; ER E{l == 0 ? ldp(lds, I_XP) : nullptr, l == 0 ? ldp(lds, I_XS) : nullptr, nullptr, (bf16*)(ws + WS_XB), (float*)(ws + WS_RS), 0.5f}; GEMM_PHASE(ER, E, ws + WS_ACT, ws + WS_W1D, MP, D, DFF);
            pg8::EpiSlab E2{(float*)(ws + WS_SLAB)}; SPLITK_PHASE(E2, (const bf16*)(ws + WS_ACT) + (size_t)MP * DFF, ws + WS_W1D, MS, D, DFF); SEAM(PH_F1D); }
        if (IN(PH_F1C)) { phase_combine<l == 0, false>(l == 0 ? ldp(lds, I_XS) : nullptr, 0.5f, lds, wv); SEAM(PH_F1C); }
        if (IN(PH_ING)) { unsigned char* ws = WSP; pg8::EpiInGate E{(float*)(ws + WS_INPROJ), (bf16*)(ws + WS_GA), (const float*)(ws + WS_RS), ldp(lds, I_BG) + (size_t)l * 3 * D};
            GEMM_PHASE(pg8::EpiInGate, E, ws + WS_XB, ws + WS_WIG, M, 8192, D); SEAM(PH_ING); }
        if (IN(PH_POST)) { phase_post(l, lds, wv); SEAM(PH_POST); }
        if (IN(PH_UQP)) { unsigned char* ws = WSP; pg8::EpiStore E{(bf16*)(ws + WS_QRAW), 3072}; GEMM_PHASE(pg8::EpiStore, E, ws + WS_CQ, ws + WS_WUQ, M, 3072, QL);
            pg8::EpiPool E2{(const bf16*)(ws + WS_GP), (bf16*)(ws + WS_MERGED), ldp(lds, I_POOLS) + (size_t)l * D}; GEMM_PHASE_C(pg8::EpiPool, E2, ws + WS_POOLED, ws + WS_WPL, M, D, PWD, G - 1 - (int)blockIdx.x); SEAM(PH_UQP); }
        if (IN(PH_KV0)) { unsigned char* ws = WSP; pg8::EpiKV E{(bf16*)(ws + WS_KP), (bf16*)(ws + WS_VP), (bf16*)(ws + WS_KP), (bf16*)(ws + WS_VP), MP, ldp(lds, I_KN) + l * 128, (LAS float*)(lds + LDSX_OFF)};
            GEMM_PHASE(pg8::EpiKV, E, ws + WS_CKV, ws + WS_WKV, MP, 4096, KVL); SEAM(PH_KV0); }
        if (IN(PH_ATT0)) { phase_sattn(l, lds, (char*)lds_raw, wv); phase_attn(l, lds, (char*)lds_raw, wv); SEAM(PH_ATT0); }
        if (IN(PH_WO)) { unsigned char* ws = WSP; typedef pg8::EpiResid<false, false> ER; ER E{nullptr, nullptr, nullptr, (bf16*)(ws + WS_XB), (float*)(ws + WS_RS), 1.0f}; GEMM_PHASE(ER, E, ws + WS_MERGED, ws + WS_WO, MP, D, D);
            pg8::EpiSlab E2{(float*)(ws + WS_SLAB)}; SPLITK_PHASE(E2, (const bf16*)(ws + WS_MERGED) + (size_t)MP * D, ws + WS_WO, MS, D, D); SEAM(PH_WO); }
        if (IN(PH_WOC)) { phase_combine<false, false>(nullptr, 1.0f, lds, wv); SEAM(PH_WOC); }
        if (IN(PH_F2A)) { unsigned char* ws = WSP; pg8::EpiSwiGLU E{(bf16*)(ws + WS_ACT), (const float*)(ws + WS_RS)}; GEMM_PHASE(pg8::EpiSwiGLU, E, ws + WS_XB, ws + WS_W2A, M, 2 * DFF, D); SEAM(PH_F2A); }
        if (IN(PH_F2D)) { unsigned char* ws = WSP; typedef pg8::EpiResid<false, l == DEPTH - 1> ER; ER E{nullptr, nullptr, l == DEPTH - 1 ? RP : nullptr, (bf16*)(ws + WS_XB), (float*)(ws + WS_RS), 0.5f}; GEMM_PHASE(ER, E, ws + WS_ACT, ws + WS_W2D, MP, D, DFF);
            pg8::EpiSlab E2{(float*)(ws + WS_SLAB)}; SPLITK_PHASE(E2, (const bf16*)(ws + WS_ACT) + (size_t)MP * DFF, ws + WS_W2D, MS, D, DFF); SEAM(PH_F2D); }
        if (IN(PH_F2C)) { phase_combine<false, l == DEPTH - 1>(nullptr, 0.5f, lds, wv); if (l == 0) phase_prep(1, lds, wv); SEAM(PH_F2C); }
#undef IN
#undef SEAM
#undef WSP
#undef RP
}
__global__ void __launch_bounds__(512, 2) mega_fwd(Params p) {
    extern __shared__ __attribute__((aligned(16))) unsigned char lds_raw[];
    LAS unsigned char* lds = (LAS unsigned char*)lds_raw;
    const int tid = threadIdx.x, wv = __builtin_amdgcn_readfirstlane(tid >> 6);
    const int G = gridDim.x;
    volatile LAS unsigned* MISC = (volatile LAS unsigned*)(lds + MISC_OFF);
    if (tid < 64) MISC[tid] = 0u;
    if (tid == 64) { LAS unsigned long long* t = (LAS unsigned long long*)(lds + PT_OFF);
#pragma unroll
        for (int i = 0; i < N_IN; ++i) t[i] = (unsigned long long)p.in[i];
        t[PT_OUT] = (unsigned long long)p.out; t[PT_WS] = (unsigned long long)p.ws;
        LAS double* iv = (LAS double*)(lds + PT_INV);
#pragma unroll
        for (int i = 0; i < 32; ++i) iv[i] = p.inv[i]; }
    __syncthreads();
    XcdBarrier bar = xcd_barrier_post((unsigned*)(p.ws + WS_CTL) + CW_BAR + p.li * XCD_BAR_WORDS, MISC + 8);
    const int lo = p.ph_lo, hi = p.ph_hi;
#ifdef DBG_STAMP
    if (blockIdx.x == 0 && threadIdx.x == 0) ((LAS unsigned long long*)(lds + STAMP_OFF))[0] = __builtin_amdgcn_s_memrealtime();
#endif
    layer_program<0>(lds, lds_raw, bar, lo, hi, G, wv);
    layer_program<1>(lds, lds_raw, bar, lo, hi, G, wv);
#ifdef DBG_STAMP
    if (blockIdx.x == 0 && threadIdx.x == 0) { const LAS unsigned long long* st = (const LAS unsigned long long*)(lds + STAMP_OFF);
        p.out[O_Y] += (float)(st[DBG_STAMP_L * NPH + (DBG_STAMP_B)] - st[DBG_STAMP_L * NPH + (DBG_STAMP_A)]) * (0.01f / 100.0f); }
#endif
}


#ifdef DBG_COPY_OFF
__global__ void dbg_copy(const unsigned char* ws, unsigned char* out, size_t bytes) { for (size_t i = ((size_t)blockIdx.x * 256 + threadIdx.x) * 16; i < bytes; i += (size_t)gridDim.x * 256 * 16) *(uint4*)(out + i) = *(const uint4*)(ws + i); }
#endif
#ifndef MK_N_LAUNCHES
#define MK_N_LAUNCHES 1
#endif
extern "C" void kernel_launch(void* const* d_in, const int* in_sizes, int n_in, void* d_out, int out_size, void* d_ws, size_t ws_size, hipStream_t stream) {
    static int grid = 0;
    if (grid == 0) {
        if (n_in != N_IN || (size_t)out_size != O_END || ws_size < WS_END) { fprintf(stderr, "kernel_launch: built for %d inputs, %zu outputs, >= %zu bytes of workspace; got %d, %d, %zu; nothing launched\n", (int)N_IN, (size_t)O_END, (size_t)WS_END, n_in, out_size, ws_size); grid = -1; return; }
        int dev = 0, cus = 0, per_cu = 0;
        if (hipGetDevice(&dev) != hipSuccess || hipDeviceGetAttribute(&cus, hipDeviceAttributeMultiprocessorCount, dev) != hipSuccess) { fprintf(stderr, "kernel_launch: device query failed\n"); grid = -1; return; }
        if (hipFuncSetAttribute((const void*)mega_fwd, hipFuncAttributeMaxDynamicSharedMemorySize, LDS_BYTES) != hipSuccess) { fprintf(stderr, "kernel_launch: hipFuncSetAttribute failed\n"); grid = -1; return; }
        if (hipOccupancyMaxActiveBlocksPerMultiprocessor(&per_cu, (const void*)mega_fwd, 512, LDS_BYTES) != hipSuccess || per_cu < 1) fprintf(stderr, "kernel_launch: note: occupancy query reports %d workgroups per CU\n", per_cu);
        (void)hipGetLastError();
        grid = cus;
    }
    if (grid < 0) return;
#ifdef DBG_MEMSET_ALL
    (void)hipMemsetAsync((char*)d_ws, 0, WS_END, stream);
#endif
    if (hipMemsetAsync((char*)d_ws + WS_CTL, 0, MK_N_LAUNCHES == 1 ? (size_t)(CW_BAR + XCD_BAR_WORDS) * 4 : (size_t)CTL_BYTES  , stream) != hipSuccess) { fprintf(stderr, "kernel_launch: memset failed\n"); return; }
    Params p{};
    for (int i = 0; i < N_IN; ++i) p.in[i] = (const float*)d_in[i];
    p.out = (float*)d_out; p.ws = (unsigned char*)d_ws;
    for (int i = 0; i < 32; ++i) p.inv[i] = std::pow(10000.0, -(double)i / 32.0);
    p.pad = 0;
#ifdef DBG_NPH
    const int total = DBG_NPH;
#else
    const int total = DEPTH * NPH;
#endif
#if MK_N_LAUNCHES == 1
    p.ph_lo = 0; p.ph_hi = total; p.li = 0;
    hipLaunchKernelGGL(mega_fwd, dim3(grid), dim3(512), LDS_BYTES, stream, p);
#else
#ifdef DBG_PHLIST
    { const int lst[] = DBG_PHLIST; for (int k : lst) { p.ph_lo = k; p.ph_hi = k + 1; p.li = 0; hipLaunchKernelGGL(mega_fwd, dim3(grid), dim3(512), LDS_BYTES, stream, p); } (void)total; }
#else
    for (int k = 0; k < total; ++k) { p.ph_lo = k; p.ph_hi = k + 1; p.li = 0; hipLaunchKernelGGL(mega_fwd, dim3(grid), dim3(512), LDS_BYTES, stream, p); }
#endif
#endif
#ifdef DBG_COPY_OFF
    hipLaunchKernelGGL(dbg_copy, dim3(2048), dim3(256), 0, stream, (const unsigned char*)d_ws + (DBG_COPY_OFF), (unsigned char*)d_out, (size_t)(DBG_COPY_BYTES));
#endif
    const hipError_t le = hipPeekAtLastError();
    if (le != hipSuccess) fprintf(stderr, "kernel_launch: launch failed: %s\n", hipGetErrorName(le));
}
```

```cpp
#include <hip/hip_runtime.h>
#include <cstdio>
#include <cstdint>
#include <cmath>

constexpr int D = 2048, DFF = 5632, MP = 16384, MS = 1024, M = MP + MS, DEPTH = 2;
constexpr int NH = 16, HD = 128, RD = 64, QL = 512, KVL = 256, PWD = 512, MQD = 512, INW = 1856;
constexpr int NMEM = 256, MH = 4, MVD = 512;
constexpr int PAST = 4096, DB = 16, DS = 64, SKS = PAST + DS;
constexpr int SALL = MP + DB * SKS;
constexpr int PPAD = 15;
constexpr float EPS = 1e-6f;
#define LOG2E 1.4426950408889634f

__device__ __forceinline__ int lane_id_fresh() { int x; asm volatile("v_mbcnt_lo_u32_b32 %0, -1, 0\n\tv_mbcnt_hi_u32_b32 %0, -1, %0" : "=v"(x)); return x; }
__device__ __forceinline__ const char* uni64(const char* p) { const unsigned long long v = (unsigned long long)p; const unsigned lo = __builtin_amdgcn_readfirstlane((unsigned)v), hi = __builtin_amdgcn_readfirstlane((unsigned)(v >> 32));
    return (const char*)(const __attribute__((address_space(1))) char*)(((unsigned long long)hi << 32) | (unsigned long long)lo); }
namespace pg8 {
#define PG8_LAS __attribute__((address_space(3)))
typedef unsigned short bf16_t;
typedef short bf16x8 __attribute__((ext_vector_type(8)));
typedef float f32x4 __attribute__((ext_vector_type(4)));
typedef unsigned u32x4 __attribute__((ext_vector_type(4)));
constexpr int BM = 256, BK = 64, HALF = 128, HTB = HALF * BK * 2  , STAGE_BYTES = 8 * HTB, NXCD = 8, WGM = 8;

__host__ __device__ __forceinline__ int lds_byte(int r, int c) { const int st = (r >> 4) * 2 + (c >> 5), rr = r & 15, cc = c & 31, ob = rr * 64 + cc * 2; return st * 1024 + (ob ^ (((ob >> 9) & 1) << 5)); }
__host__ __device__ __forceinline__ void stage_rc(int b, int& R, int& C) { const int st = b / 1024, sb = b % 1024, swz = sb ^ (((sb >> 9) & 1) << 5); R = (st >> 1) * 16 + swz / 64; C = (st & 1) * 32 + (swz % 64) / 2; }
__host__ __device__ __forceinline__ int perm32(int rho) { const int n = rho >> 4, i = rho & 15; return 8 * (i >> 2) + 4 * n + (i & 3); }

struct Unit { int pm, pn, kt0, nkt, kc; };
struct Gemm { const bf16_t* A; const bf16_t* Bt; int M, N, K; };

struct StaticOrder {
    static constexpr bool KSPLIT = false;
    int nM, nN, nwg, G, c;
    __host__ __device__ void init(int M, int N, int G_, int c_) { nM = M / BM; nN = N / BM; nwg = nM * nN; G = G_; c = c_; }
    __device__ bool next(int i, Unit& u) const {
        const long L = (long)i * G + c; if (L >= nwg) return false;
        int wgid = (int)L; { const int q = nwg / NXCD, r = nwg % NXCD, xcd = wgid % NXCD, off = wgid / NXCD; wgid = (xcd < r ? xcd * (q + 1) : r * (q + 1) + (xcd - r) * q) + off; }
        const int nig = WGM * nN, gid = wgid / nig, fm = gid * WGM, gsz = (nM - fm) < WGM ? (nM - fm) : WGM;
        u.pm = __builtin_amdgcn_readfirstlane(fm + ((wgid % nig) % gsz)); u.pn = __builtin_amdgcn_readfirstlane((wgid % nig) / gsz); return true;
    }
    __device__ __forceinline__ void a_ready(const Unit&) const {}
    __device__ __forceinline__ void done(const Unit&) const {}
};

struct SplitKOrder {
    static constexpr bool KSPLIT = true;
    int nM, nN, S, T, G, c;
    __device__ void init(int M, int N, int K, int S_, int G_, int c_) { nM = M / BM; nN = N / BM; S = S_; T = K / BK; G = G_; c = c_; }
    __device__ bool next(int i, Unit& u) const {
        const int L = i * G + c; if (L >= nM * nN * S) return false;
        const int kc = L % S, tile = L / S, s0 = 2 * ((kc * T) / (2 * S)), s1 = 2 * (((kc + 1) * T) / (2 * S));
        u.pm = __builtin_amdgcn_readfirstlane(tile % nM); u.pn = __builtin_amdgcn_readfirstlane(tile / nM); u.kt0 = __builtin_amdgcn_readfirstlane(s0); u.nkt = __builtin_amdgcn_readfirstlane(s1 - s0); u.kc = __builtin_amdgcn_readfirstlane(kc); return true;
    }
    __device__ __forceinline__ void a_ready(const Unit&) const {}
    __device__ __forceinline__ void done(const Unit&) const {}
};
typedef float f32x2_t __attribute__((ext_vector_type(2)));
typedef __bf16 bf16x2_t __attribute__((ext_vector_type(2)));
__device__ __forceinline__ unsigned cvt_pk_bf16(float lo, float hi) { const f32x2_t v = {lo, hi}; const bf16x2_t r = __builtin_convertvector(v, bf16x2_t); return __builtin_bit_cast(unsigned, r); }
__device__ __forceinline__ u32x4 pack8(const f32x4 a, const f32x4 b) { u32x4 w; w.x = cvt_pk_bf16(a[0], a[1]); w.y = cvt_pk_bf16(a[2], a[3]); w.z = cvt_pk_bf16(b[0], b[1]); w.w = cvt_pk_bf16(b[2], b[3]); return w; }
__device__ __forceinline__ float bf_lo(unsigned w) { return __uint_as_float(w << 16); }
__device__ __forceinline__ float bf_hi(unsigned w) { return __uint_as_float(w & 0xffff0000u); }
__device__ __forceinline__ float dot4(const f32x4 a) { return (a[0] * a[0] + a[1] * a[1]) + (a[2] * a[2] + a[3] * a[3]); }
__device__ __forceinline__ float xsum_fq(float v) {
    { const auto a = __builtin_amdgcn_permlane16_swap(__float_as_uint(v), __float_as_uint(v), false, false); v = __uint_as_float(a[0]) + __uint_as_float(a[1]); }
    { const auto b = __builtin_amdgcn_permlane32_swap(__float_as_uint(v), __float_as_uint(v), false, false); v = __uint_as_float(b[0]) + __uint_as_float(b[1]); }
    return v;
}
__device__ __forceinline__ float row_rstd(const float* rs, int row, int fq) {
    const f32x4* p = (const f32x4*)(rs + (size_t)row * 32 + fq * 8); const f32x4 a = p[0], b = p[1];
    float s = ((a[0] + a[1]) + (a[2] + a[3])) + ((b[0] + b[1]) + (b[2] + b[3]));
    s = xsum_fq(s);
    return rsqrtf(s * (1.0f / D) + EPS);
}
__device__ __forceinline__ float silu_f(float g) { return g * __builtin_amdgcn_rcpf(1.0f + __builtin_amdgcn_exp2f(-LOG2E * g)); }
__device__ __forceinline__ float sigm_f(float g) { return __builtin_amdgcn_rcpf(1.0f + __builtin_amdgcn_exp2f(-LOG2E * g)); }

struct EpiSwiGLU { static constexpr bool PERM = true, AFTER_DRAIN = false;
    bf16_t* act; const float* rs;
    __device__ __forceinline__ void operator()(const f32x4 (&acc)[2][2][4][2], const Unit& u, int wr, int wc, int fr, int fq) const {
        { int ln_ = lane_id_fresh(); asm volatile("" : "+v"(ln_)); fr = ln_ & 15; fq = ln_ >> 4; }
        const int row0 = u.pm * BM + wr * 64 + fr, col0 = u.pn * HALF + wc * 32 + 8 * fq;
#pragma unroll
        for (int ai = 0; ai < 2; ++ai)
#pragma unroll
            for (int m = 0; m < 4; ++m) { const int row = row0 + ai * HALF + m * 16; const float r = row_rstd(rs, row, fq);
                f32x4 y[2];
#pragma unroll
                for (int n = 0; n < 2; ++n) { const f32x4 g = acc[ai][0][m][n] * r, uu = acc[ai][1][m][n] * r;
#pragma unroll
                    for (int j = 0; j < 4; ++j) y[n][j] = silu_f(g[j]) * uu[j]; }
                *(u32x4*)(act + (size_t)row * DFF + col0) = pack8(y[0], y[1]); }
    }
};
template <bool F32SRC, bool F32OUT> struct EpiResid { static constexpr bool PERM = true, AFTER_DRAIN = false;
    const float* res_lo; const float* res_hi; float* Rout; bf16_t* xb; float* rs; float alpha;
    __device__ __forceinline__ void operator()(const f32x4 (&acc)[2][2][4][2], const Unit& u, int wr, int wc, int fr, int fq) const {
        { int ln_ = lane_id_fresh(); asm volatile("" : "+v"(ln_)); fr = ln_ & 15; fq = ln_ >> 4; }
        const int row0 = u.pm * BM + wr * 64 + fr, col0 = u.pn * BM + wc * 32 + 8 * fq;
        const float* src = (u.pm < MP / BM) ? res_lo : (res_hi - (size_t)MP * D);
#pragma unroll
        for (int ai = 0; ai < 2; ++ai) {
            f32x4 x[4][2][2];
#pragma unroll
            for (int m = 0; m < 4; ++m)
#pragma unroll
                for (int bj = 0; bj < 2; ++bj) { const size_t off = (size_t)(row0 + ai * HALF + m * 16) * D + col0 + bj * HALF;
                    if constexpr (F32SRC) { x[m][bj][0] = *(const f32x4*)(src + off); x[m][bj][1] = *(const f32x4*)(src + off + 4); }
                    else { const u32x4 w = *(const u32x4*)(xb + off); x[m][bj][0] = (f32x4){bf_lo(w.x), bf_hi(w.x), bf_lo(w.y), bf_hi(w.y)}; x[m][bj][1] = (f32x4){bf_lo(w.z), bf_hi(w.z), bf_lo(w.w), bf_hi(w.w)}; } }
            asm volatile("" ::: "memory");
#pragma unroll
            for (int m = 0; m < 4; ++m) { const int row = row0 + ai * HALF + m * 16; const size_t off = (size_t)row * D + col0; float ss = 0.f;
#pragma unroll
                for (int bj = 0; bj < 2; ++bj) {
                    const f32x4 o0 = x[m][bj][0] + acc[ai][bj][m][0] * alpha, o1 = x[m][bj][1] + acc[ai][bj][m][1] * alpha;
                    if constexpr (F32OUT) { *(f32x4*)(Rout + off + bj * HALF) = o0; *(f32x4*)(Rout + off + bj * HALF + 4) = o1; }
                    *(u32x4*)(xb + off + bj * HALF) = pack8(o0, o1); ss += dot4(o0) + dot4(o1); }
                ss = xsum_fq(ss);
                if (fq == 0) rs[(size_t)row * 32 + u.pn * 4 + wc] = ss; }
            asm volatile("" ::: "memory");
        }
    }
};
struct EpiInGate { static constexpr bool PERM = true, AFTER_DRAIN = false;
    float* inproj; bf16_t* gates; const float* rs; const float* bgate;
    __device__ __forceinline__ void operator()(const f32x4 (&acc)[2][2][4][2], const Unit& u, int wr, int wc, int fr, int fq) const {
        { int ln_ = lane_id_fresh(); asm volatile("" : "+v"(ln_)); fr = ln_ & 15; fq = ln_ >> 4; }
        const int row0 = u.pm * BM + wr * 64 + fr;
        if (u.pn < 8) { const int col0 = u.pn * BM + wc * 32 + 8 * fq;
#pragma unroll
            for (int ai = 0; ai < 2; ++ai)
#pragma unroll
                for (int m = 0; m < 4; ++m) { const int row = row0 + ai * HALF + m * 16; const float r = row_rstd(rs, row, fq); float* o = inproj + (size_t)row * D + col0;
#pragma unroll
                    for (int bj = 0; bj < 2; ++bj) { *(f32x4*)(o + bj * HALF) = acc[ai][bj][m][0] * r; *(f32x4*)(o + bj * HALF + 4) = acc[ai][bj][m][1] * r; } }
        } else { const int t = u.pn - 8, j = t >> 3, col0 = (t & 7) * BM + wc * 32 + 8 * fq; bf16_t* G = gates + (size_t)j * M * D;
            f32x4 bv[2][2];
#pragma unroll
            for (int bj = 0; bj < 2; ++bj)
#pragma unroll
                for (int n = 0; n < 2; ++n) bv[bj][n] = *(const f32x4*)(bgate + j * D + col0 + bj * HALF + 4 * n);
#pragma unroll
            for (int ai = 0; ai < 2; ++ai)
#pragma unroll
                for (int m = 0; m < 4; ++m) { const int row = row0 + ai * HALF + m * 16; const float r = row_rstd(rs, row, fq);
#pragma unroll
                    for (int bj = 0; bj < 2; ++bj) { f32x4 v0 = acc[ai][bj][m][0] * r + bv[bj][0], v1 = acc[ai][bj][m][1] * r + bv[bj][1];
#ifndef DBG_NOSIG
#pragma unroll
                        for (int q = 0; q < 4; ++q) { v0[q] = sigm_f(v0[q]); v1[q] = sigm_f(v1[q]); }
#endif

                        *(u32x4*)(G + (size_t)row * D + col0 + bj * HALF) = pack8(v0, v1); } }
        }
    }
};
struct EpiPool { static constexpr bool PERM = true, AFTER_DRAIN = false;
    const bf16_t* gp; bf16_t* merged; const float* pscale;
    __device__ __forceinline__ void operator()(const f32x4 (&acc)[2][2][4][2], const Unit& u, int wr, int wc, int fr, int fq) const {
        { int ln_ = lane_id_fresh(); asm volatile("" : "+v"(ln_)); fr = ln_ & 15; fq = ln_ >> 4; }
        const int row0 = u.pm * BM + wr * 64 + fr, col0 = u.pn * BM + wc * 32 + 8 * fq;
        f32x4 ps[2][2];
#pragma unroll
        for (int bj = 0; bj < 2; ++bj)
#pragma unroll
            for (int n = 0; n < 2; ++n) ps[bj][n] = *(const f32x4*)(pscale + col0 + bj * HALF + 4 * n);
#pragma unroll
        for (int ai = 0; ai < 2; ++ai)
#pragma unroll
            for (int m = 0; m < 4; ++m) { const size_t off = (size_t)(row0 + ai * HALF + m * 16) * D + col0;
#pragma unroll
                for (int bj = 0; bj < 2; ++bj) { const u32x4 g = *(const u32x4*)(gp + off + bj * HALF);
                    f32x4 g0 = {bf_lo(g.x), bf_hi(g.x), bf_lo(g.y), bf_hi(g.y)}, g1 = {bf_lo(g.z), bf_hi(g.z), bf_lo(g.w), bf_hi(g.w)};
#ifdef DBG_NOGATE
                    g0 = (f32x4){1.f, 1.f, 1.f, 1.f}; g1 = g0;
#endif
                    *(u32x4*)(merged + off + bj * HALF) = pack8(acc[ai][bj][m][0] * ps[bj][0] * g0, acc[ai][bj][m][1] * ps[bj][1] * g1); } }
    }
};
struct EpiStore { static constexpr bool PERM = true, AFTER_DRAIN = false;
    bf16_t* O; int ldc;
    __device__ __forceinline__ void operator()(const f32x4 (&acc)[2][2][4][2], const Unit& u, int wr, int wc, int fr, int fq) const {
        { int ln_ = lane_id_fresh(); asm volatile("" : "+v"(ln_)); fr = ln_ & 15; fq = ln_ >> 4; }
        const int row0 = u.pm * BM + wr * 64 + fr, col0 = u.pn * BM + wc * 32 + 8 * fq;
#pragma unroll
        for (int ai = 0; ai < 2; ++ai)
#pragma unroll
            for (int m = 0; m < 4; ++m) { bf16_t* o = O + (size_t)(row0 + ai * HALF + m * 16) * ldc + col0;
#pragma unroll
                for (int bj = 0; bj < 2; ++bj) *(u32x4*)(o + bj * HALF) = pack8(acc[ai][bj][m][0], acc[ai][bj][m][1]); }
    }
};
struct EpiStoreF32 { static constexpr bool PERM = true, AFTER_DRAIN = false;
    float* O; int ldc;
    __device__ __forceinline__ void operator()(const f32x4 (&acc)[2][2][4][2], const Unit& u, int wr, int wc, int fr, int fq) const {
        { int ln_ = lane_id_fresh(); asm volatile("" : "+v"(ln_)); fr = ln_ & 15; fq = ln_ >> 4; }
        const int row0 = u.pm * BM + wr * 64 + fr, col0 = u.pn * BM + wc * 32 + 8 * fq;
#pragma unroll
        for (int ai = 0; ai < 2; ++ai)
#pragma unroll
            for (int m = 0; m < 4; ++m) { float* o = O + (size_t)(row0 + ai * HALF + m * 16) * ldc + col0;
#pragma unroll
                for (int bj = 0; bj < 2; ++bj) { *(f32x4*)(o + bj * HALF) = acc[ai][bj][m][0]; *(f32x4*)(o + bj * HALF + 4) = acc[ai][bj][m][1]; } }
    }
};
struct EpiSlab { static constexpr bool PERM = true, AFTER_DRAIN = false;
    float* slab;
    __device__ __forceinline__ void operator()(const f32x4 (&acc)[2][2][4][2], const Unit& u, int wr, int wc, int fr, int fq) const {
        { int ln_ = lane_id_fresh(); asm volatile("" : "+v"(ln_)); fr = ln_ & 15; fq = ln_ >> 4; }
        const int row0 = u.pm * BM + wr * 64 + fr, col0 = u.pn * BM + wc * 32 + 8 * fq; float* base = slab + (size_t)u.kc * MS * D;
#pragma unroll
        for (int ai = 0; ai < 2; ++ai)
#pragma unroll
            for (int m = 0; m < 4; ++m) { float* o = base + (size_t)(row0 + ai * HALF + m * 16) * D + col0;
#pragma unroll
                for (int bj = 0; bj < 2; ++bj) { *(f32x4*)(o + bj * HALF) = acc[ai][bj][m][0]; *(f32x4*)(o + bj * HALF + 4) = acc[ai][bj][m][1]; } }
    }
};
struct EpiKV { static constexpr bool PERM = true, AFTER_DRAIN = false;
    bf16_t *K0, *V0, *K1, *V1; int split; const float* knorm; PG8_LAS float* P;
    __device__ __forceinline__ void operator()(const f32x4 (&acc)[2][2][4][2], const Unit& u, int wr, int wc, int fr, int fq) const {
        { int ln_ = lane_id_fresh(); asm volatile("" : "+v"(ln_)); fr = ln_ & 15; fq = ln_ >> 4; }
        const int grow = u.pm * BM; const bool second = grow >= split; const int orow0 = (second ? grow - split : grow) + wr * 64 + fr;
        bf16_t* Kd = second ? K1 : K0; bf16_t* Vd = second ? V1 : V0;
        if (u.pn >= 8) { const int col0 = (u.pn - 8) * BM + wc * 32 + 8 * fq;
#pragma unroll
            for (int ai = 0; ai < 2; ++ai)
#pragma unroll
                for (int m = 0; m < 4; ++m) { bf16_t* o = Vd + (size_t)(orow0 + ai * HALF + m * 16) * D + col0;
#pragma unroll
                    for (int bj = 0; bj < 2; ++bj) *(u32x4*)(o + bj * HALF) = pack8(acc[ai][bj][m][0], acc[ai][bj][m][1]); }
        } else { const int col0 = u.pn * BM + wc * 32 + 8 * fq, rt0 = wr * 64 + fr;
#pragma unroll
            for (int ai = 0; ai < 2; ++ai)
#pragma unroll
                for (int m = 0; m < 4; ++m)
#pragma unroll
                    for (int bj = 0; bj < 2; ++bj) { float ss = dot4(acc[ai][bj][m][0]) + dot4(acc[ai][bj][m][1]); ss = xsum_fq(ss);
                        if (fq == 0) P[((rt0 + ai * HALF + m * 16) * 2 + bj) * 4 + wc] = ss; __builtin_amdgcn_sched_barrier(0); }
            asm volatile("s_waitcnt lgkmcnt(0)" ::: "memory"); __builtin_amdgcn_s_barrier(); asm volatile("" ::: "memory");
            const f32x4 g0 = *(const f32x4*)(knorm + wc * 32 + 8 * fq), g1 = *(const f32x4*)(knorm + wc * 32 + 8 * fq + 4);
#pragma unroll
            for (int ai = 0; ai < 2; ++ai)
#pragma unroll
                for (int m = 0; m < 4; ++m) { bf16_t* o = Kd + (size_t)(orow0 + ai * HALF + m * 16) * D + col0;
#pragma unroll
                    for (int bj = 0; bj < 2; ++bj) { const f32x4 p4 = *(const PG8_LAS f32x4*)(P + ((rt0 + ai * HALF + m * 16) * 2 + bj) * 4);
                        const float r = rsqrtf(((p4[0] + p4[1]) + (p4[2] + p4[3])) * (1.0f / HD) + EPS);
                        *(u32x4*)(o + bj * HALF) = pack8(acc[ai][bj][m][0] * r * g0, acc[ai][bj][m][1] * r * g1); }
                    asm volatile("" ::: "memory"); __builtin_amdgcn_sched_barrier(0); }
        }
    }
};

template <class Epi, class Sched, bool ALIGN_EPI = false, bool SP2 = false>
__device__ __forceinline__ void gemm_phase(PG8_LAS unsigned char* lds, const Gemm g, const Sched& S, const Epi& E, const int wv  ) {
    int tid_ = wv * 64 + lane_id_fresh(); asm volatile("" : "+v"(tid_));
    const int tid = tid_, wid = __builtin_amdgcn_readfirstlane(tid >> 6), lane = tid & 63, wr = wid >> 2, wc = wid & 3, fr = lane & 15, fq = lane >> 4;
    const int K = g.K; int nt = K / BK;
    unsigned voffA[2], voffB[2];
#pragma unroll
    for (int i = 0; i < 2; ++i) { int R, C; stage_rc(tid * 16 + i * 8192, R, C); const int Rb = Epi::PERM ? ((R & ~31) + perm32(R & 31)) : R;
        voffA[i] = (unsigned)(R * K + C) * 2u; voffB[i] = (unsigned)(Rb * K + C) * 2u; }
    const size_t kstep = (size_t)(BK * 2);
    const size_t hstep = (size_t)HALF * K * 2;
    const size_t tstep = 2 * hstep;
    const unsigned ldsw = (unsigned)wid * 1024u;
    const int aoff = lds_byte(wr * 64 + fr, fq * 8), boff = lds_byte(wc * 32 + fr, fq * 8);
#define PG8_SA(b, h) (((b) * 2 + (h)) * HTB)
#define PG8_SB(b, h) ((4 + (b) * 2 + (h)) * HTB)
#define PG8_STAGE(bufoff, gbase, voff) do { const char* gb_ = uni64((const char*)(gbase)); _Pragma("unroll") for (int _i = 0; _i < 2; ++_i) \
        __builtin_amdgcn_global_load_lds((const unsigned*)(gb_ + (voff)[_i]), (PG8_LAS unsigned*)(lds + (bufoff) + ldsw + _i * 8192), 16, 0, 0); } while (0)
#define PG8_LDA(dst, b, h) do { _Pragma("unroll") for (int m = 0; m < 4; ++m) _Pragma("unroll") for (int k = 0; k < 2; ++k) dst[m][k] = *(const PG8_LAS bf16x8*)(lds + PG8_SA(b, h) + aoff + m * 2048 + k * 1024); } while (0)
#define PG8_LDB(dst, b, h) do { _Pragma("unroll") for (int n = 0; n < 2; ++n) _Pragma("unroll") for (int k = 0; k < 2; ++k) dst[n][k] = *(const PG8_LAS bf16x8*)(lds + PG8_SB(b, h) + boff + n * 2048 + k * 1024); } while (0)
#define PG8_MMA(ai, bj, At, Bt) do { __builtin_amdgcn_s_setprio(1); _Pragma("unroll") for (int m = 0; m < 4; ++m) _Pragma("unroll") for (int n = 0; n < 2; ++n) _Pragma("unroll") for (int k = 0; k < 2; ++k) \
        acc[ai][bj][m][n] = __builtin_amdgcn_mfma_f32_16x16x32_bf16(Bt[n][k], At[m][k], acc[ai][bj][m][n], 0, 0, 0); __builtin_amdgcn_s_setprio(0); } while (0)
#define PG8_WAIT_V(n) asm volatile("s_waitcnt vmcnt(" #n ")" ::: "memory")
#define PG8_WAIT_L(n) asm volatile("s_waitcnt lgkmcnt(" #n ")" ::: "memory")
#define PG8_BAR __builtin_amdgcn_s_barrier()
#define PG8_SCHED __builtin_amdgcn_sched_barrier(0)
    Unit cur, nxt; int ui = 0;
    if (!S.next(0, cur)) return;
    f32x4 acc[2][2][4][2];
#pragma unroll
    for (int a = 0; a < 2; ++a)
#pragma unroll
        for (int b = 0; b < 2; ++b)
#pragma unroll
            for (int m = 0; m < 4; ++m)
#pragma unroll
                for (int n = 0; n < 2; ++n) acc[a][b][m][n] = (f32x4){0.f, 0.f, 0.f, 0.f};
    bf16x8 At[4][2], B0[2][2], B1[2][2];
    const char* cA = (const char*)g.A + (size_t)cur.pm * tstep; const char* cB = (const char*)g.Bt + (size_t)cur.pn * tstep;
    if constexpr (Sched::KSPLIT) { cA += (size_t)cur.kt0 * kstep; cB += (size_t)cur.kt0 * kstep; nt = cur.nkt; }
    S.a_ready(cur);
    if constexpr (SP2) {
        PG8_STAGE(PG8_SB(0, 0), cB, voffB); PG8_STAGE(PG8_SB(0, 1), cB + hstep, voffB); PG8_STAGE(PG8_SA(0, 0), cA, voffA); PG8_STAGE(PG8_SA(0, 1), cA + hstep, voffA);
        if (wr == 1) PG8_BAR;
        PG8_WAIT_V(2); PG8_BAR;
        PG8_STAGE(PG8_SB(1, 0), cB + kstep, voffB); PG8_STAGE(PG8_SA(1, 0), cA + kstep, voffA); PG8_STAGE(PG8_SB(1, 1), cB + hstep + kstep, voffB);
        PG8_WAIT_V(6); PG8_BAR;
    } else {
        PG8_STAGE(PG8_SB(0, 0), cB, voffB); PG8_STAGE(PG8_SA(0, 0), cA, voffA); PG8_STAGE(PG8_SB(0, 1), cB + hstep, voffB); PG8_STAGE(PG8_SA(0, 1), cA + hstep, voffA);
        if (wr == 1) PG8_BAR;
        PG8_WAIT_V(4); PG8_BAR;
        PG8_STAGE(PG8_SB(1, 0), cB + kstep, voffB); PG8_STAGE(PG8_SA(1, 0), cA + kstep, voffA); PG8_STAGE(PG8_SB(1, 1), cB + hstep + kstep, voffB);
        PG8_WAIT_V(6); PG8_BAR;
    }
    for (;;) {
        const bool has_next = S.next(ui + 1, nxt);
        const char* nA = has_next ? (const char*)g.A + (size_t)nxt.pm * tstep + (Sched::KSPLIT ? (size_t)nxt.kt0 * kstep : (size_t)0) : cA; const char* nB = has_next ? (const char*)g.Bt + (size_t)nxt.pn * tstep + (Sched::KSPLIT ? (size_t)nxt.kt0 * kstep : (size_t)0) : cB;
        for (int t = 0; t < nt; t += 2) {
            const bool last = (t == nt - 2);
            const char* a1 = cA + (size_t)(t + 1) * kstep;
            const char* a2 = last ? nA : cA + (size_t)(t + 2) * kstep; const char* b2 = last ? nB : cB + (size_t)(t + 2) * kstep;
            const char* a3 = a2 + kstep; const char* b3 = b2 + kstep;
            if (last && has_next) S.a_ready(nxt);
            if constexpr (SP2) {
            PG8_LDB(B0, 0, 0); PG8_LDB(B1, 0, 1); PG8_SCHED; PG8_LDA(At, 0, 0); PG8_STAGE(PG8_SA(1, 1), a1 + hstep, voffA);
            PG8_WAIT_V(8); PG8_WAIT_L(0); PG8_BAR; PG8_MMA(0, 0, At, B0); PG8_MMA(0, 1, At, B1); PG8_BAR; PG8_SCHED;
            PG8_LDA(At, 0, 1); PG8_STAGE(PG8_SB(0, 0), b2, voffB); PG8_STAGE(PG8_SB(0, 1), b2 + hstep, voffB); PG8_STAGE(PG8_SA(0, 0), a2, voffA);
            PG8_WAIT_V(8); PG8_WAIT_L(0); PG8_BAR; PG8_MMA(1, 0, At, B0); PG8_MMA(1, 1, At, B1); PG8_BAR; PG8_SCHED;
            PG8_LDB(B0, 1, 0); PG8_LDB(B1, 1, 1); PG8_SCHED; PG8_LDA(At, 1, 0); PG8_STAGE(PG8_SA(0, 1), a2 + hstep, voffA);
            PG8_WAIT_V(8); PG8_WAIT_L(0); PG8_BAR; PG8_MMA(0, 0, At, B0); PG8_MMA(0, 1, At, B1); PG8_BAR; PG8_SCHED;
            PG8_LDA(At, 1, 1); PG8_STAGE(PG8_SB(1, 0), b3, voffB); PG8_STAGE(PG8_SB(1, 1), b3 + hstep, voffB); PG8_STAGE(PG8_SA(1, 0), a3, voffA);
            PG8_WAIT_V(8); PG8_WAIT_L(0); PG8_BAR; PG8_MMA(1, 0, At, B0); PG8_MMA(1, 1, At, B1); PG8_BAR; PG8_SCHED;
            } else {
            PG8_LDB(B0, 0, 0); PG8_SCHED; PG8_LDA(At, 0, 0); PG8_STAGE(PG8_SA(1, 1), a1 + hstep, voffA);
            PG8_WAIT_L(8); PG8_BAR; PG8_WAIT_L(0); PG8_MMA(0, 0, At, B0); PG8_BAR; PG8_SCHED;
            PG8_LDB(B1, 0, 1); PG8_STAGE(PG8_SB(0, 0), b2, voffB);
            PG8_BAR; PG8_WAIT_L(0); PG8_MMA(0, 1, At, B1); PG8_BAR;
            PG8_LDA(At, 0, 1); PG8_STAGE(PG8_SA(0, 0), a2, voffA);
            PG8_BAR; PG8_WAIT_L(0); PG8_MMA(1, 0, At, B0); PG8_BAR; PG8_SCHED;
            PG8_STAGE(PG8_SB(0, 1), b2 + hstep, voffB);
            PG8_WAIT_V(6); PG8_BAR; PG8_MMA(1, 1, At, B1); PG8_BAR;
            PG8_LDB(B0, 1, 0); PG8_SCHED; PG8_LDA(At, 1, 0); PG8_STAGE(PG8_SA(0, 1), a2 + hstep, voffA);
            PG8_WAIT_L(8); PG8_BAR; PG8_WAIT_L(0); PG8_MMA(0, 0, At, B0); PG8_BAR; PG8_SCHED;
            PG8_LDB(B1, 1, 1); PG8_STAGE(PG8_SB(1, 0), b3, voffB);
            PG8_BAR; PG8_WAIT_L(0); PG8_MMA(0, 1, At, B1); PG8_BAR;
            PG8_LDA(At, 1, 1); PG8_STAGE(PG8_SA(1, 0), a3, voffA);
            PG8_BAR; PG8_WAIT_L(0); PG8_MMA(1, 0, At, B0); PG8_BAR; PG8_SCHED;
            PG8_STAGE(PG8_SB(1, 1), b3 + hstep, voffB);
            PG8_WAIT_V(6); PG8_BAR; PG8_MMA(1, 1, At, B1); PG8_BAR;
            }
        }
        if constexpr (ALIGN_EPI) { if (wr == 0) PG8_BAR; }
        if constexpr (!Epi::AFTER_DRAIN) { E(acc, cur, wr, wc, fr, fq); S.done(cur); }
        if (!has_next) break;
#pragma unroll
        for (int a = 0; a < 2; ++a)
#pragma unroll
            for (int b = 0; b < 2; ++b)
#pragma unroll
                for (int m = 0; m < 4; ++m)
#pragma unroll
                    for (int n = 0; n < 2; ++n) acc[a][b][m][n] = (f32x4){0.f, 0.f, 0.f, 0.f};
        cur = nxt; cA = nA; cB = nB; ++ui; if constexpr (Sched::KSPLIT) nt = cur.nkt;
        if constexpr (ALIGN_EPI) { if (wr == 1) PG8_BAR; }
    }
    PG8_WAIT_V(0);
    if constexpr (!ALIGN_EPI) { if (wr == 0) PG8_BAR; }
    PG8_BAR;
    if constexpr (Epi::AFTER_DRAIN) { E.fused(acc, cur, wr, wc, fr, fq, lds, wid, lane); S.done(cur); }
#undef PG8_SA
#undef PG8_SB
#undef PG8_STAGE
#undef PG8_LDA
#undef PG8_LDB
#undef PG8_MMA
#undef PG8_WAIT_V
#undef PG8_WAIT_L
#undef PG8_BAR
#undef PG8_SCHED
}
}

#ifndef ATT_SD_MEM
#define ATT_SD_MEM 1
#endif
#ifndef ATT_SD_MAIN
#define ATT_SD_MAIN 1
#endif
namespace att {
typedef unsigned short bf16_t;
using bf16x8 = __attribute__((ext_vector_type(8))) short;
using s16x4  = __attribute__((ext_vector_type(4))) short;
using f32x16 = __attribute__((ext_vector_type(16))) float;
using f32x4  = __attribute__((ext_vector_type(4))) float;
using u32x4  = __attribute__((ext_vector_type(4))) unsigned;
constexpr int KVBLK = 64;
constexpr int ATT_WS_OFF = 116736;
constexpr float THR = 8.f;
#define ATT_SBAR() __builtin_amdgcn_sched_barrier(0)
__device__ __forceinline__ int crow(int r, int hi) { return (r & 3) + 8 * (r >> 2) + 4 * hi; }
__device__ __forceinline__ unsigned cvtpk(float lo, float hi) { return pg8::cvt_pk_bf16(lo, hi); }
__device__ __forceinline__ float bflo(unsigned w) { return __uint_as_float(w << 16); }
__device__ __forceinline__ float bfhi(unsigned w) { return __uint_as_float(w & 0xffff0000u); }
template <int DQK> __device__ __forceinline__ int kswz(int row, int cb) { if constexpr (DQK == 128) return row * 256 + (cb ^ ((row & 7) << 4)); else return row * 384 + (cb ^ (((row >> 1) & 7) << 4)); }
__device__ __forceinline__ int v_st(int k, int c) { const int kk = (k & ~0xC) | ((k & 4) << 1) | ((k & 8) >> 1); return ((kk >> 3) * 4 + (c >> 5)) * 512 + ((kk & 7) * 32 + (c & 31)) * 2; }
__device__ __forceinline__ int v_rd_base(int lane) { return ((lane & 3) << 3) | (((lane >> 2) & 3) << 6) | (((lane >> 4) & 1) << 5) | (((lane >> 5) & 1) << 8); }
constexpr int v_rd_off(int d0, int ks, int half) { return d0 * 512 + ks * 4096 + half * 2048; }
template <int OFF> __device__ __forceinline__ s16x4 tr_read(int vb) { s16x4 r; asm volatile("ds_read_b64_tr_b16 %0, %1 offset:%2" : "=&v"(r) : "v"(vb), "i"(OFF) : "memory"); return r; }
template <int D0> __device__ __forceinline__ void pv_one(f32x16& od, int vb, bf16x8 pa0, bf16x8 pa1, bf16x8 pa2, bf16x8 pa3) {
  const s16x4 l0 = tr_read<v_rd_off(D0, 0, 0)>(vb), h0 = tr_read<v_rd_off(D0, 0, 1)>(vb), l1 = tr_read<v_rd_off(D0, 1, 0)>(vb), h1 = tr_read<v_rd_off(D0, 1, 1)>(vb);
  const s16x4 l2 = tr_read<v_rd_off(D0, 2, 0)>(vb), h2 = tr_read<v_rd_off(D0, 2, 1)>(vb), l3 = tr_read<v_rd_off(D0, 3, 0)>(vb), h3 = tr_read<v_rd_off(D0, 3, 1)>(vb);
  asm volatile("s_waitcnt lgkmcnt(0)" ::: "memory"); ATT_SBAR();
#define ATT_PK(L, H) (bf16x8){L[0], L[1], L[2], L[3], H[0], H[1], H[2], H[3]}
  od = __builtin_amdgcn_mfma_f32_32x32x16_bf16(pa0, ATT_PK(l0, h0), od, 0, 0, 0);
  od = __builtin_amdgcn_mfma_f32_32x32x16_bf16(pa1, ATT_PK(l1, h1), od, 0, 0, 0);
  od = __builtin_amdgcn_mfma_f32_32x32x16_bf16(pa2, ATT_PK(l2, h2), od, 0, 0, 0);
  od = __builtin_amdgcn_mfma_f32_32x32x16_bf16(pa3, ATT_PK(l3, h3), od, 0, 0, 0);
#undef ATT_PK
}
__device__ __forceinline__ void pv_d0(f32x16* o, int vb, bf16x8 pa0, bf16x8 pa1, bf16x8 pa2, bf16x8 pa3) {
  pv_one<0>(o[0], vb, pa0, pa1, pa2, pa3); pv_one<1>(o[1], vb, pa0, pa1, pa2, pa3); pv_one<2>(o[2], vb, pa0, pa1, pa2, pa3); pv_one<3>(o[3], vb, pa0, pa1, pa2, pa3);
}
__device__ __forceinline__ void partialSM(f32x16& p0, f32x16& p1, float& m_reg, float& mn, float& alpha, const float C, const bool masked) {
  if (masked) {
    asm volatile("" ::: "memory");
#pragma unroll
    for (int r = 0; r < 16; ++r) { p0[r] = -__builtin_inff(); p1[r] = -__builtin_inff(); } }
  float pmax = p0[0];
#pragma unroll
  for (int r = 1; r < 16; ++r) pmax = fmaxf(pmax, p0[r]);
#pragma unroll
  for (int r = 0; r < 16; ++r) pmax = fmaxf(pmax, p1[r]);
  { auto rr = __builtin_amdgcn_permlane32_swap(__float_as_uint(pmax), __float_as_uint(pmax), false, false);
    pmax = fmaxf(__uint_as_float(rr[0]), __uint_as_float(rr[1])); }
  if (__builtin_expect(__all((pmax - m_reg) * C <= THR * LOG2E), 1)) { mn = m_reg; alpha = 1.f; }
  else { mn = fmaxf(m_reg, pmax); alpha = __builtin_amdgcn_exp2f((m_reg - mn) * C); m_reg = mn; }
  const float mnC = -mn * C;
#pragma unroll
  for (int r = 0; r < 16; ++r) p0[r] = fmaf(p0[r], C, mnC);
#pragma unroll
  for (int r = 0; r < 16; ++r) p1[r] = fmaf(p1[r], C, mnC);
#pragma unroll
  for (int r = 0; r < 16; ++r) p0[r] = __builtin_amdgcn_exp2f(p0[r]);
}
__device__ __forceinline__ void finishSM(f32x16& p0, f32x16& p1, float alpha, float& l_reg, bf16x8& pa0, bf16x8& pa1, bf16x8& pa2, bf16x8& pa3) {
#pragma unroll
  for (int r = 0; r < 16; ++r) p1[r] = __builtin_amdgcn_exp2f(p1[r]);
  float ps = 0;
#pragma unroll
  for (int r = 0; r < 16; ++r) ps += p0[r];
#pragma unroll
  for (int r = 0; r < 16; ++r) ps += p1[r];
  { auto rr = __builtin_amdgcn_permlane32_swap(__float_as_uint(ps), __float_as_uint(ps), false, false);
    ps = __uint_as_float(rr[0]) + __uint_as_float(rr[1]); }
  l_reg = l_reg * alpha + ps;
#define ATT_PK4(P, BASE, OUT) do { unsigned a0 = cvtpk(P[BASE + 0], P[BASE + 1]), a1 = cvtpk(P[BASE + 2], P[BASE + 3]);   \
    unsigned b0 = cvtpk(P[BASE + 4], P[BASE + 5]), b1 = cvtpk(P[BASE + 6], P[BASE + 7]);                              \
    auto r0 = __builtin_amdgcn_permlane32_swap(a0, b0, false, false); auto r1 = __builtin_amdgcn_permlane32_swap(a1, b1, false, false); \
    u32x4 w = {r0[0], r1[0], r0[1], r1[1]}; OUT = *reinterpret_cast<bf16x8*>(&w); } while (0)
  ATT_PK4(p0, 0, pa0); ATT_PK4(p0, 8, pa1); ATT_PK4(p1, 0, pa2); ATT_PK4(p1, 8, pa3);
#undef ATT_PK4
}
template <int DQK, int BUFOFF> __device__ __forceinline__ void qkt(f32x16& p0, f32x16& p1, const int (&kb)[4], const bf16x8* qr, const int qrb) {
  typedef const __attribute__((address_space(3))) bf16x8* lp;
  constexpr int ROWB = DQK * 2;
  p0 = f32x16{}; p1 = f32x16{};
#pragma unroll
  for (int d0 = 0; d0 < DQK / 16; ++d0) {
    const bf16x8 b0 = *(lp)(kb[d0 & 3] + (d0 >> 2) * 128 + BUFOFF);
    const bf16x8 b1 = *(lp)(kb[d0 & 3] + (d0 >> 2) * 128 + BUFOFF + 32 * ROWB);
    const bf16x8 q = d0 < 8 ? qr[d0 < 8 ? d0 : 0] : *(lp)(qrb + (d0 - 8) * 1024);
    p0 = __builtin_amdgcn_mfma_f32_32x32x16_bf16(b0, q, p0, 0, 0, 0);
    p1 = __builtin_amdgcn_mfma_f32_32x32x16_bf16(b1, q, p1, 0, 0, 0); }
}
__device__ __forceinline__ void softmax_fixed(f32x16& p0, f32x16& p1, float& l_reg, bf16x8& pa0, bf16x8& pa1, bf16x8& pa2, bf16x8& pa3, const bool masked) {
  if (masked) { asm volatile("" ::: "memory");
#pragma unroll
    for (int r = 0; r < 16; ++r) { p0[r] = -__builtin_inff(); p1[r] = -__builtin_inff(); } }
#pragma unroll
  for (int r = 0; r < 16; ++r) { p0[r] = __builtin_amdgcn_exp2f(p0[r]); p1[r] = __builtin_amdgcn_exp2f(p1[r]); }
  float ps = 0;
#pragma unroll
  for (int r = 0; r < 16; ++r) ps += p0[r];
#pragma unroll
  for (int r = 0; r < 16; ++r) ps += p1[r];
  { auto rr = __builtin_amdgcn_permlane32_swap(__float_as_uint(ps), __float_as_uint(ps), false, false); ps = __uint_as_float(rr[0]) + __uint_as_float(rr[1]); }
  l_reg += ps;
#define ATT_PK4(P, BASE, OUT) do { unsigned a0 = cvtpk(P[BASE + 0], P[BASE + 1]), a1 = cvtpk(P[BASE + 2], P[BASE + 3]);   \
    unsigned b0 = cvtpk(P[BASE + 4], P[BASE + 5]), b1 = cvtpk(P[BASE + 6], P[BASE + 7]);                              \
    auto r0 = __builtin_amdgcn_permlane32_swap(a0, b0, false, false); auto r1 = __builtin_amdgcn_permlane32_swap(a1, b1, false, false); \
    u32x4 w = {r0[0], r1[0], r0[1], r1[1]}; OUT = *reinterpret_cast<bf16x8*>(&w); } while (0)
  ATT_PK4(p0, 0, pa0); ATT_PK4(p0, 8, pa1); ATT_PK4(p1, 0, pa2); ATT_PK4(p1, 8, pa3);
#undef ATT_PK4
}

template <int DQK, int KOFF, int VOFF>
__device__ __forceinline__ void mseg(f32x16& p0, f32x16& p1, f32x16* o, const int (&kb)[4], const bf16x8* qr, const int qrb, const int vb, const bf16x8 pa0, const bf16x8 pa1, const bf16x8 pa2, const bf16x8 pa3, const bool doq) {
  typedef const __attribute__((address_space(3))) bf16x8* lp;
  typedef __attribute__((address_space(3))) s16x4* tp;
  constexpr int ROWB = DQK * 2;
#define MS_PV(KS, PA) do { _Pragma("unroll") for (int d0 = 0; d0 < 4; ++d0) { \
      const s16x4 l_ = __builtin_amdgcn_ds_read_tr16_b64_v4i16((tp)(vb + VOFF + v_rd_off(d0, KS, 0))), h_ = __builtin_amdgcn_ds_read_tr16_b64_v4i16((tp)(vb + VOFF + v_rd_off(d0, KS, 1))); \
      o[d0] = __builtin_amdgcn_mfma_f32_32x32x16_bf16(PA, (bf16x8){l_[0], l_[1], l_[2], l_[3], h_[0], h_[1], h_[2], h_[3]}, o[d0], 0, 0, 0); } } while (0)
#define MS_QK(D0) do { if (doq) { const bf16x8 b0_ = *(lp)(kb[(D0) & 3] + ((D0) >> 2) * 128 + KOFF), b1_ = *(lp)(kb[(D0) & 3] + ((D0) >> 2) * 128 + KOFF + 32 * ROWB); \
      const bf16x8 q_ = (D0) < 8 ? qr[(D0) < 8 ? (D0) : 0] : *(lp)(qrb + ((D0) - 8) * 1024); \
      p0 = __builtin_amdgcn_mfma_f32_32x32x16_bf16(b0_, q_, p0, 0, 0, 0); p1 = __builtin_amdgcn_mfma_f32_32x32x16_bf16(b1_, q_, p1, 0, 0, 0); } } while (0)
  if (doq) { p0 = f32x16{}; p1 = f32x16{}; }
  __builtin_amdgcn_s_setprio(1);
  MS_PV(0, pa0); MS_QK(0); MS_QK(1); MS_PV(1, pa1); MS_QK(2); MS_QK(3); MS_PV(2, pa2); MS_QK(4); MS_QK(5); MS_PV(3, pa3); MS_QK(6); MS_QK(7);
  if constexpr (DQK == 192) { MS_QK(8); MS_QK(9); MS_QK(10); MS_QK(11); }
  __builtin_amdgcn_s_setprio(0);
#ifndef ATT_NO_SGB
  __builtin_amdgcn_sched_group_barrier(0x100, 14, 0);
#pragma unroll
  for (int i = 0; i < 6; ++i) { __builtin_amdgcn_sched_group_barrier(0x008, 1, 0); __builtin_amdgcn_sched_group_barrier(0x100, 2, 0); }
#pragma unroll
  for (int i = 6; i < (DQK == 192 ? 40 : 32); ++i) { __builtin_amdgcn_sched_group_barrier(0x008, 1, 0); __builtin_amdgcn_sched_group_barrier(0x100, 1, 0); }
#endif
#undef MS_PV
#undef MS_QK
}

template <int DQK, int ldk, int ldv, bool FIXM>
__device__ __forceinline__ void attn_item_pp(const bf16x8* qr, const bf16_t* __restrict__ Kn, const bf16_t* __restrict__ Kr, const bf16_t* __restrict__ Vh,
                                             int NT, int NTR, int tlim, float C, char* lds, f32x16* o, float& l_out, const int wv, const bool act) {
  constexpr int SHM_V = KVBLK * 128 * 2, SHM_K = KVBLK * DQK * 2;
  int tid_ = wv * 64 + lane_id_fresh(); asm volatile("" : "+v"(tid_));
  const int tid = tid_, wid = tid >> 6, lane = tid & 63, r32 = lane & 31, hi = lane >> 5; const bool lead = wv < 4;
  char* V_lds = lds; char* K_lds = lds + 2 * SHM_V;
  float* ws = (float*)(lds + ATT_WS_OFF) + wid * 64; float* al_l = ws + 32;
  float m_reg = -1e30f, l_reg = 0;
  const int sr = tid >> 4, sc = (tid & 15) * 8, vst0 = v_st(sr, sc), vst1 = v_st(32 + sr, sc);
  const int kst0 = kswz<DQK>(sr, sc * 2), kst1 = kswz<DQK>(32 + sr, sc * 2);
  const int rr_ = tid >> 3, rc_ = (tid & 7) * 8, kst2 = kswz<DQK>(rr_, 256 + rc_ * 2);
  const int vb0 = (int)(uintptr_t)V_lds + v_rd_base(lane);
  int kb[4];
#pragma unroll
  for (int q = 0; q < 4; ++q) { kb[q] = (int)(uintptr_t)K_lds + kswz<DQK>(r32, q * 32 + hi * 16); asm volatile("" : "+v"(kb[q])); }
  int qrb = (int)(uintptr_t)lds + 2 * SHM_V + 2 * SHM_K + 2048 + wid * 4096 + lane * 16; asm volatile("" : "+v"(qrb));
  bf16x8 vs0, vs1, ks0, ks1, kr = {};
  const unsigned voV = (unsigned)(sr * ldv + sc) * 2u, voK = (unsigned)(sr * ldk + sc) * 2u, voR = (unsigned)(rr_ * 64 + rc_) * 2u;
#define PP_LOADK(t) do { const int k0_ = ((t) < NTR ? (t) : NTR - 1) * KVBLK; const char* kt_ = (const char*)(Kn + (long)k0_ * ldk); \
    ks0 = *(const bf16x8*)(kt_ + voK); ks1 = *(const bf16x8*)(kt_ + (long)32 * ldk * 2 + voK); if constexpr (DQK == 192) kr = *(const bf16x8*)((const char*)(Kr + (long)k0_ * 64) + voR); } while (0)
#define PP_LOADV(t) do { const int k0_ = ((t) < NTR ? (t) : NTR - 1) * KVBLK; const char* vt_ = (const char*)(Vh + (long)k0_ * ldv); \
    vs0 = *(const bf16x8*)(vt_ + voV); vs1 = *(const bf16x8*)(vt_ + (long)32 * ldv * 2 + voV); } while (0)
#define PP_WRITEK(b) do { *(bf16x8*)(K_lds + (b) * SHM_K + kst0) = ks0; *(bf16x8*)(K_lds + (b) * SHM_K + kst1) = ks1; if constexpr (DQK == 192) *(bf16x8*)(K_lds + (b) * SHM_K + kst2) = kr; } while (0)
#define PP_WRITEV(b) do { *(bf16x8*)(V_lds + (b) * SHM_V + vst0) = vs0; *(bf16x8*)(V_lds + (b) * SHM_V + vst1) = vs1; } while (0)
#define PP_RESC(a) do { if (__any((a) < 1.f)) { if (hi == 0) al_l[r32] = (a); asm volatile("s_waitcnt lgkmcnt(0)" ::: "memory"); \
    _Pragma("unroll") for (int d = 0; d < 4; ++d) _Pragma("unroll") for (int r = 0; r < 16; ++r) o[d][r] *= al_l[crow(r, hi)]; } } while (0)
#define PP_SOFTMAX(t) do { if constexpr (FIXM) softmax_fixed(p0, p1, l_reg, pa0, pa1, pa2, pa3, (t) >= tlim); else { partialSM(p0, p1, m_reg, mn, al, C, (t) >= tlim); finishSM(p0, p1, al, l_reg, pa0, pa1, pa2, pa3); PP_RESC(al); } } while (0)
  f32x16 p0 = {}, p1 = {}; float mn = 0.f, al = 1.f; bf16x8 pa0 = {}, pa1 = {}, pa2 = {}, pa3 = {};
  PP_LOADK(0); PP_LOADV(0); asm volatile("s_waitcnt vmcnt(0)" ::: "memory"); PP_WRITEK(0); PP_WRITEV(0);
  PP_LOADK(1); asm volatile("s_waitcnt vmcnt(0)" ::: "memory"); PP_WRITEK(1);
  PP_LOADK(2); PP_LOADV(1);
  __syncthreads();
  if (!lead) __syncthreads();
  if (act) qkt<DQK, 0>(p0, p1, kb, qr, qrb);
  __syncthreads();
  if (!lead) { PP_WRITEK(0); PP_WRITEV(1); PP_LOADK(3); PP_LOADV(2); }
  if (act) PP_SOFTMAX(0);
  __syncthreads();
  for (int s = 1; s < NT; s += 2) {
    if (act) { ATT_SBAR(); mseg<DQK, SHM_K, 0>(p0, p1, o, kb, qr, qrb, vb0, pa0, pa1, pa2, pa3, true); ATT_SBAR(); }
    __syncthreads();
    if (lead) { PP_WRITEK(0); PP_WRITEV(1); PP_LOADK(s + 2); PP_LOADV(s + 1); } else { PP_WRITEK(1); PP_WRITEV(0); PP_LOADK(s + 3); PP_LOADV(s + 2); }
    if (act) PP_SOFTMAX(s);
    __syncthreads();
    if (act) { ATT_SBAR(); mseg<DQK, 0, SHM_V>(p0, p1, o, kb, qr, qrb, vb0, pa0, pa1, pa2, pa3, s + 1 < NT); ATT_SBAR(); }
    __syncthreads();
    if (lead) { PP_WRITEK(1); PP_WRITEV(0); PP_LOADK(s + 3); PP_LOADV(s + 2); } else { PP_WRITEK(0); PP_WRITEV(1); PP_LOADK(s + 4); PP_LOADV(s + 3); }
    if (act && s + 1 < NT) PP_SOFTMAX(s + 1);
    __syncthreads();
  }
  if (lead) __syncthreads();
  l_out = l_reg;
#undef PP_LOADK
#undef PP_LOADV
#undef PP_WRITEK
#undef PP_WRITEV
#undef PP_RESC
#undef PP_SOFTMAX
}

constexpr int SI_CK = 0, SI_KT = 65536, SI_VT = 90112, SI_PX = 106496, SI_QR = 107520, SI_WS = 123904;
__device__ __forceinline__ int ckswz(int row, int cb) { return row * 512 + (cb ^ ((row & 15) << 4)); }
__device__ __forceinline__ void sample_item(const bf16x8* qr, const bf16_t* __restrict__ ckv, const bf16_t* __restrict__ krs, const bf16_t* __restrict__ Wk, const bf16_t* __restrict__ Wv,
                                            const float* __restrict__ knorm, const float C, char* lds, f32x16* o, float& l_out, const int wv) {
  typedef const __attribute__((address_space(3))) bf16x8* lp;
  typedef __attribute__((address_space(3))) s16x4* tp;
  constexpr int NTS = SKS / KVBLK;
  int tid_ = wv * 64 + lane_id_fresh(); asm volatile("" : "+v"(tid_));
  const int tid = tid_, lane = tid & 63, r32 = lane & 31, hi = lane >> 5; const bool isV = wv >= 4; const int cw = (wv & 3) * 32;
  float* ws = (float*)(lds + SI_WS) + wv * 64; float* al_l = ws + 32; float* PX = (float*)(lds + SI_PX);
  bf16x8 wf[16];
  { const bf16_t* wsrc = (isV ? Wv : Wk) + (size_t)(cw + r32) * KVL + hi * 8;
#pragma unroll
    for (int ks = 0; ks < 16; ++ks) wf[ks] = *(const bf16x8*)(wsrc + ks * 16); }
  const float* gkp = knorm + cw + 4 * hi;
  int cb8[8];
#pragma unroll
  for (int q = 0; q < 8; ++q) { cb8[q] = (int)(uintptr_t)lds + SI_CK + ckswz(r32, q * 32 + hi * 16); asm volatile("" : "+v"(cb8[q])); }
  const int kh = (wv >> 1) & 1;
  int kb[4];
#pragma unroll
  for (int q = 0; q < 4; ++q) { kb[q] = (int)(uintptr_t)lds + SI_KT + kswz<192>(32 * kh + r32, q * 32 + hi * 16); asm volatile("" : "+v"(kb[q])); }
  int qrb = (int)(uintptr_t)lds + SI_QR + (wv & 3) * 4096 + lane * 16; asm volatile("" : "+v"(qrb));
  const int vb = (int)(uintptr_t)lds + SI_VT + v_rd_base(lane);
  bf16x8 sr_;
  const unsigned goR = (unsigned)(((tid >> 3) * RD + (tid & 7) * 8) * 2);
  const int kro = kswz<192>(tid >> 3, 256 + (tid & 7) * 16);
#define SI_LOAD(t, b) do { const int t_ = (t) < NTS ? (t) : NTS - 1; const char* cb_ = uni64((const char*)(ckv + (long)t_ * KVBLK * KVL)); \
    _Pragma("unroll") for (int j = 0; j < 4; ++j) { const int row_ = (wv * 4 + j) * 2 + (lane >> 5); const unsigned go_ = (unsigned)(row_ * 512 + (((lane & 31) ^ (row_ & 15)) << 4)); \
      __builtin_amdgcn_global_load_lds((const unsigned*)(cb_ + go_), (__attribute__((address_space(3))) unsigned*)((__attribute__((address_space(3))) char*)lds + SI_CK + (b) * 32768 + (wv * 4 + j) * 1024), 16, 0, 0); } \
    sr_ = *(const bf16x8*)((const char*)(krs + (long)t_ * KVBLK * RD) + goR); } while (0)
#define SI_WRITE_ROPE() do { *(bf16x8*)(lds + SI_KT + kro) = sr_; } while (0)
  float m_reg = -1e30f, l_reg = 0.f;
  SI_LOAD(0, 0); asm volatile("s_waitcnt vmcnt(0)" ::: "memory"); SI_WRITE_ROPE(); SI_LOAD(1, 1);
  asm volatile("s_waitcnt vmcnt(0)" ::: "memory"); __syncthreads();
#pragma unroll 1
  for (int t = 0; t < NTS; ++t) {
    const int bo = (t & 1) * 32768;
    f32x16 a0 = {}, a1 = {};
#pragma unroll
    for (int ks = 0; ks < 16; ++ks) { const bf16x8 b0 = *(lp)(cb8[ks & 7] + (ks >> 3) * 256 + bo), b1 = *(lp)(cb8[ks & 7] + (ks >> 3) * 256 + bo + 32 * 512);
      a0 = __builtin_amdgcn_mfma_f32_32x32x16_bf16(wf[ks], b0, a0, 0, 0, 0); a1 = __builtin_amdgcn_mfma_f32_32x32x16_bf16(wf[ks], b1, a1, 0, 0, 0); }
    if (!isV) { float s0 = 0.f, s1 = 0.f;
#pragma unroll
      for (int r = 0; r < 16; ++r) { s0 += a0[r] * a0[r]; s1 += a1[r] * a1[r]; }
      { auto rr = __builtin_amdgcn_permlane32_swap(__float_as_uint(s0), __float_as_uint(s0), false, false); s0 = __uint_as_float(rr[0]) + __uint_as_float(rr[1]); }
      { auto rr = __builtin_amdgcn_permlane32_swap(__float_as_uint(s1), __float_as_uint(s1), false, false); s1 = __uint_as_float(rr[0]) + __uint_as_float(rr[1]); }
      if (hi == 0) { PX[r32 * 4 + (wv & 3)] = s0; PX[(32 + r32) * 4 + (wv & 3)] = s1; } }
    __syncthreads();
    if (!isV) {
      const f32x4 x0 = *(const f32x4*)(PX + r32 * 4), x1 = *(const f32x4*)(PX + (32 + r32) * 4);
      const float r0 = rsqrtf(((x0[0] + x0[1]) + (x0[2] + x0[3])) * (1.0f / 128) + 1e-6f), r1 = rsqrtf(((x1[0] + x1[1]) + (x1[2] + x1[3])) * (1.0f / 128) + 1e-6f);
#pragma unroll
      for (int q = 0; q < 4; ++q) { const int cbt = (cw + 8 * q + 4 * hi) * 2; const f32x4 gq = *(const f32x4*)(gkp + 8 * q);
        unsigned long long w0 = (unsigned long long)cvtpk(a0[4 * q] * r0 * gq[0], a0[4 * q + 1] * r0 * gq[1]) | ((unsigned long long)cvtpk(a0[4 * q + 2] * r0 * gq[2], a0[4 * q + 3] * r0 * gq[3]) << 32);
        unsigned long long w1 = (unsigned long long)cvtpk(a1[4 * q] * r1 * gq[0], a1[4 * q + 1] * r1 * gq[1]) | ((unsigned long long)cvtpk(a1[4 * q + 2] * r1 * gq[2], a1[4 * q + 3] * r1 * gq[3]) << 32);
        *(unsigned long long*)(lds + SI_KT + kswz<192>(r32, cbt)) = w0; *(unsigned long long*)(lds + SI_KT + kswz<192>(32 + r32, cbt)) = w1; }
    } else {
#pragma unroll
      for (int q = 0; q < 4; ++q) { const int c = cw + 8 * q + 4 * hi;
        unsigned long long w0 = (unsigned long long)cvtpk(a0[4 * q], a0[4 * q + 1]) | ((unsigned long long)cvtpk(a0[4 * q + 2], a0[4 * q + 3]) << 32);
        unsigned long long w1 = (unsigned long long)cvtpk(a1[4 * q], a1[4 * q + 1]) | ((unsigned long long)cvtpk(a1[4 * q + 2], a1[4 * q + 3]) << 32);
        *(unsigned long long*)(lds + SI_VT + v_st(r32, c)) = w0; *(unsigned long long*)(lds + SI_VT + v_st(32 + r32, c)) = w1; }
    }
    __syncthreads();
    if (wv < 4) {
      f32x16 p = {};
#pragma unroll
      for (int d0 = 0; d0 < 12; ++d0) { const bf16x8 kf = *(lp)(kb[d0 & 3] + (d0 >> 2) * 128); const bf16x8 qf = d0 < 8 ? qr[d0 < 8 ? d0 : 0] : *(lp)(qrb + (d0 - 8) * 1024);
        p = __builtin_amdgcn_mfma_f32_32x32x16_bf16(kf, qf, p, 0, 0, 0); }
      float pmax = p[0];
#pragma unroll
      for (int r = 1; r < 16; ++r) pmax = fmaxf(pmax, p[r]);
      { auto rr = __builtin_amdgcn_permlane32_swap(__float_as_uint(pmax), __float_as_uint(pmax), false, false); pmax = fmaxf(__uint_as_float(rr[0]), __uint_as_float(rr[1])); }
      float mn, alpha;
      if (__builtin_expect(__all((pmax - m_reg) * C <= THR * LOG2E), 1)) { mn = m_reg; alpha = 1.f; }
      else { mn = fmaxf(m_reg, pmax); alpha = __builtin_amdgcn_exp2f((m_reg - mn) * C); m_reg = mn; }
      const float mnC = -mn * C; float ps = 0.f;
#pragma unroll
      for (int r = 0; r < 16; ++r) { p[r] = __builtin_amdgcn_exp2f(fmaf(p[r], C, mnC)); ps += p[r]; }
      { auto rr = __builtin_amdgcn_permlane32_swap(__float_as_uint(ps), __float_as_uint(ps), false, false); ps = __uint_as_float(rr[0]) + __uint_as_float(rr[1]); }
      l_reg = l_reg * alpha + ps;
      bf16x8 pa0, pa1;
#define SI_PK4(P, BASE, OUT) do { unsigned a0_ = cvtpk(P[BASE + 0], P[BASE + 1]), a1_ = cvtpk(P[BASE + 2], P[BASE + 3]); unsigned b0_ = cvtpk(P[BASE + 4], P[BASE + 5]), b1_ = cvtpk(P[BASE + 6], P[BASE + 7]); \
    auto r0_ = __builtin_amdgcn_permlane32_swap(a0_, b0_, false, false); auto r1_ = __builtin_amdgcn_permlane32_swap(a1_, b1_, false, false); u32x4 w_ = {r0_[0], r1_[0], r0_[1], r1_[1]}; OUT = *reinterpret_cast<bf16x8*>(&w_); } while (0)
      SI_PK4(p, 0, pa0); SI_PK4(p, 8, pa1);
#undef SI_PK4
      if (__any(alpha < 1.f)) { if (hi == 0) al_l[r32] = alpha; asm volatile("s_waitcnt lgkmcnt(0)" ::: "memory");
#pragma unroll
        for (int d = 0; d < 4; ++d)
#pragma unroll
          for (int r = 0; r < 16; ++r) o[d][r] *= al_l[crow(r, hi)]; }
#pragma unroll
      for (int d0 = 0; d0 < 4; ++d0) {
        const int of0 = d0 * 512 + (2 * kh) * 4096, of1 = d0 * 512 + (2 * kh + 1) * 4096;
        const s16x4 l0 = __builtin_amdgcn_ds_read_tr16_b64_v4i16((tp)(vb + of0)), h0 = __builtin_amdgcn_ds_read_tr16_b64_v4i16((tp)(vb + of0 + 2048));
        const s16x4 l1 = __builtin_amdgcn_ds_read_tr16_b64_v4i16((tp)(vb + of1)), h1 = __builtin_amdgcn_ds_read_tr16_b64_v4i16((tp)(vb + of1 + 2048));
        o[d0] = __builtin_amdgcn_mfma_f32_32x32x16_bf16(pa0, (bf16x8){l0[0], l0[1], l0[2], l0[3], h0[0], h0[1], h0[2], h0[3]}, o[d0], 0, 0, 0);
        o[d0] = __builtin_amdgcn_mfma_f32_32x32x16_bf16(pa1, (bf16x8){l1[0], l1[1], l1[2], l1[3], h1[0], h1[1], h1[2], h1[3]}, o[d0], 0, 0, 0); }
    }
    __syncthreads();
    SI_WRITE_ROPE(); SI_LOAD(t + 2, t & 1);
  }
  float* CMB_O = (float*)(lds + 32768); float* CMB_ML = (float*)(lds + SI_PX);
  if (wv == 2 || wv == 3) { if (hi == 0) { CMB_ML[(wv & 1) * 64 + r32 * 2] = m_reg; CMB_ML[(wv & 1) * 64 + r32 * 2 + 1] = l_reg; }
#pragma unroll
    for (int d = 0; d < 4; ++d)
#pragma unroll
      for (int r = 0; r < 16; ++r) CMB_O[(wv & 1) * 4096 + (d * 16 + r) * 64 + lane] = o[d][r]; }
  __syncthreads();
  if (wv < 2) { const float m1 = CMB_ML[wv * 64 + r32 * 2], l1 = CMB_ML[wv * 64 + r32 * 2 + 1]; const float m = fmaxf(m_reg, m1);
    const float e0 = __builtin_amdgcn_exp2f((m_reg - m) * C), e1 = __builtin_amdgcn_exp2f((m1 - m) * C); l_reg = l_reg * e0 + l1 * e1;
    if (hi == 0) { al_l[r32] = e0; ws[r32] = e1; } asm volatile("s_waitcnt lgkmcnt(0)" ::: "memory");
#pragma unroll
    for (int d = 0; d < 4; ++d)
#pragma unroll
      for (int r = 0; r < 16; ++r) o[d][r] = o[d][r] * al_l[crow(r, hi)] + CMB_O[wv * 4096 + (d * 16 + r) * 64 + lane] * ws[crow(r, hi)];
    asm volatile("s_waitcnt lgkmcnt(0)" ::: "memory"); }
  l_out = l_reg;
  __syncthreads();
#undef SI_LOAD
#undef SI_WRITE_ROPE
}
}

constexpr size_t WS_CTL = 0, CTL_BYTES = 1u << 20;
constexpr size_t WS_ROPE = WS_CTL + CTL_BYTES;
constexpr size_t WS_RS = WS_ROPE + (size_t)MP * 32 * 8;
constexpr size_t WS_W1A = WS_RS + (size_t)M * 32 * 4;
constexpr size_t WS_W1D = WS_W1A + (size_t)2 * DFF * D * 2;
constexpr size_t WS_WIG = WS_W1D + (size_t)D * DFF * 2;
constexpr size_t WS_WUQ = WS_WIG + (size_t)8192 * D * 2;
constexpr size_t WS_WKV = WS_WUQ + (size_t)3072 * QL * 2;
constexpr size_t WS_WPL = WS_WKV + (size_t)4096 * KVL * 2;
constexpr size_t WS_WMK = WS_WPL + (size_t)D * PWD * 2;
constexpr size_t WS_WO = WS_WMK + (size_t)2560 * D * 2;
constexpr size_t WS_W2A = WS_WO + (size_t)D * D * 2;
constexpr size_t WS_W2D = WS_W2A + (size_t)2 * DFF * D * 2;
constexpr size_t WS_XB = WS_W2D + (size_t)D * DFF * 2;
constexpr size_t WS_MB = WS_XB + (size_t)M * D * 2;
constexpr size_t WS_MKVRAW = WS_MB + (size_t)NMEM * D * 2;
constexpr size_t WS_MEMKP = WS_MKVRAW + (size_t)NMEM * 2560 * 4;
constexpr size_t WS_MEMVP = WS_MEMKP + (size_t)NMEM * 512 * 2;
constexpr size_t WS_MEMKS = WS_MEMVP + (size_t)NMEM * D * 2;
constexpr size_t WS_MEMVS = WS_MEMKS + (size_t)DB * NMEM * 512 * 2;
constexpr size_t WS_KRP = WS_MEMVS + (size_t)DB * NMEM * D * 2;
constexpr size_t WS_KRS = WS_KRP + (size_t)MP * RD * 2;
constexpr size_t WS_QRAW = WS_KRS + (size_t)DB * SKS * RD * 2;
constexpr size_t WS_CKV = WS_QRAW + (size_t)M * 3072 * 2;
constexpr size_t WS_MERGED = WS_CKV + (size_t)SALL * KVL * 2;
constexpr size_t WS_CQ = WS_MERGED + (size_t)M * D * 2;
constexpr size_t WS_POOLED = WS_CQ + (size_t)M * QL * 2;
constexpr size_t WS_QM = WS_POOLED + (size_t)M * PWD * 2;
constexpr size_t WS_GA = WS_QM + (size_t)M * MQD * 2;
constexpr size_t WS_BIG = WS_GA + (size_t)M * D * 2;
constexpr size_t WS_GP = WS_BIG, WS_GM = WS_GP + (size_t)M * D * 2, WS_INPROJ = WS_GM + (size_t)M * D * 2, WS_EARLY_END = WS_INPROJ + (size_t)M * D * 4;
constexpr size_t WS_KP = WS_INPROJ, WS_VP = WS_KP + (size_t)MP * D * 2, WS_LATE_END = WS_VP + (size_t)MP * D * 2;
static_assert(WS_GP == WS_GA + (size_t)M * D * 2 && WS_GM == WS_GP + (size_t)M * D * 2, "gates contiguous");
constexpr size_t WS_ACT = WS_BIG, WS_ACT_END = WS_ACT + (size_t)M * DFF * 2;
constexpr size_t WS_END = WS_LATE_END > WS_EARLY_END ? (WS_LATE_END > WS_ACT_END ? WS_LATE_END : WS_ACT_END) : (WS_EARLY_END > WS_ACT_END ? WS_EARLY_END : WS_ACT_END);
constexpr int CW_QUEUE = 2048;
constexpr int CW_BAR = 4096;
constexpr size_t O_Y = 0, O_CKVP = (size_t)M * D, O_KRP = O_CKVP + (size_t)DEPTH * MP * KVL, O_POOLP = O_KRP + (size_t)DEPTH * MP * RD, O_MKP = O_POOLP + (size_t)DEPTH * PPAD * PWD,
                 O_MVP = O_MKP + (size_t)DEPTH * NMEM * 512, O_CKVS = O_MVP + (size_t)DEPTH * NMEM * D, O_KRS = O_CKVS + (size_t)DEPTH * MS * KVL, O_POOLS = O_KRS + (size_t)DEPTH * MS * RD,
                 O_END = O_POOLS + (size_t)DEPTH * DB * PPAD * PWD;
constexpr int STAMP_OFF = 131072 + 8192 + 2048;
constexpr int RING_BYTES = 131072, LDSX_OFF = RING_BYTES  , MISC_OFF = LDSX_OFF + 8192, LDS_BYTES = 147456;

#define LAS __attribute__((address_space(3)))
typedef unsigned short bf16;
typedef float f32x4 __attribute__((ext_vector_type(4)));
typedef unsigned u32x4 __attribute__((ext_vector_type(4)));
typedef unsigned u32x2 __attribute__((ext_vector_type(2)));
typedef float f32x2 __attribute__((ext_vector_type(2)));
#define LDS_WAIT() asm volatile("s_waitcnt lgkmcnt(0)" ::: "memory")
__device__ __forceinline__ unsigned pk2(float lo, float hi) { return pg8::cvt_pk_bf16(lo, hi); }
template <int CTRL> __device__ __forceinline__ float dpp_f(float v) { return __uint_as_float(__builtin_amdgcn_update_dpp(0u, __float_as_uint(v), CTRL, 0xf, 0xf, false)); }
__device__ __forceinline__ float sum16(float v) { v += dpp_f<0x128>(v); v += dpp_f<0x124>(v); v += dpp_f<0x122>(v); v += dpp_f<0x121>(v); return v; }
__device__ __forceinline__ float wave_sum(float v) { return pg8::xsum_fq(sum16(v)); }
__device__ __forceinline__ float sum_x32(float v) { const auto b = __builtin_amdgcn_permlane32_swap(__float_as_uint(v), __float_as_uint(v), false, false); return __uint_as_float(b[0]) + __uint_as_float(b[1]); }
__device__ __forceinline__ float other_x32(float v, bool upper) { const auto b = __builtin_amdgcn_permlane32_swap(__float_as_uint(v), __float_as_uint(v), false, false); return __uint_as_float(upper ? b[0] : b[1]); }

#define XB_TMO      128
#define XB_XCNT(j)  (256  + 64 * (j))
#define XB_XSUB(j)  (1280 + 64 * (j))
#define XB_XGEN(j)  (2304 + 64 * (j))
#define XB_TOP      3328
#define XB_TOPGEN   3392
#define XCD_BAR_WORDS 3456
#define XB_SPIN_CAP (1u << 22)

__device__ __forceinline__ unsigned xb_ld(unsigned* p)              { return __hip_atomic_load(p, __ATOMIC_RELAXED, __HIP_MEMORY_SCOPE_AGENT); }
__device__ __forceinline__ unsigned xb_add(unsigned* p, unsigned v) { return __hip_atomic_fetch_add(p, v, __ATOMIC_RELAXED, __HIP_MEMORY_SCOPE_AGENT); }
__device__ __forceinline__ unsigned xb_xcc_id() { return (unsigned)__builtin_amdgcn_s_getreg((3 << 11) | 20) & 0xFu; }
#define XB_SPIN(cond, bar) do { unsigned _sp = 0; while (cond) { __builtin_amdgcn_s_sleep(1); \
    if ((++_sp & 255u) == 0u) { if (xb_ld(&(bar)[XB_TMO])) break; if (_sp > XB_SPIN_CAP) { atomicAdd(&(bar)[XB_TMO], 1u); break; } } } } while (0)

struct XcdBarrier {
    unsigned* bar; unsigned x;
    volatile LAS unsigned* st;
};

__device__ __forceinline__ XcdBarrier xcd_barrier_post(unsigned* bar, volatile LAS unsigned* st) {
    XcdBarrier b; b.bar = bar; b.x = xb_xcc_id(); b.st = st;
    if (threadIdx.x == 0) (void)xb_add(&bar[XB_XCNT(b.x)], 1u);
    return b;
}
__device__ __forceinline__ void xcd_barrier_complete(unsigned* bar, unsigned x, unsigned& nloc, unsigned& nx) {
    const unsigned G = gridDim.x * gridDim.y * gridDim.z;
    unsigned sum, cnt, mine, sp = 0u;
    for (;;) {
        sum = 0u; cnt = 0u; mine = 0u;
#pragma unroll
        for (unsigned j = 0; j < 16; ++j) { const unsigned c = xb_ld(&bar[XB_XCNT(j)]); sum += c; cnt += (c > 0u) ? 1u : 0u; mine = (j == x) ? c : mine; }
        if (sum == G) break;
        __builtin_amdgcn_s_sleep(1);
        if ((++sp & 255u) == 0u) { if (xb_ld(&bar[XB_TMO])) break; if (sp > XB_SPIN_CAP) { atomicAdd(&bar[XB_TMO], 1u); break; } }
    }
    nloc = mine > 0u ? mine : 1u; nx = cnt > 0u ? cnt : 1u;
}

__device__ __forceinline__ void xcd_barrier(const XcdBarrier& b) {
    asm volatile("s_waitcnt vmcnt(0)" ::: "memory");
    __syncthreads();
    if (threadIdx.x == 0) {
        unsigned* bar = b.bar;
        __builtin_amdgcn_s_waitcnt(0);
        unsigned nloc = b.st[0], nx = b.st[1];
        if (nloc == 0u) { xcd_barrier_complete(bar, b.x, nloc, nx); b.st[0] = nloc; b.st[1] = nx; }
        const unsigned old = xb_add(&bar[XB_XSUB(b.x)], 1u);
        const unsigned gen = old / nloc;
        if (old + 1u == (gen + 1u) * nloc) {
            __builtin_amdgcn_fence(__ATOMIC_RELEASE, "agent");
            asm volatile("s_waitcnt vmcnt(0)" ::: "memory");
            const unsigned og = xb_add(&bar[XB_TOP], 1u);
            const unsigned tg = og / nx;
            if (og + 1u == (tg + 1u) * nx) xb_add(&bar[XB_TOPGEN], 1u);
            else XB_SPIN(xb_ld(&bar[XB_TOPGEN]) == tg, bar);
            __builtin_amdgcn_fence(__ATOMIC_ACQUIRE, "agent");
            xb_add(&bar[XB_XGEN(b.x)], 1u);
            asm volatile("s_waitcnt vmcnt(0)" ::: "memory");
        } else {
            XB_SPIN(xb_ld(&bar[XB_XGEN(b.x)]) == gen, bar);
            __builtin_amdgcn_fence(__ATOMIC_ACQUIRE, "agent");
            asm volatile("s_waitcnt vmcnt(0)" ::: "memory");
        }
    }
    __syncthreads();
}


enum { PH_PREP = 0, PH_F1A, PH_F1D, PH_F1C, PH_ING, PH_POST, PH_UQP, PH_KV0, PH_ATT0, PH_WO, PH_WOC, PH_F2A, PH_F2D, PH_F2C, NPH };
enum { I_XP = 0, I_XS, I_MEMP, I_CCKV, I_CKR, I_SPOOL, I_CMK, I_CMV, I_F1N, I_F1G, I_F1U, I_F1D, I_MIXN, I_WIN, I_QLN, I_KVLN, I_WUQ, I_WUQR, I_WUK, I_WUV, I_QN, I_KN, I_QRN, I_KRN,
       I_POOLW, I_POOLS, I_MEMN, I_WMK, I_WMV, I_MQN, I_MKN, I_WG, I_BG, I_WOUT, I_F2N, I_F2G, I_F2U, I_F2D, N_IN };
struct Params { const float* in[N_IN]; float* out; unsigned char* ws; double inv[32]; int ph_lo, ph_hi, li, pad; };
constexpr int PT_OFF = MISC_OFF + 256, PT_OUT = N_IN, PT_WS = N_IN + 1, PT_INV = PT_OFF + 8 * (N_IN + 2);
__device__ __forceinline__ const float* ldp(LAS unsigned char* lds, int i) {
    const LAS unsigned* t = (const LAS unsigned*)(lds + PT_OFF) + 2 * i;
    const unsigned lo = __builtin_amdgcn_readfirstlane(t[0]), hi = __builtin_amdgcn_readfirstlane(t[1]);
    return (const float*)(const __attribute__((address_space(1))) float*)(((unsigned long long)hi << 32) | (unsigned long long)lo);
}
__device__ __forceinline__ unsigned char* ldws(LAS unsigned char* lds) { return (unsigned char*)ldp(lds, PT_WS); }
__device__ __forceinline__ float* ldout(LAS unsigned char* lds) { return (float*)ldp(lds, PT_OUT); }

__device__ __forceinline__ void tr_item(const float* W, int N, const float* gain, bf16* dst, int ldt, int mode, int item, LAS float* scr, int lane) {
    const int nblk = N >> 6, kb = item / nblk, nb = item - kb * nblk, k0 = kb << 6, n0 = nb << 6;
    const int drow0 = mode == 0 ? n0 : (((n0 >> 7) << 8) + (n0 & 127) + (mode == 2 ? 128 : 0));
    const float* src = W + (size_t)k0 * N + n0 + lane;
    float v[64];
#pragma unroll
    for (int i = 0; i < 64; ++i) v[i] = src[(size_t)i * N];
    if (gain) {
#pragma unroll
        for (int i = 0; i < 64; ++i) v[i] *= gain[k0 + i]; }
#pragma unroll
    for (int i = 0; i < 64; ++i) scr[i * 65 + lane] = v[i];
    LDS_WAIT(); asm volatile("" ::: "memory");
    const int c = lane & 7;
#pragma unroll
    for (int j = 0; j < 8; ++j) { const int n = (lane >> 3) + 8 * j; const LAS float* s = scr + (8 * c) * 65 + n;
        u32x4 o; o.x = pk2(s[0 * 65], s[1 * 65]); o.y = pk2(s[2 * 65], s[3 * 65]); o.z = pk2(s[4 * 65], s[5 * 65]); o.w = pk2(s[6 * 65], s[7 * 65]);
        *(u32x4*)(dst + (size_t)(drow0 + n) * ldt + k0 + 8 * c) = o; }
    LDS_WAIT(); asm volatile("" ::: "memory");
}
__device__ __forceinline__ u32x4 cvt8(const float* p) { const f32x4 a = *(const f32x4*)p, b = *(const f32x4*)(p + 4); u32x4 o; o.x = pk2(a[0], a[1]); o.y = pk2(a[2], a[3]); o.z = pk2(b[0], b[1]); o.w = pk2(b[2], b[3]); return o; }

__device__ __forceinline__ void phase_prep(int l, LAS unsigned char* lds, const int wv) {
    int tid_ = wv * 64 + lane_id_fresh(); asm volatile("" : "+v"(tid_));     const int lane = tid_ & 63, wave = __builtin_amdgcn_readfirstlane(tid_ >> 6);
    unsigned char* ws = ldws(lds);
    LAS float* scr = (LAS float*)(lds + wave * 16640);
    const int gw = blockIdx.x * 8 + wave, NGW = gridDim.x * 8;
    constexpr int C_FA = (D / 64) * (DFF / 64), C_FD = (DFF / 64) * (D / 64), C_IN = (D / 64) * (INW / 64), C_G = (D / 64) * (3 * D / 64), C_UQ = (QL / 64) * (D / 64), C_UQR = (QL / 64) * (1024 / 64),
                  C_UK = (KVL / 64) * (D / 64), C_PL = 4 * 2 * 8, C_MK = (D / 64) * (512 / 64), C_MV = (D / 64) * (D / 64), C_WO = (D / 64) * (D / 64), C_ZIG = 192, C_ZPL = D;
    constexpr int NITEMS = 4 * C_FA + 2 * C_FD + C_IN + C_G + C_UQ + C_UQR + 2 * C_UK + C_PL + C_MK + C_MV + C_WO + C_ZIG + C_ZPL;
    for (int it = gw; it < NITEMS; it += NGW) {
        int r = it;
        if (r < C_FA) { tr_item(ldp(lds, I_F1G) + (size_t)l * D * DFF, DFF, ldp(lds, I_F1N) + l * D, (bf16*)(ws + WS_W1A), D, 1, r, scr, lane); continue; } r -= C_FA;
        if (r < C_FA) { tr_item(ldp(lds, I_F1U) + (size_t)l * D * DFF, DFF, ldp(lds, I_F1N) + l * D, (bf16*)(ws + WS_W1A), D, 2, r, scr, lane); continue; } r -= C_FA;
        if (r < C_FD) { tr_item(ldp(lds, I_F1D) + (size_t)l * D * DFF, D, nullptr, (bf16*)(ws + WS_W1D), DFF, 0, r, scr, lane); continue; } r -= C_FD;
        if (r < C_FA) { tr_item(ldp(lds, I_F2G) + (size_t)l * D * DFF, DFF, ldp(lds, I_F2N) + l * D, (bf16*)(ws + WS_W2A), D, 1, r, scr, lane); continue; } r -= C_FA;
        if (r < C_FA) { tr_item(ldp(lds, I_F2U) + (size_t)l * D * DFF, DFF, ldp(lds, I_F2N) + l * D, (bf16*)(ws + WS_W2A), D, 2, r, scr, lane); continue; } r -= C_FA;
        if (r < C_FD) { tr_item(ldp(lds, I_F2D) + (size_t)l * D * DFF, D, nullptr, (bf16*)(ws + WS_W2D), DFF, 0, r, scr, lane); continue; } r -= C_FD;
        if (r < C_IN) { tr_item(ldp(lds, I_WIN) + (size_t)l * D * INW, INW, ldp(lds, I_MIXN) + l * D, (bf16*)(ws + WS_WIG), D, 0, r, scr, lane); continue; } r -= C_IN;
        if (r < C_G) { tr_item(ldp(lds, I_WG) + (size_t)l * D * 3 * D, 3 * D, ldp(lds, I_MIXN) + l * D, (bf16*)(ws + WS_WIG) + (size_t)D * D, D, 0, r, scr, lane); continue; } r -= C_G;
        if (r < C_UQ) { tr_item(ldp(lds, I_WUQ) + (size_t)l * QL * D, D, nullptr, (bf16*)(ws + WS_WUQ), QL, 0, r, scr, lane); continue; } r -= C_UQ;
        if (r < C_UQR) { tr_item(ldp(lds, I_WUQR) + (size_t)l * QL * 1024, 1024, nullptr, (bf16*)(ws + WS_WUQ) + (size_t)D * QL, QL, 0, r, scr, lane); continue; } r -= C_UQR;
        if (r < C_UK) { tr_item(ldp(lds, I_WUK) + (size_t)l * KVL * D, D, nullptr, (bf16*)(ws + WS_WKV), KVL, 0, r, scr, lane); continue; } r -= C_UK;
        if (r < C_UK) { tr_item(ldp(lds, I_WUV) + (size_t)l * KVL * D, D, nullptr, (bf16*)(ws + WS_WKV) + (size_t)D * KVL, KVL, 0, r, scr, lane); continue; } r -= C_UK;
        if (r < C_PL) { const int g = r >> 4; tr_item(ldp(lds, I_POOLW) + ((size_t)l * 4 + g) * 128 * 512, 512, nullptr, (bf16*)(ws + WS_WPL) + (size_t)(g * 512) * PWD + g * 128, PWD, 0, r & 15, scr, lane); continue; } r -= C_PL;
        if (r < C_MK) { tr_item(ldp(lds, I_WMK) + (size_t)l * D * 512, 512, nullptr, (bf16*)(ws + WS_WMK), D, 0, r, scr, lane); continue; } r -= C_MK;
        if (r < C_MV) { tr_item(ldp(lds, I_WMV) + (size_t)l * D * D, D, nullptr, (bf16*)(ws + WS_WMK) + (size_t)512 * D, D, 0, r, scr, lane); continue; } r -= C_MV;
        if (r < C_WO) { tr_item(ldp(lds, I_WOUT) + (size_t)l * D * D, D, nullptr, (bf16*)(ws + WS_WO), D, 0, r, scr, lane); continue; } r -= C_WO;
        if (r < C_ZIG) { u32x4* o = (u32x4*)((bf16*)(ws + WS_WIG) + (size_t)(INW + r) * D) + lane; const u32x4 z = {0u, 0u, 0u, 0u}; o[0] = z; o[64] = z; o[128] = z; o[192] = z; continue; } r -= C_ZIG;
        { if ((lane >> 4) != (r >> 9)) { const u32x4 z = {0u, 0u, 0u, 0u}; *((u32x4*)((bf16*)(ws + WS_WPL) + (size_t)r * PWD) + lane) = z; } }
    }
    const size_t tix = (size_t)gw * 64 + lane, tst = (size_t)NGW * 64;
    { const float* src = ldp(lds, I_CCKV) + (size_t)l * DB * PAST * KVL; bf16* dst = (bf16*)(ws + WS_CKV);
      for (size_t e0 = tix; e0 < (size_t)DB * PAST * (KVL / 8); e0 += 4 * tst) { u32x4 t[4];
#pragma unroll
          for (int q = 0; q < 4; ++q) { const size_t e = e0 + q * tst; if (e < (size_t)DB * PAST * (KVL / 8)) t[q] = cvt8(src + e * 8); }
#pragma unroll
          for (int q = 0; q < 4; ++q) { const size_t e = e0 + q * tst; if (e < (size_t)DB * PAST * (KVL / 8)) { const size_t row = e >> 5, c8 = e & 31, b = row >> 12, s = row & 4095; *(u32x4*)(dst + ((size_t)MP + b * SKS + s) * KVL + c8 * 8) = t[q]; } } } }
    { const float* src = ldp(lds, I_CKR) + (size_t)l * DB * PAST * RD; bf16* dst = (bf16*)(ws + WS_KRS);
      for (size_t e0 = tix; e0 < (size_t)DB * PAST * (RD / 8); e0 += 4 * tst) { u32x4 t[4];
#pragma unroll
          for (int q = 0; q < 4; ++q) { const size_t e = e0 + q * tst; if (e < (size_t)DB * PAST * (RD / 8)) t[q] = cvt8(src + e * 8); }
#pragma unroll
          for (int q = 0; q < 4; ++q) { const size_t e = e0 + q * tst; if (e < (size_t)DB * PAST * (RD / 8)) { const size_t row = e >> 3, c8 = e & 7, b = row >> 12, s = row & 4095; *(u32x4*)(dst + (b * SKS + s) * RD + c8 * 8) = t[q]; } } } }
    { const float* src = ldp(lds, I_CMK) + (size_t)l * DB * NMEM * 512; bf16* dst = (bf16*)(ws + WS_MEMKS);
      for (size_t e0 = tix; e0 < (size_t)DB * NMEM * 512 / 8; e0 += 4 * tst) { u32x4 t[4];
#pragma unroll
          for (int q = 0; q < 4; ++q) { const size_t e = e0 + q * tst; if (e < (size_t)DB * NMEM * 512 / 8) t[q] = cvt8(src + e * 8); }
#pragma unroll
          for (int q = 0; q < 4; ++q) { const size_t e = e0 + q * tst; if (e < (size_t)DB * NMEM * 512 / 8) *(u32x4*)(dst + e * 8) = t[q]; } } }
    { const float* src = ldp(lds, I_CMV) + (size_t)l * DB * NMEM * D; bf16* dst = (bf16*)(ws + WS_MEMVS);
      for (size_t e0 = tix; e0 < (size_t)DB * NMEM * D / 8; e0 += 4 * tst) { u32x4 t[4];
#pragma unroll
          for (int q = 0; q < 4; ++q) { const size_t e = e0 + q * tst; if (e < (size_t)DB * NMEM * D / 8) t[q] = cvt8(src + e * 8); }
#pragma unroll
          for (int q = 0; q < 4; ++q) { const size_t e = e0 + q * tst; if (e < (size_t)DB * NMEM * D / 8) *(u32x4*)(dst + e * 8) = t[q]; } } }
    { const float* mn = ldp(lds, I_MEMN) + l * D; const float* memp = ldp(lds, I_MEMP); bf16* MBp = (bf16*)(ws + WS_MB);
      for (int row = gw; row < NMEM; row += NGW) { const float* x = memp + (size_t)row * D; f32x4 v[8]; float ss = 0.f;
#pragma unroll
          for (int j = 0; j < 8; ++j) { v[j] = *(const f32x4*)(x + j * 256 + lane * 4); ss += pg8::dot4(v[j]); }
          const float r = rsqrtf(wave_sum(ss) * (1.0f / D) + EPS);
#pragma unroll
          for (int j = 0; j < 8; ++j) { const f32x4 g = *(const f32x4*)(mn + j * 256 + lane * 4); const f32x4 y = v[j] * r * g; u32x2 o; o.x = pk2(y[0], y[1]); o.y = pk2(y[2], y[3]); *(u32x2*)(MBp + (size_t)row * D + j * 256 + lane * 4) = o; } } }
    if (l == 0) {
        bf16* XB = (bf16*)(ws + WS_XB); float* RS = (float*)(ws + WS_RS); const float* xp = ldp(lds, I_XP); const float* xs = ldp(lds, I_XS);
        for (int row = gw; row < M; row += NGW) { const float* x = row < MP ? xp + (size_t)row * D : xs + (size_t)(row - MP) * D; float ss = 0.f;
#pragma unroll
            for (int j = 0; j < 8; ++j) { const f32x4 v = *(const f32x4*)(x + j * 256 + lane * 4); ss += pg8::dot4(v); u32x2 o; o.x = pk2(v[0], v[1]); o.y = pk2(v[2], v[3]); *(u32x2*)(XB + (size_t)row * D + j * 256 + lane * 4) = o; }
            ss = wave_sum(ss); if (lane < 32) RS[(size_t)row * 32 + lane] = lane == 0 ? ss : 0.f; }
        f32x2* tab = (f32x2*)(ws + WS_ROPE);
        for (size_t e = tix; e < (size_t)MP * 32; e += tst) { const int pos = (int)(e >> 5), i = (int)(e & 31);
            const double ang = (double)pos * ((const LAS double*)(lds + PT_INV))[i]; const double n = __builtin_rint(ang * 0.15915494309189535); const double rr = __builtin_fma(-n, 6.283185307179586, ang) - n * 2.4492935982947064e-16;
            const double x2 = rr * rr; double sn = 0.0, cs = 0.0;
#pragma unroll
            for (int k = 14; k >= 1; --k) { sn = (sn + 1.0) * (x2 * (-1.0 / (double)((2 * k) * (2 * k + 1)))); cs = (cs + 1.0) * (x2 * (-1.0 / (double)((2 * k - 1) * (2 * k)))); }
            sn = (sn + 1.0) * rr; cs = cs + 1.0;
            tab[e] = (f32x2){(float)cs, (float)sn}; }
    }
}

constexpr size_t WS_SLAB = WS_QRAW;
template <bool F32SRC, bool F32OUT>
__device__ __forceinline__ void phase_combine(const float* resid  , float alpha, LAS unsigned char* lds, const int wv) {
    int tid_ = wv * 64 + lane_id_fresh(); asm volatile("" : "+v"(tid_)); const int lane = tid_ & 63, wave = __builtin_amdgcn_readfirstlane(tid_ >> 6);
    unsigned char* ws = ldws(lds); const float* slab = (const float*)(ws + WS_SLAB); float* R = ldout(lds) + O_Y + (size_t)MP * D; bf16* XB = (bf16*)(ws + WS_XB) + (size_t)MP * D; float* RS = (float*)(ws + WS_RS) + (size_t)MP * 32;
    const int gw = blockIdx.x * 8 + wave, NGW = gridDim.x * 8;
    for (int hr = gw; hr < 2 * MS; hr += NGW) { const int row = hr >> 1, half = hr & 1; float ss = 0.f;
#pragma unroll
        for (int jj = 0; jj < 4; ++jj) { const int j = half * 4 + jj; const size_t off = (size_t)row * D + j * 256 + lane * 4; f32x4 a = *(const f32x4*)(slab + off);
#pragma unroll
            for (int k = 1; k < 8; ++k) a += *(const f32x4*)(slab + (size_t)k * MS * D + off);
            f32x4 x; if constexpr (F32SRC) x = *(const f32x4*)(resid + off); else { const u32x2 w = *(const u32x2*)(XB + off); x = (f32x4){pg8::bf_lo(w.x), pg8::bf_hi(w.x), pg8::bf_lo(w.y), pg8::bf_hi(w.y)}; }
            const f32x4 o = x + a * alpha; if constexpr (F32OUT) *(f32x4*)(R + off) = o; u32x2 w2; w2.x = pk2(o[0], o[1]); w2.y = pk2(o[2], o[3]); *(u32x2*)(XB + off) = w2; ss += pg8::dot4(o); }
        ss = wave_sum(ss); if (lane < 16) RS[(size_t)row * 32 + half * 16 + lane] = lane == 0 ? ss : 0.f; }
}
__device__ __forceinline__ void phase_post(int l, LAS unsigned char* lds, const int wv) {
    int tid_ = wv * 64 + lane_id_fresh(); asm volatile("" : "+v"(tid_));     const int lane = tid_ & 63, wave = __builtin_amdgcn_readfirstlane(tid_ >> 6);
    unsigned char* ws = ldws(lds); const int gw = blockIdx.x * 8 + wave, NGW = gridDim.x * 8;
    const float* INP = (const float*)(ws + WS_INPROJ); const f32x2* tab = (const f32x2*)(ws + WS_ROPE);
    bf16* CQ = (bf16*)(ws + WS_CQ); bf16* CKV = (bf16*)(ws + WS_CKV); bf16* KRP = (bf16*)(ws + WS_KRP); bf16* KRS = (bf16*)(ws + WS_KRS); bf16* POOLED = (bf16*)(ws + WS_POOLED); bf16* QM = (bf16*)(ws + WS_QM);
    const float* qln = ldp(lds, I_QLN) + l * QL; const float* kvln = ldp(lds, I_KVLN) + l * KVL; const float* krn = ldp(lds, I_KRN) + l * RD; const float* mqn = ldp(lds, I_MQN) + l * 128;
    float* out = ldout(lds); const float* spool = ldp(lds, I_SPOOL); const float* mkn = ldp(lds, I_MKN) + l * 128;
    const f32x4 gq0 = *(const f32x4*)(qln + 8 * lane), gq1 = *(const f32x4*)(qln + 8 * lane + 4), gkv = *(const f32x4*)(kvln + 4 * lane);
    const f32x4 gm0 = *(const f32x4*)(mqn + ((8 * lane) & 127)), gm1 = *(const f32x4*)(mqn + ((8 * lane) & 127) + 4); const float gkr = krn[lane];
    const int NBLK = M / 4;
    for (int blk = gw; blk < NBLK + NMEM; blk += NGW) {
        if (blk >= NBLK) {
            const int j = blk - NBLK; const float* raw = (const float*)(ws + WS_MKVRAW) + (size_t)j * 2560;
            { const f32x4 a = *(const f32x4*)(raw + 8 * lane), b = *(const f32x4*)(raw + 8 * lane + 4); const float r = rsqrtf(sum16(pg8::dot4(a) + pg8::dot4(b)) * (1.0f / 128) + EPS);
              const f32x4 g0 = *(const f32x4*)(mkn + ((8 * lane) & 127)), g1 = *(const f32x4*)(mkn + ((8 * lane) & 127) + 4); const f32x4 y0 = a * r * g0, y1 = b * r * g1;
              float* o = out + O_MKP + ((size_t)l * NMEM + j) * 512 + 8 * lane; *(f32x4*)o = y0; *(f32x4*)(o + 4) = y1;
              *(u32x4*)((bf16*)(ws + WS_MEMKP) + (size_t)j * 512 + 8 * lane) = pg8::pack8(y0, y1); }
#pragma unroll
            for (int q = 0; q < 4; ++q) { const f32x4 a = *(const f32x4*)(raw + 512 + q * 512 + 8 * lane), b = *(const f32x4*)(raw + 512 + q * 512 + 8 * lane + 4);
              float* o = out + O_MVP + ((size_t)l * NMEM + j) * D + q * 512 + 8 * lane; *(f32x4*)o = a; *(f32x4*)(o + 4) = b;
              *(u32x4*)((bf16*)(ws + WS_MEMVP) + (size_t)j * D + q * 512 + 8 * lane) = pg8::pack8(a, b); }
            continue;
        }
        const int r0 = blk * 4; const bool samp = r0 >= MP; const int b = samp ? (r0 - MP) >> 6 : 0; const int s0 = samp ? MP + b * DS : 0; const int t0 = r0 - s0;
        const int w = 2 << (lane >> 4);
        f32x4 acc[4][2], cur[4][2];
#pragma unroll
        for (int k = 0; k < 4; ++k) { acc[k][0] = (f32x4){0.f, 0.f, 0.f, 0.f}; acc[k][1] = acc[k][0]; cur[k][0] = acc[k][0]; cur[k][1] = acc[k][0]; }
        for (int dj = 0; dj < 19; ++dj) { const int t = t0 + 3 - dj;
            if (dj < w + 3) { f32x4 a = {0.f, 0.f, 0.f, 0.f}, bb = a;
                if (t >= 0) { const float* src = INP + (size_t)(s0 + t) * D + 832 + 8 * lane; a = *(const f32x4*)src; bb = *(const f32x4*)(src + 4); }
                else if (samp) { const float* src = spool + (((size_t)l * DB + b) * PPAD + (PPAD + t)) * PWD + 8 * lane; a = *(const f32x4*)src; bb = *(const f32x4*)(src + 4); }
#pragma unroll
                for (int k = 0; k < 4; ++k) { const int d = k - (3 - dj);
                    if (d >= 0 && d < w) { acc[k][0] += a; acc[k][1] += bb; } if (d == 0) { cur[k][0] = a; cur[k][1] = bb; } } } }
#pragma unroll
        for (int k = 0; k < 4; ++k) { const int t = t0 + k; const int cnt = samp ? w : (t + 1 < w ? t + 1 : w); const float ic = 1.0f / (float)cnt;
            *(u32x4*)(POOLED + (size_t)(r0 + k) * PWD + 8 * lane) = pg8::pack8(acc[k][0] * ic - cur[k][0], acc[k][1] * ic - cur[k][1]);
            const int T = samp ? DS : MP;
            if (t >= T - PPAD) { float* o = samp ? out + O_POOLS + (((size_t)l * DB + b) * PPAD + (t - (T - PPAD))) * PWD + 8 * lane : out + O_POOLP + ((size_t)l * PPAD + (t - (T - PPAD))) * PWD + 8 * lane;
                *(f32x4*)o = cur[k][0]; *(f32x4*)(o + 4) = cur[k][1]; } }
#pragma unroll 1
        for (int k = 0; k < 4; ++k) { const int row = r0 + k, t = t0 + k; const float* ip = INP + (size_t)row * D;
            { const f32x4 a = *(const f32x4*)(ip + 8 * lane), bb = *(const f32x4*)(ip + 8 * lane + 4); const float r = rsqrtf(wave_sum(pg8::dot4(a) + pg8::dot4(bb)) * (1.0f / QL) + EPS);
              *(u32x4*)(CQ + (size_t)row * QL + 8 * lane) = pg8::pack8(a * r * gq0, bb * r * gq1); }
            { const f32x4 a = *(const f32x4*)(ip + 512 + 4 * lane); const float r = rsqrtf(wave_sum(pg8::dot4(a)) * (1.0f / KVL) + EPS); const f32x4 y = a * r * gkv;
              float* o = samp ? out + O_CKVS + ((size_t)l * MS + (row - MP)) * KVL + 4 * lane : out + O_CKVP + ((size_t)l * MP + row) * KVL + 4 * lane; *(f32x4*)o = y;
              const size_t crow = samp ? (size_t)MP + (size_t)b * SKS + PAST + t : (size_t)row; u32x2 o2; o2.x = pk2(y[0], y[1]); o2.y = pk2(y[2], y[3]); *(u32x2*)(CKV + crow * KVL + 4 * lane) = o2; }
            { const float x = ip[768 + lane]; const float r = rsqrtf(wave_sum(x * x) * (1.0f / RD) + EPS); const float v = x * r * gkr; const float pv = other_x32(v, lane >= 32);
              const int pos = samp ? PAST + t : t; const f32x2 cs = tab[(size_t)pos * 32 + (lane & 31)];
              const float y = lane < 32 ? v * cs.x - pv * cs.y : pv * cs.y + v * cs.x;
              float* o = samp ? out + O_KRS + ((size_t)l * MS + (row - MP)) * RD + lane : out + O_KRP + ((size_t)l * MP + row) * RD + lane; *o = y;
              bf16* ko = samp ? KRS + ((size_t)b * SKS + PAST + t) * RD + lane : KRP + (size_t)row * RD + lane; *ko = (bf16)(pk2(y, 0.f) & 0xffffu); }
            { const f32x4 a = *(const f32x4*)(ip + 1344 + 8 * lane), bb = *(const f32x4*)(ip + 1344 + 8 * lane + 4); const float r = rsqrtf(sum16(pg8::dot4(a) + pg8::dot4(bb)) * (1.0f / 128) + EPS);
              *(u32x4*)(QM + (size_t)row * MQD + 8 * lane) = pg8::pack8(a * r * gm0, bb * r * gm1); }
        }
    }
}

__device__ __forceinline__ void attn_store(att::f32x16* o, float l_reg, const bf16* gate, bf16* merged, bool store, float* li_l, float* stg, int lane) {
    const int r32 = lane & 31, hi = lane >> 5;
    if (!store) return;
    if (hi == 0) li_l[r32] = l_reg; LDS_WAIT();
    float rl[16];
#pragma unroll
    for (int r = 0; r < 16; ++r) rl[r] = __builtin_amdgcn_rcpf(li_l[att::crow(r, hi)]);
#pragma unroll
    for (int h = 0; h < 2; ++h) {
#pragma unroll
        for (int d = 0; d < 2; ++d)
#pragma unroll
            for (int r = 0; r < 16; ++r) stg[att::crow(r, hi) * 68 + d * 32 + r32] = o[2 * h + d][r] * rl[r];
        LDS_WAIT();
#pragma unroll
        for (int i = 0; i < 4; ++i) { const int p = lane + 64 * i, row = p >> 3, c8 = p & 7; const f32x4 a = *(const f32x4*)(stg + row * 68 + c8 * 8), bq = *(const f32x4*)(stg + row * 68 + c8 * 8 + 4);
            const size_t idx = (size_t)row * D + h * 64 + c8 * 8; const u32x4 g = *(const u32x4*)(gate + idx), m = *(const u32x4*)(merged + idx);
            const f32x4 o0 = {att::bflo(m.x) + att::bflo(g.x) * a[0], att::bfhi(m.x) + att::bfhi(g.x) * a[1], att::bflo(m.y) + att::bflo(g.y) * a[2], att::bfhi(m.y) + att::bfhi(g.y) * a[3]};
            const f32x4 o1 = {att::bflo(m.z) + att::bflo(g.z) * bq[0], att::bfhi(m.z) + att::bfhi(g.z) * bq[1], att::bflo(m.w) + att::bflo(g.w) * bq[2], att::bfhi(m.w) + att::bfhi(g.w) * bq[3]};
            *(u32x4*)(merged + idx) = pg8::pack8(o0, o1); }
        LDS_WAIT(); asm volatile("" ::: "memory");
    }
}
__device__ __forceinline__ void mem_attn_item(int l, LAS unsigned char* ldsl, char* lds, bool samp, int qb, int hc, const int wv) {
    int tid_ = wv * 64 + lane_id_fresh(); asm volatile("" : "+v"(tid_)); const int lane = tid_ & 63, wave = __builtin_amdgcn_readfirstlane(tid_ >> 6);
    unsigned char* ws = ldws(ldsl); const int r32 = lane & 31, hi = lane >> 5;
    const bf16* QM = (const bf16*)(ws + WS_QM); const bf16* GM = (const bf16*)(ws + WS_GM); bf16* MERGED = (bf16*)(ws + WS_MERGED);
    float* li_l = (float*)(lds + att::ATT_WS_OFF) + wave * 64;
    const float C = 0.08838834764831845f * LOG2E;
    const int h = hc >> 2, c = hc & 3;
    const int rowbase = samp ? MP + qb * DS + (wave & 1) * 32 : qb * 256 + wave * 32;
    const bf16* Kb = samp ? (const bf16*)(ws + WS_MEMKS) + (size_t)qb * NMEM * 512 + h * 128 : (const bf16*)(ws + WS_MEMKP) + h * 128;
    const bf16* Vb = samp ? (const bf16*)(ws + WS_MEMVS) + (size_t)qb * NMEM * D + h * 512 + c * 128 : (const bf16*)(ws + WS_MEMVP) + h * 512 + c * 128;
    att::bf16x8 qr[8];
    const bf16* qp = QM + (size_t)(rowbase + r32) * MQD + h * 128 + hi * 8;
#pragma unroll
    for (int d0 = 0; d0 < 8; ++d0) qr[d0] = *(const att::bf16x8*)(qp + d0 * 16);
    att::f32x16 o[4] = {}; float l_reg;
    int nt = 4; asm volatile("" : "+s"(nt)); att::attn_item_pp<128, 512, D, false>(qr, Kb, nullptr, Vb, nt, nt, nt, C, lds, o, l_reg, wv, !samp || wave < 2);
    const size_t ob = (size_t)rowbase * D + h * 512 + c * 128;
    attn_store(o, l_reg, GM + ob, MERGED + ob, !samp || wave < 2, li_l, (float*)(lds + wave * 8704), lane);
    __syncthreads();
}
__device__ __forceinline__ void main_attn_item(int l, LAS unsigned char* ldsl, char* lds, bool samp, int qb_or_b, int h, const int wv) {
    int tid_ = wv * 64 + lane_id_fresh(); asm volatile("" : "+v"(tid_));     const int lane = tid_ & 63, wave = __builtin_amdgcn_readfirstlane(tid_ >> 6);
    unsigned char* ws = ldws(ldsl); const int r32 = lane & 31, hi = lane >> 5;
    const bf16* QRAW = (const bf16*)(ws + WS_QRAW); const bf16* GA = (const bf16*)(ws + WS_GA); bf16* MERGED = (bf16*)(ws + WS_MERGED); const f32x2* tab = (const f32x2*)(ws + WS_ROPE);
    float* li_l = (float*)(lds + (samp ? att::SI_WS : att::ATT_WS_OFF)) + wave * 64;
    const float C = 0.07216878364870322f * LOG2E;
    const int rowbase = samp ? MP + qb_or_b * DS + (wave & 1) * 32 : qb_or_b * 256 + wave * 32;
    const int row = rowbase + r32; const int pos = samp ? PAST + (row - MP - qb_or_b * DS) : row;
    att::bf16x8 qr[8]; char* qrl = lds + (samp ? att::SI_QR + (wave & 3) * 4096 : 2 * 16384 + 2 * 24576 + 2048 + wave * 4096) + lane * 16; const bool qwr = !samp || wave < 4;
    { const bf16* qn = QRAW + (size_t)row * 3072 + h * 128 + hi * 8; const bf16* qrp = QRAW + (size_t)row * 3072 + D + h * 64 + hi * 8;
      const float* gn = ldp(ldsl, I_QN) + l * 128 + hi * 8; const float* gr = ldp(ldsl, I_QRN) + l * 64 + hi * 8;
      u32x4 rn[8]; float ss = 0.f;
#pragma unroll
      for (int d0 = 0; d0 < 8; ++d0) { rn[d0] = *(const u32x4*)(qn + d0 * 16);
#pragma unroll
          for (int q = 0; q < 4; ++q) { const float a = att::bflo(rn[d0][q]), bb = att::bfhi(rn[d0][q]); ss += a * a + bb * bb; } }
      ss = sum_x32(ss); const float rs_n = rsqrtf(ss * (1.0f / 128) + EPS) * (samp ? 1.0f : C);
#pragma unroll
      for (int d0 = 0; d0 < 8; ++d0) { const f32x4 g0 = *(const f32x4*)(gn + d0 * 16), g1 = *(const f32x4*)(gn + d0 * 16 + 4); u32x4 w;
          w.x = pk2(att::bflo(rn[d0].x) * rs_n * g0[0], att::bfhi(rn[d0].x) * rs_n * g0[1]); w.y = pk2(att::bflo(rn[d0].y) * rs_n * g0[2], att::bfhi(rn[d0].y) * rs_n * g0[3]);
          w.z = pk2(att::bflo(rn[d0].z) * rs_n * g1[0], att::bfhi(rn[d0].z) * rs_n * g1[1]); w.w = pk2(att::bflo(rn[d0].w) * rs_n * g1[2], att::bfhi(rn[d0].w) * rs_n * g1[3]);
          qr[d0] = *reinterpret_cast<att::bf16x8*>(&w); }
      u32x4 rr[4]; float sr = 0.f;
#pragma unroll
      for (int d = 0; d < 4; ++d) { rr[d] = *(const u32x4*)(qrp + d * 16);
#pragma unroll
          for (int q = 0; q < 4; ++q) { const float a = att::bflo(rr[d][q]), bb = att::bfhi(rr[d][q]); sr += a * a + bb * bb; } }
      sr = sum_x32(sr); const float rs_r = rsqrtf(sr * (1.0f / 64) + EPS) * (samp ? 1.0f : C);
#pragma unroll
      for (int d = 0; d < 2; ++d) { float x1[8], x2[8], y1[8], y2[8];
          const f32x4 ga0 = *(const f32x4*)(gr + d * 16), ga1 = *(const f32x4*)(gr + d * 16 + 4), gb0 = *(const f32x4*)(gr + 32 + d * 16), gb1 = *(const f32x4*)(gr + 32 + d * 16 + 4);
#pragma unroll
          for (int q = 0; q < 4; ++q) { x1[2 * q] = att::bflo(rr[d][q]) * rs_r * (q < 2 ? ga0[2 * q] : ga1[2 * q - 4]); x1[2 * q + 1] = att::bfhi(rr[d][q]) * rs_r * (q < 2 ? ga0[2 * q + 1] : ga1[2 * q - 3]);
                                        x2[2 * q] = att::bflo(rr[d + 2][q]) * rs_r * (q < 2 ? gb0[2 * q] : gb1[2 * q - 4]); x2[2 * q + 1] = att::bfhi(rr[d + 2][q]) * rs_r * (q < 2 ? gb0[2 * q + 1] : gb1[2 * q - 3]); }
          const f32x4* tp = (const f32x4*)(tab + (size_t)pos * 32 + d * 16 + hi * 8);
#pragma unroll
          for (int q = 0; q < 4; ++q) { const f32x4 cs = tp[q];
              y1[2 * q] = x1[2 * q] * cs[0] - x2[2 * q] * cs[1]; y2[2 * q] = x1[2 * q] * cs[1] + x2[2 * q] * cs[0];
              y1[2 * q + 1] = x1[2 * q + 1] * cs[2] - x2[2 * q + 1] * cs[3]; y2[2 * q + 1] = x1[2 * q + 1] * cs[3] + x2[2 * q + 1] * cs[2]; }
          u32x4 w1, w2; w1.x = pk2(y1[0], y1[1]); w1.y = pk2(y1[2], y1[3]); w1.z = pk2(y1[4], y1[5]); w1.w = pk2(y1[6], y1[7]);
          w2.x = pk2(y2[0], y2[1]); w2.y = pk2(y2[2], y2[3]); w2.z = pk2(y2[4], y2[5]); w2.w = pk2(y2[6], y2[7]);
          if (qwr) { *(u32x4*)(qrl + d * 1024) = w1; *(u32x4*)(qrl + (2 + d) * 1024) = w2; } }
    }
    att::f32x16 o[4] = {}; float l_reg;
    const size_t ob = (size_t)rowbase * D + h * 128;
    if (samp) {
        att::sample_item(qr, (const bf16*)(ws + WS_CKV) + ((size_t)MP + (size_t)qb_or_b * SKS) * KVL, (const bf16*)(ws + WS_KRS) + (size_t)qb_or_b * SKS * RD,
                         (const bf16*)(ws + WS_WKV) + (size_t)(h * 128) * KVL, (const bf16*)(ws + WS_WKV) + (size_t)(D + h * 128) * KVL, ldp(ldsl, I_KN) + l * 128, C, lds, o, l_reg, wv);
        attn_store(o, l_reg, GA + ob, MERGED + ob, wave < 2, li_l, (float*)(lds + wave * 8704), lane);
    } else {
        const bf16* Kn = (const bf16*)(ws + WS_KP) + h * 128; const bf16* Vh = (const bf16*)(ws + WS_VP) + h * 128; const bf16* Kr = (const bf16*)(ws + WS_KRP);
        const int NT = 4 * qb_or_b + 4, tlim = 4 * qb_or_b + (wave >> 1) + 1;
        att::attn_item_pp<192, D, D, true>(qr, Kn, Kr, Vh, NT, NT, tlim, C, lds, o, l_reg, wv, true);
        attn_store(o, l_reg, GA + ob, MERGED + ob, true, li_l, (float*)(lds + wave * 8704), lane);
    }
    __syncthreads();
}
__device__ __forceinline__ int q_pull(unsigned* head, volatile LAS int* slot) {
    if (threadIdx.x == 0) *slot = (int)__hip_atomic_fetch_add(head, 1u, __ATOMIC_RELAXED, __HIP_MEMORY_SCOPE_AGENT);
    __syncthreads();
    const int i = __builtin_amdgcn_readfirstlane(*slot);
    __syncthreads();
    return i;
}
__device__ __forceinline__ void phase_attn(int l, LAS unsigned char* ldsl, char* lds, const int wv) {
    unsigned* qbase = (unsigned*)(ldws(ldsl) + WS_CTL) + CW_QUEUE + (l * 2) * 8 * 64;
    volatile LAS int* slot = (volatile LAS int*)(ldsl + MISC_OFF + 64);
    const int x0 = (int)(xb_xcc_id() & 7u);
#pragma unroll 1
    for (int k = 0; k < 8; ++k) { const int x = (x0 + k) & 7;
#pragma unroll 1
        for (;;) { const int j = q_pull(qbase + x * 64, slot); if (j >= 128) break;
            const int qb = 63 - (j >> 1), h = 2 * x + (j & 1);
            main_attn_item(l, ldsl, lds, false, qb, h, wv);
            mem_attn_item(l, ldsl, lds, false, qb, h, wv); } }
}
__device__ __forceinline__ void phase_sattn(int l, LAS unsigned char* ldsl, char* lds, const int wv) {
    unsigned* qbase = (unsigned*)(ldws(ldsl) + WS_CTL) + CW_QUEUE + (l * 2 + 1) * 8 * 64;
    volatile LAS int* slot = (volatile LAS int*)(ldsl + MISC_OFF + 64); volatile LAS int* list = (volatile LAS int*)(ldsl + MISC_OFF + 80);
    const int x0 = (int)(xb_xcc_id() & 7u); int n = 0;
#pragma unroll 1
    for (int k = 0; k < 8 && n < 32; ++k) { const int x = (x0 + k) & 7;
#pragma unroll 1
        for (; n < 32;) { const int j = q_pull(qbase + x * 64, slot); if (j >= 32) break;
            const int it = x * 32 + j; if (threadIdx.x == 0) list[n] = it; ++n;
            main_attn_item(l, ldsl, lds, true, it >> 4, it & 15, wv); } }
    __syncthreads();
#pragma unroll 1
    for (int t = 0; t < n; ++t) { const int it = __builtin_amdgcn_readfirstlane(list[t]); mem_attn_item(l, ldsl, lds, true, it >> 4, it & 15, wv); }
}
#ifndef PHMASK
#define PHMASK 0xFFFFFFFFu
#endif
#define GEMM_PHASE(EpiT, E, Ap, Bp, Mr, Nc, Kd) do { pg8::Gemm g_{(const pg8::bf16_t*)(Ap), (const pg8::bf16_t*)(Bp), (Mr), (Nc), (Kd)}; pg8::StaticOrder S_; S_.init((Mr), (Nc), G, (int)blockIdx.x); \
        pg8::gemm_phase<EpiT, pg8::StaticOrder, true, true>(lds, g_, S_, E, wv); } while (0)
#define GEMM_PHASE_C(EpiT, E, Ap, Bp, Mr, Nc, Kd, cidx) do { pg8::Gemm g_{(const pg8::bf16_t*)(Ap), (const pg8::bf16_t*)(Bp), (Mr), (Nc), (Kd)}; pg8::StaticOrder S_; S_.init((Mr), (Nc), G, (cidx)); \
        pg8::gemm_phase<EpiT, pg8::StaticOrder, true, true>(lds, g_, S_, E, wv); } while (0)
#define SPLITK_PHASE(E, Ap, Bp, Mr, Nc, Kd) do { pg8::Gemm g_{(const pg8::bf16_t*)(Ap), (const pg8::bf16_t*)(Bp), (Mr), (Nc), (Kd)}; pg8::SplitKOrder S_; S_.init((Mr), (Nc), (Kd), 8, G, (int)blockIdx.x); \
        pg8::gemm_phase<pg8::EpiSlab, pg8::SplitKOrder, true, true>(lds, g_, S_, E, wv); } while (0)
template <int l> __device__ __forceinline__ void layer_program(LAS unsigned char* lds, unsigned char* lds_raw, const XcdBarrier& bar, const int lo, const int hi, const int G, const int wv) {
        const int pb = l * NPH;
#define WSP ldws(lds)
#define RP (ldout(lds) + O_Y)
#define IN(k) (((PHMASK >> (k)) & 1) && lo <= pb + (k) && pb + (k) < hi)
#ifdef DBG_STAMP
#define SEAM(k) do { if (pb + (k) + 1 < hi) xcd_barrier(bar); if (blockIdx.x == 0 && threadIdx.x == 0) ((LAS unsigned long long*)(lds + STAMP_OFF))[pb + (k) + 1] = __builtin_amdgcn_s_memrealtime(); } while (0)
#else
#define SEAM(k) do { if (pb + (k) + 1 < hi) xcd_barrier(bar); } while (0)
#endif
        if (l == 0 && IN(PH_PREP)) { phase_prep(0, lds, wv); SEAM(PH_PREP); }
        if (IN(PH_F1A)) { unsigned char* ws = WSP;
            pg8::EpiStoreF32 E2{(float*)(ws + WS_MKVRAW), 2560}; GEMM_PHASE_C(pg8::EpiStoreF32, E2, ws + WS_MB, ws + WS_WMK, NMEM, 2560, D, G - 1 - (int)blockIdx.x);
            pg8::EpiSwiGLU E{(bf16*)(ws + WS_ACT), (const float*)(ws + WS_RS)}; GEMM_PHASE(pg8::EpiSwiGLU, E, ws + WS_XB, ws + WS_W1A, M, 2 * DFF, D); SEAM(PH_F1A); }
        if (IN(PH_F1D)) { unsigned char* ws = WSP; typedef pg8::EpiResid<l == 0, false> ER; ER E{l == 0 ? ldp(lds, I_XP) : nullptr, l == 0 ? ldp(lds, I_XS) : nullptr, nullptr, (bf16*)(ws + WS_XB), (float*)(ws + WS_RS), 0.5f}; GEMM_PHASE(ER, E, ws + WS_ACT, ws + WS_W1D, MP, D, DFF);
            pg8::EpiSlab E2{(float*)(ws + WS_SLAB)}; SPLITK_PHASE(E2, (const bf16*)(ws + WS_ACT) + (size_t)MP * DFF, ws + WS_W1D, MS, D, DFF); SEAM(PH_F1D); }
        if (IN(PH_F1C)) { phase_combine<l == 0, false>(l == 0 ? ldp(lds, I_XS) : nullptr, 0.5f, lds, wv); SEAM(PH_F1C); }
        if (IN(PH_ING)) { unsigned char* ws = WSP; pg8::EpiInGate E{(float*)(ws + WS_INPROJ), (bf16*)(ws + WS_GA), (const float*)(ws + WS_RS), ldp(lds, I_BG) + (size_t)l * 3 * D};
            GEMM_PHASE(pg8::EpiInGate, E, ws + WS_XB, ws + WS_WIG, M, 8192, D); SEAM(PH_ING); }
        if (IN(PH_POST)) { phase_post(l, lds, wv); SEAM(PH_POST); }
        if (IN(PH_UQP)) { unsigned char* ws = WSP; pg8::EpiStore E{(bf16*)(ws + WS_QRAW), 3072}; GEMM_PHASE(pg8::EpiStore, E, ws + WS_CQ, ws + WS_WUQ, M, 3072, QL);
            pg8::EpiPool E2{(const bf16*)(ws + WS_GP), (bf16*)(ws + WS_MERGED), ldp(lds, I_POOLS) + (size_t)l * D}; GEMM_PHASE_C(pg8::EpiPool, E2, ws + WS_POOLED, ws + WS_WPL, M, D, PWD, G - 1 - (int)blockIdx.x); SEAM(PH_UQP); }
        if (IN(PH_KV0)) { unsigned char* ws = WSP; pg8::EpiKV E{(bf16*)(ws + WS_KP), (bf16*)(ws + WS_VP), (bf16*)(ws + WS_KP), (bf16*)(ws + WS_VP), MP, ldp(lds, I_KN) + l * 128, (LAS float*)(lds + LDSX_OFF)};
            GEMM_PHASE(pg8::EpiKV, E, ws + WS_CKV, ws + WS_WKV, MP, 4096, KVL); SEAM(PH_KV0); }
        if (IN(PH_ATT0)) { phase_sattn(l, lds, (char*)lds_raw, wv); phase_attn(l, lds, (char*)lds_raw, wv); SEAM(PH_ATT0); }
        if (IN(PH_WO)) { unsigned char* ws = WSP; typedef pg8::EpiResid<false, false> ER; ER E{nullptr, nullptr, nullptr, (bf16*)(ws + WS_XB), (float*)(ws + WS_RS), 1.0f}; GEMM_PHASE(ER, E, ws + WS_MERGED, ws + WS_WO, MP, D, D);
            pg8::EpiSlab E2{(float*)(ws + WS_SLAB)}; SPLITK_PHASE(E2, (const bf16*)(ws + WS_MERGED) + (size_t)MP * D, ws + WS_WO, MS, D, D); SEAM(PH_WO); }
        if (IN(PH_WOC)) { phase_combine<false, false>(nullptr, 1.0f, lds, wv); SEAM(PH_WOC); }
        if (IN(PH_F2A)) { unsigned char* ws = WSP; pg8::EpiSwiGLU E{(bf16*)(ws + WS_ACT), (const float*)(ws + WS_RS)}; GEMM_PHASE(pg8::EpiSwiGLU, E, ws + WS_XB, ws + WS_W2A, M, 2 * DFF, D); SEAM(PH_F2A); }
        if (IN(PH_F2D)) { unsigned char* ws = WSP; typedef pg8::EpiResid<false, l == DEPTH - 1> ER; ER E{nullptr, nullptr, l == DEPTH - 1 ? RP : nullptr, (bf16*)(ws + WS_XB), (float*)(ws + WS_RS), 0.5f}; GEMM_PHASE(ER, E, ws + WS_ACT, ws + WS_W2D, MP, D, DFF);
            pg8::EpiSlab E2{(float*)(ws + WS_SLAB)}; SPLITK_PHASE(E2, (const bf16*)(ws + WS_ACT) + (size_t)MP * DFF, ws + WS_W2D, MS, D, DFF); SEAM(PH_F2D); }
        if (IN(PH_F2C)) { phase_combine<false, l == DEPTH - 1>(nullptr, 0.5f, lds, wv); if (l == 0) phase_prep(1, lds, wv); SEAM(PH_F2C); }
#undef IN
#undef SEAM
#undef WSP
#undef RP
}
__global__ void __launch_bounds__(512, 2) mega_fwd(Params p) {
    extern __shared__ __attribute__((aligned(16))) unsigned char lds_raw[];
    LAS unsigned char* lds = (LAS unsigned char*)lds_raw;
    const int tid = threadIdx.x, wv = __builtin_amdgcn_readfirstlane(tid >> 6);
    const int G = gridDim.x;
    volatile LAS unsigned* MISC = (volatile LAS unsigned*)(lds + MISC_OFF);
    if (tid < 64) MISC[tid] = 0u;
    if (tid == 64) { LAS unsigned long long* t = (LAS unsigned long long*)(lds + PT_OFF);
#pragma unroll
        for (int i = 0; i < N_IN; ++i) t[i] = (unsigned long long)p.in[i];
        t[PT_OUT] = (unsigned long long)p.out; t[PT_WS] = (unsigned long long)p.ws;
        LAS double* iv = (LAS double*)(lds + PT_INV);
#pragma unroll
        for (int i = 0; i < 32; ++i) iv[i] = p.inv[i]; }
    __syncthreads();
    XcdBarrier bar = xcd_barrier_post((unsigned*)(p.ws + WS_CTL) + CW_BAR + p.li * XCD_BAR_WORDS, MISC + 8);
    const int lo = p.ph_lo, hi = p.ph_hi;
#ifdef DBG_STAMP
    if (blockIdx.x == 0 && threadIdx.x == 0) ((LAS unsigned long long*)(lds + STAMP_OFF))[0] = __builtin_amdgcn_s_memrealtime();
#endif
    layer_program<0>(lds, lds_raw, bar, lo, hi, G, wv);
    layer_program<1>(lds, lds_raw, bar, lo, hi, G, wv);
#ifdef DBG_STAMP
    if (blockIdx.x == 0 && threadIdx.x == 0) { const LAS unsigned long long* st = (const LAS unsigned long long*)(lds + STAMP_OFF);
        p.out[O_Y] += (float)(st[DBG_STAMP_L * NPH + (DBG_STAMP_B)] - st[DBG_STAMP_L * NPH + (DBG_STAMP_A)]) * (0.01f / 100.0f); }
#endif
}


#ifdef DBG_COPY_OFF
__global__ void dbg_copy(const unsigned char* ws, unsigned char* out, size_t bytes) { for (size_t i = ((size_t)blockIdx.x * 256 + threadIdx.x) * 16; i < bytes; i += (size_t)gridDim.x * 256 * 16) *(uint4*)(out + i) = *(const uint4*)(ws + i); }
#endif
#ifndef MK_N_LAUNCHES
#define MK_N_LAUNCHES 1
#endif
extern "C" void kernel_launch(void* const* d_in, const int* in_sizes, int n_in, void* d_out, int out_size, void* d_ws, size_t ws_size, hipStream_t stream) {
    static int grid = 0;
    if (grid == 0) {
        if (n_in != N_IN || (size_t)out_size != O_END || ws_size < WS_END) { fprintf(stderr, "kernel_launch: built for %d inputs, %zu outputs, >= %zu bytes of workspace; got %d, %d, %zu; nothing launched\n", (int)N_IN, (size_t)O_END, (size_t)WS_END, n_in, out_size, ws_size); grid = -1; return; }
        int dev = 0, cus = 0, per_cu = 0;
        if (hipGetDevice(&dev) != hipSuccess || hipDeviceGetAttribute(&cus, hipDeviceAttributeMultiprocessorCount, dev) != hipSuccess) { fprintf(stderr, "kernel_launch: device query failed\n"); grid = -1; return; }
        if (hipFuncSetAttribute((const void*)mega_fwd, hipFuncAttributeMaxDynamicSharedMemorySize, LDS_BYTES) != hipSuccess) { fprintf(stderr, "kernel_launch: hipFuncSetAttribute failed\n"); grid = -1; return; }
        if (hipOccupancyMaxActiveBlocksPerMultiprocessor(&per_cu, (const void*)mega_fwd, 512, LDS_BYTES) != hipSuccess || per_cu < 1) fprintf(stderr, "kernel_launch: note: occupancy query reports %d workgroups per CU\n", per_cu);
        (void)hipGetLastError();
        grid = cus;
    }
    if (grid < 0) return;
#ifdef DBG_MEMSET_ALL
    (void)hipMemsetAsync((char*)d_ws, 0, WS_END, stream);
#endif
    if (hipMemsetAsync((char*)d_ws + WS_CTL, 0, CTL_BYTES, stream) != hipSuccess) { fprintf(stderr, "kernel_launch: memset failed\n"); return; }
    Params p{};
    for (int i = 0; i < N_IN; ++i) p.in[i] = (const float*)d_in[i];
    p.out = (float*)d_out; p.ws = (unsigned char*)d_ws;
    for (int i = 0; i < 32; ++i) p.inv[i] = std::pow(10000.0, -(double)i / 32.0);
    p.pad = 0;
#ifdef DBG_NPH
    const int total = DBG_NPH;
#else
    const int total = DEPTH * NPH;
#endif
#if MK_N_LAUNCHES == 1
    p.ph_lo = 0; p.ph_hi = total; p.li = 0;
    hipLaunchKernelGGL(mega_fwd, dim3(grid), dim3(512), LDS_BYTES, stream, p);
#else
#ifdef DBG_PHLIST
    { const int lst[] = DBG_PHLIST; for (int k : lst) { p.ph_lo = k; p.ph_hi = k + 1; p.li = 0; hipLaunchKernelGGL(mega_fwd, dim3(grid), dim3(512), LDS_BYTES, stream, p); } (void)total; }
#else
    for (int k = 0; k < total; ++k) { p.ph_lo = k; p.ph_hi = k + 1; p.li = 0; hipLaunchKernelGGL(mega_fwd, dim3(grid), dim3(512), LDS_BYTES, stream, p); }
#endif
#endif
#ifdef DBG_COPY_OFF
    hipLaunchKernelGGL(dbg_copy, dim3(2048), dim3(256), 0, stream, (const unsigned char*)d_ws + (DBG_COPY_OFF), (unsigned char*)d_out, (size_t)(DBG_COPY_BYTES));
#endif
    const hipError_t le = hipPeekAtLastError();
    if (le != hipSuccess) fprintf(stderr, "kernel_launch: launch failed: %s\n", hipGetErrorName(le));
}
```
